# Optimizing an MI355X kernel written in HIP

```python
import math
import jax, jax.numpy as jnp
from jax import lax
import numpy as np

D_MODEL = 1024
BATCH = 8
SEQ = 8192
DEPTH = 2

CTX_LEN = 256
GRID_W = 64
HEAD_DIM = 64
ATTN_WIDTH = D_MODEL // 2
SGU_WIDTH = D_MODEL // 4
FOURIER_WIDTH = D_MODEL // 4
MIX_WIDTH = ATTN_WIDTH + SGU_WIDTH + FOURIER_WIDTH
N_Q_HEADS = ATTN_WIDTH // HEAD_DIM
N_KV_HEADS = N_Q_HEADS // 4
KV_WIDTH = N_KV_HEADS * HEAD_DIM
SGU_HEAD_DIM = 64
N_SGU_HEADS = SGU_WIDTH // SGU_HEAD_DIM
FOURIER_GROUP_DIM = 64
N_FOURIER_GROUPS = FOURIER_WIDTH // FOURIER_GROUP_DIM
IN_WIDTH = ATTN_WIDTH + 2 * KV_WIDTH + 2 * SGU_WIDTH + FOURIER_WIDTH
Q_END = ATTN_WIDTH
K_END = Q_END + KV_WIDTH
V_END = K_END + KV_WIDTH
U_END = V_END + SGU_WIDTH
G_END = U_END + SGU_WIDTH
WINDOW = 128
BLOCK = 128
CHUNK = 128
D_FF = 4 * D_MODEL
ROPE_THETA = 10000.0
EPS = 1e-6
NEG_INF = -1e30

kernel_name = "hymba_style_hybrid_dit_block"


def rmsnorm(x, g):
    xf = x.astype(jnp.float32)
    y = xf * lax.rsqrt(jnp.mean(xf * xf, axis=-1, keepdims=True) + EPS)
    return (y * g.astype(jnp.float32)).astype(x.dtype)


def axial_rope_tables(rows):
    row = jnp.repeat(jnp.arange(rows), GRID_W).astype(jnp.float32)
    col = jnp.tile(jnp.arange(GRID_W), rows).astype(jnp.float32)
    n_freq = HEAD_DIM // 4
    inv_freq = ROPE_THETA ** (-jnp.arange(n_freq, dtype=jnp.float32) / n_freq)
    ang_r = row[:, None] * inv_freq[None, :]
    ang_c = col[:, None] * inv_freq[None, :]
    ang = jnp.concatenate([ang_r, ang_r, ang_c, ang_c], axis=-1)
    return jnp.cos(ang), jnp.sin(ang)


def apply_rope(x, cos, sin):
    x1, x2, x3, x4 = jnp.split(x, 4, axis=-1)
    rot = jnp.concatenate([-x2, x1, -x4, x3], axis=-1)
    out = x * cos[None, :, None, :] + rot * sin[None, :, None, :]
    return out.astype(x.dtype)


def neighbour_blocks(t):
    z = jnp.zeros_like(t[:, :1])
    prev = jnp.concatenate([z, t[:, :-1]], axis=1)
    nxt = jnp.concatenate([t[:, 1:], z], axis=1)
    return jnp.concatenate([prev, t, nxt], axis=2)


def latent_window_attention(q, k, v, ck, cv, sink):
    B, S, H, hd = q.shape
    G = H // N_KV_HEADS
    nb = S // BLOCK
    scale = hd ** -0.5
    qb = q.reshape(B, nb, BLOCK, N_KV_HEADS, G, hd)
    kw = neighbour_blocks(k.reshape(B, nb, BLOCK, N_KV_HEADS, hd))
    vw = neighbour_blocks(v.reshape(B, nb, BLOCK, N_KV_HEADS, hd))
    s_loc = jnp.einsum('bnqhgd,bnkhd->bnhgqk', qb, kw, preferred_element_type=jnp.float32) * scale
    qpos = jnp.arange(BLOCK)[:, None]
    kpos = jnp.arange(3 * BLOCK)[None, :] - BLOCK
    band = jnp.abs(kpos - qpos) <= WINDOW
    kabs = jnp.arange(nb)[:, None, None] * BLOCK + kpos[None]
    valid = band[None] & (kabs >= 0) & (kabs < S)
    s_loc = jnp.where(valid[None, :, None, None], s_loc, NEG_INF)
    s_ctx = jnp.einsum('bnqhgd,bchd->bnhgqc', qb, ck, preferred_element_type=jnp.float32) * scale
    s_sink = jnp.broadcast_to(sink.astype(jnp.float32).reshape(1, 1, N_KV_HEADS, G, 1, 1),
                              s_loc.shape[:-1] + (1,))
    p = jax.nn.softmax(jnp.concatenate([s_loc, s_ctx, s_sink], axis=-1), axis=-1)
    n_loc = 3 * BLOCK
    n_ctx = ck.shape[1]
    p_loc = p[..., :n_loc].astype(v.dtype)
    p_ctx = p[..., n_loc:n_loc + n_ctx].astype(v.dtype)
    out = (jnp.einsum('bnhgqk,bnkhd->bnqhgd', p_loc, vw)
           + jnp.einsum('bnhgqc,bchd->bnqhgd', p_ctx, cv))
    return out.reshape(B, S, H * hd)


def context_attention(cq, ck, cv, sink):
    B, L, H, hd = cq.shape
    G = H // N_KV_HEADS
    qg = cq.reshape(B, L, N_KV_HEADS, G, hd)
    s = jnp.einsum('bqhgd,bkhd->bhgqk', qg, ck, preferred_element_type=jnp.float32) * (hd ** -0.5)
    s_sink = jnp.broadcast_to(sink.astype(jnp.float32).reshape(1, N_KV_HEADS, G, 1, 1),
                              s.shape[:-1] + (1,))
    p = jax.nn.softmax(jnp.concatenate([s, s_sink], axis=-1), axis=-1)[..., :L]
    out = jnp.einsum('bhgqk,bkhd->bqhgd', p.astype(cv.dtype), cv)
    return out.reshape(B, L, H * hd)


def spatial_gating(u, v, w_s, b_s, g_s):
    B, S, _ = u.shape
    vh = rmsnorm(v.reshape(B, S, N_SGU_HEADS, SGU_HEAD_DIM), g_s)
    vc = vh.reshape(B, S // CHUNK, CHUNK, N_SGU_HEADS, SGU_HEAD_DIM)
    mixed = jnp.einsum('hpq,bnqhd->bnphd', w_s, vc) + b_s.T[None, None, :, :, None]
    return u * mixed.reshape(B, S, SGU_WIDTH)


def fourier_mix(f):
    B, S, _ = f.shape
    fg = f.reshape(B, S, N_FOURIER_GROUPS, FOURIER_GROUP_DIM).astype(jnp.float32)
    y = jnp.real(jnp.fft.fft2(fg, axes=(1, 3), norm='ortho'))
    return y.reshape(B, S, FOURIER_WIDTH).astype(f.dtype)


def merge_heads(attn, sgu, four, g_mix, w_out):
    a = rmsnorm(attn, g_mix[:ATTN_WIDTH])
    s = rmsnorm(sgu, g_mix[ATTN_WIDTH:ATTN_WIDTH + SGU_WIDTH])
    f = rmsnorm(four, g_mix[ATTN_WIDTH + SGU_WIDTH:])
    return jnp.concatenate([a, s, f], axis=-1) @ w_out


def squared_relu_mlp(h, w1, w2):
    return jnp.square(jax.nn.relu(h @ w1)) @ w2


def setup_inputs(seed: int = 0) -> dict:
    key = jax.random.key(seed)
    ks = jax.random.split(key, 24)
    f32 = jnp.float32
    nrm = lambda k, shape, s: jax.random.normal(k, shape, f32) * s
    gain = lambda k, shape: 1.0 + 0.05 * jax.random.normal(k, shape, f32)
    return {
        "x": nrm(ks[0], (BATCH, SEQ, D_MODEL), 1.0),
        "c": nrm(ks[1], (BATCH, D_MODEL), 1.0),
        "ctx": nrm(ks[2], (BATCH, CTX_LEN, D_MODEL), 1.0),
        "c_ctx": nrm(ks[3], (D_MODEL,), 1.0),
        "w_ada": nrm(ks[4], (DEPTH, D_MODEL, 6 * D_MODEL), 0.5 * D_MODEL ** -0.5),
        "b_ada": nrm(ks[5], (DEPTH, 6 * D_MODEL), 0.02),
        "g_pre_mix": gain(ks[6], (DEPTH, D_MODEL)),
        "w_in": nrm(ks[7], (DEPTH, D_MODEL, IN_WIDTH), D_MODEL ** -0.5),
        "sink": nrm(ks[8], (DEPTH, N_Q_HEADS), 0.5),
        "w_sgu": nrm(ks[9], (DEPTH, N_SGU_HEADS, CHUNK, CHUNK), 0.5 * CHUNK ** -0.5),
        "b_sgu": gain(ks[10], (DEPTH, N_SGU_HEADS, CHUNK)),
        "g_sgu": gain(ks[11], (DEPTH, N_SGU_HEADS, SGU_HEAD_DIM)),
        "g_mix": gain(ks[12], (DEPTH, MIX_WIDTH)),
        "w_out": nrm(ks[13], (DEPTH, MIX_WIDTH, D_MODEL), MIX_WIDTH ** -0.5),
        "g_post_mix": gain(ks[14], (DEPTH, D_MODEL)),
        "g_pre_ff": gain(ks[15], (DEPTH, D_MODEL)),
        "w_ff1": nrm(ks[16], (DEPTH, D_MODEL, D_FF), D_MODEL ** -0.5),
        "w_ff2": nrm(ks[17], (DEPTH, D_FF, D_MODEL), D_FF ** -0.5),
        "g_post_ff": gain(ks[18], (DEPTH, D_MODEL)),
    }


def reference(x, c, ctx, c_ctx, w_ada, b_ada, g_pre_mix, w_in, sink, w_sgu, b_sgu, g_sgu,
              g_mix, w_out, g_post_mix, g_pre_ff, w_ff1, w_ff2, g_post_ff):
    B, S, _ = x.shape
    ROWS = S // GRID_W
    cos, sin = axial_rope_tables(ROWS)
    h_ctx = ctx
    for l in range(DEPTH):
        last = l == DEPTH - 1
        mod_x = (jax.nn.silu(c) @ w_ada[l] + b_ada[l])[:, None, :]
        sh1, sc1, g1, sh2, sc2, g2 = jnp.split(mod_x, 6, axis=-1)
        mod_c = jax.nn.silu(c_ctx) @ w_ada[l] + b_ada[l]
        csh1, csc1, cg1, csh2, csc2, cg2 = jnp.split(mod_c, 6, axis=-1)

        hc = rmsnorm(h_ctx, g_pre_mix[l]) * (1.0 + csc1) + csh1
        if last:
            ckv = hc @ w_in[l][:, Q_END:V_END]
            ck, cv = jnp.split(ckv, 2, axis=-1)
        else:
            pc = hc @ w_in[l]
            cq, ck, cv, cu, cg, cf = jnp.split(pc, [Q_END, K_END, V_END, U_END, G_END], axis=-1)
        ck = ck.reshape(B, CTX_LEN, N_KV_HEADS, HEAD_DIM)
        cv = cv.reshape(B, CTX_LEN, N_KV_HEADS, HEAD_DIM)
        if not last:
            c_attn = context_attention(cq.reshape(B, CTX_LEN, N_Q_HEADS, HEAD_DIM), ck, cv, sink[l])
            c_sgu = spatial_gating(jax.nn.gelu(cu), jax.nn.gelu(cg), w_sgu[l], b_sgu[l], g_sgu[l])
            c_four = fourier_mix(cf)
            yc = merge_heads(c_attn, c_sgu, c_four, g_mix[l], w_out[l])
            h_ctx = h_ctx + cg1 * rmsnorm(yc, g_post_mix[l])
            hc2 = rmsnorm(h_ctx, g_pre_ff[l]) * (1.0 + csc2) + csh2
            h_ctx = h_ctx + cg2 * rmsnorm(squared_relu_mlp(hc2, w_ff1[l], w_ff2[l]), g_post_ff[l])

        hx = rmsnorm(x, g_pre_mix[l]) * (1.0 + sc1) + sh1
        px = hx @ w_in[l]
        q, k, v, u, gv, f = jnp.split(px, [Q_END, K_END, V_END, U_END, G_END], axis=-1)
        q = apply_rope(q.reshape(B, S, N_Q_HEADS, HEAD_DIM), cos, sin)
        k = apply_rope(k.reshape(B, S, N_KV_HEADS, HEAD_DIM), cos, sin)
        v = v.reshape(B, S, N_KV_HEADS, HEAD_DIM)
        attn = latent_window_attention(q, k, v, ck, cv, sink[l])
        sgu = spatial_gating(jax.nn.gelu(u), jax.nn.gelu(gv), w_sgu[l], b_sgu[l], g_sgu[l])
        four = fourier_mix(f)
        y = merge_heads(attn, sgu, four, g_mix[l], w_out[l])
        x = x + g1 * rmsnorm(y, g_post_mix[l])
        hx2 = rmsnorm(x, g_pre_ff[l]) * (1.0 + sc2) + sh2
        x = x + g2 * rmsnorm(squared_relu_mlp(hx2, w_ff1[l], w_ff2[l]), g_post_ff[l])
    return x
```

```cpp
#include <hip/hip_runtime.h>
#include <hip/hip_cooperative_groups.h>
#include <cstdio>
#include <cstdint>
namespace cg = cooperative_groups;
namespace pg8 {
#define PG8_LAS __attribute__((address_space(3)))
typedef unsigned short bf16_t;
typedef short bf16x8 __attribute__((ext_vector_type(8)));
typedef float f32x4 __attribute__((ext_vector_type(4)));
typedef unsigned u32x4 __attribute__((ext_vector_type(4)));
constexpr int BM = 256, BK = 64, HALF = 128, HTB = HALF * BK * 2  , STAGE_BYTES = 8 * HTB, NXCD = 8, WGM = 8;

__host__ __device__ __forceinline__ int lds_byte(int r, int c) { const int st = (r >> 4) * 2 + (c >> 5), rr = r & 15, cc = c & 31, ob = rr * 64 + cc * 2; return st * 1024 + (ob ^ (((ob >> 9) & 1) << 5)); }
__host__ __device__ __forceinline__ void stage_rc(int b, int& R, int& C) { const int st = b / 1024, sb = b % 1024, swz = sb ^ (((sb >> 9) & 1) << 5); R = (st >> 1) * 16 + swz / 64; C = (st & 1) * 32 + (swz % 64) / 2; }
__host__ __device__ __forceinline__ int perm32(int rho) { const int n = rho >> 4, i = rho & 15; return 8 * (i >> 2) + 4 * n + (i & 3); }

struct Unit { int pm, pn, ko; };
struct Gemm { const bf16_t* A; const bf16_t* Bt; int M, N, K, ld; };

struct StaticOrder {
    int nM, nN, nwg, G, c;
    __host__ __device__ void init(int M, int N, int G_, int c_) { nM = M / BM; nN = N / BM; nwg = nM * nN; G = G_; c = c_; }
    __host__ __device__ bool next(int i, Unit& u) const {
        const long L = (long)i * G + c; if (L >= nwg) return false;
        int wgid = (int)L; { const int q = nwg / NXCD, r = nwg % NXCD, xcd = wgid % NXCD, off = wgid / NXCD; wgid = (xcd < r ? xcd * (q + 1) : r * (q + 1) + (xcd - r) * q) + off; }
        const int nig = WGM * nN, gid = wgid / nig, fm = gid * WGM, gsz = (nM - fm) < WGM ? (nM - fm) : WGM;
        u.pm = fm + ((wgid % nig) % gsz); u.pn = (wgid % nig) / gsz; u.ko = 0; return true;
    }
    __device__ __forceinline__ void a_ready(const Unit&) const {}
    __device__ __forceinline__ void done(const Unit&) const {}
};

__device__ __forceinline__ unsigned cvt_pk_bf16(float lo, float hi) { unsigned r; asm volatile("v_cvt_pk_bf16_f32 %0, %1, %2" : "=v"(r) : "v"(lo), "v"(hi)); return r; }
typedef float f32x2 __attribute__((ext_vector_type(2)));
typedef unsigned u32x2 __attribute__((ext_vector_type(2)));
__device__ __forceinline__ unsigned short f2bf1(float f) { return (unsigned short)(cvt_pk_bf16(f, 0.f) & 0xffffu); }
__device__ __forceinline__ float gelu_tanh(float x) {
    const float u = 0.7978845608f * (x + 0.044715f * x * x * x);
    return x * __builtin_amdgcn_rcpf(1.0f + __builtin_amdgcn_exp2f(-2.885390082f * u));
}
template <int ACT, bool REMAP> struct EpiPlain {
    static constexpr bool PERM = true, AFTER_DRAIN = false;
    bf16_t* O; int ldc; float scale;
    __device__ __forceinline__ void operator()(const f32x4 (&acc)[2][2][4][2], const Unit& u, int wr, int wc, int fr, int fq) const {
        asm volatile("" : "+v"(fr), "+v"(fq));
        const int row0 = (REMAP ? u.pn * BM : u.pm * BM) + wr * 64 + fr; const int col0 = (REMAP ? 0 : u.pn * BM) + wc * 32 + 8 * fq;
#pragma unroll
        for (int ai = 0; ai < 2; ++ai)
#pragma unroll
            for (int m = 0; m < 4; ++m) { bf16_t* rowp = O + (size_t)(row0 + ai * HALF + m * 16) * ldc + col0;
#pragma unroll
                for (int bj = 0; bj < 2; ++bj) { f32x4 v0 = acc[ai][bj][m][0], v1 = acc[ai][bj][m][1];
                    if (ACT == 1) {
#pragma unroll
                        for (int j = 0; j < 4; ++j) { float a = fmaxf(v0[j], 0.f), b = fmaxf(v1[j], 0.f); v0[j] = a * a; v1[j] = b * b; } }
                    v0 = v0 * scale; v1 = v1 * scale;
                    u32x4 w; w.x = cvt_pk_bf16(v0[0], v0[1]); w.y = cvt_pk_bf16(v0[2], v0[3]); w.z = cvt_pk_bf16(v1[0], v1[1]); w.w = cvt_pk_bf16(v1[2], v1[3]);
                    *(u32x4*)(rowp + bj * HALF) = w; } }
    }
};

struct SplitKOrder {
    int G, c, pm0, npm, npn, nks, ksub_bytes;
    __device__ bool next(int i, Unit& u) const {
        const int L = i * G + c; if (L >= npm * npn * nks) return false;
        u.ko = (L % nks) * ksub_bytes; const int t = L / nks; u.pn = t % npn; u.pm = pm0 + t / npn; return true;
    }
    __device__ __forceinline__ void a_ready(const Unit&) const {}
    __device__ __forceinline__ void done(const Unit&) const {}
};
struct EpiPart {
    static constexpr bool PERM = true, AFTER_DRAIN = false;
    float* P; int ldc, ksub_bytes, pm0; size_t slice;
    __device__ __forceinline__ void operator()(const f32x4 (&acc)[2][2][4][2], const Unit& u, int wr, int wc, int fr, int fq) const {
        asm volatile("" : "+v"(fr), "+v"(fq));
        float* base = P + (size_t)(u.ko / ksub_bytes) * slice;
        const int row0 = (u.pm - pm0) * BM + wr * 64 + fr, col0 = u.pn * BM + wc * 32 + 8 * fq;
#pragma unroll
        for (int ai = 0; ai < 2; ++ai)
#pragma unroll
            for (int m = 0; m < 4; ++m) { float* rowp = base + (size_t)(row0 + ai * HALF + m * 16) * ldc + col0;
#pragma unroll
                for (int bj = 0; bj < 2; ++bj) { *(f32x4*)(rowp + bj * HALF) = acc[ai][bj][m][0]; *(f32x4*)(rowp + bj * HALF + 4) = acc[ai][bj][m][1]; } }
    }
};
template <class Epi, class Sched, bool ALIGN_EPI = false, bool SP2 = false>
__device__ __forceinline__ void gemm_phase(PG8_LAS unsigned char* lds, const Gemm g, const Sched& S, const Epi& E) {
    int tid_l = threadIdx.x; asm volatile("" : "+v"(tid_l));
    const int tid = tid_l, wid = __builtin_amdgcn_readfirstlane(tid >> 6), lane = tid & 63, wr = wid >> 2, wc = wid & 3, fr = lane & 15, fq = lane >> 4;
    const int K = g.K, LD = g.ld ? g.ld : g.K, nt = K / BK;
    unsigned voffA[2], voffB[2];
#pragma unroll
    for (int i = 0; i < 2; ++i) { int R, C; stage_rc(tid * 16 + i * 8192, R, C); const int Rb = Epi::PERM ? ((R & ~31) + perm32(R & 31)) : R;
        voffA[i] = (unsigned)(R * LD + C) * 2u; voffB[i] = (unsigned)(Rb * LD + C) * 2u; }
    const size_t kstep = (size_t)(BK * 2);
    const size_t hstep = (size_t)HALF * LD * 2;
    const size_t tstep = 2 * hstep;
    const unsigned ldsw = (unsigned)wid * 1024u;
    const int aoff = lds_byte(wr * 64 + fr, fq * 8), boff = lds_byte(wc * 32 + fr, fq * 8);
#define PG8_SA(b, h) (((b) * 2 + (h)) * HTB)
#define PG8_SB(b, h) ((4 + (b) * 2 + (h)) * HTB)
#define PG8_STAGE(bufoff, gbase, voff) do { _Pragma("unroll") for (int _i = 0; _i < 2; ++_i) \
        __builtin_amdgcn_global_load_lds((const unsigned*)((const char*)(gbase) + (voff)[_i]), (PG8_LAS unsigned*)(lds + (bufoff) + ldsw + _i * 8192), 16, 0, 0); } while (0)
#define PG8_LDA(dst, b, h) do { _Pragma("unroll") for (int m = 0; m < 4; ++m) _Pragma("unroll") for (int k = 0; k < 2; ++k) dst[m][k] = *(const PG8_LAS bf16x8*)(lds + PG8_SA(b, h) + aoff + m * 2048 + k * 1024); } while (0)
#define PG8_LDB(dst, b, h) do { _Pragma("unroll") for (int n = 0; n < 2; ++n) _Pragma("unroll") for (int k = 0; k < 2; ++k) dst[n][k] = *(const PG8_LAS bf16x8*)(lds + PG8_SB(b, h) + boff + n * 2048 + k * 1024); } while (0)
#define PG8_MMA(ai, bj, At, Bt) do { __builtin_amdgcn_s_setprio(1); _Pragma("unroll") for (int m = 0; m < 4; ++m) _Pragma("unroll") for (int n = 0; n < 2; ++n) _Pragma("unroll") for (int k = 0; k < 2; ++k) \
        acc[ai][bj][m][n] = __builtin_amdgcn_mfma_f32_16x16x32_bf16(Bt[n][k], At[m][k], acc[ai][bj][m][n], 0, 0, 0); __builtin_amdgcn_s_setprio(0); } while (0)
#define PG8_WAIT_V(n) asm volatile("s_waitcnt vmcnt(" #n ")" ::: "memory")
#define PG8_WAIT_L(n) asm volatile("s_waitcnt lgkmcnt(" #n ")" ::: "memory")
#define PG8_BAR __builtin_amdgcn_s_barrier()
#define PG8_SCHED __builtin_amdgcn_sched_barrier(0)
    Unit cur, nxt; int ui = 0;
    if (!S.next(0, cur)) return;
    f32x4 acc[2][2][4][2];
#pragma unroll
    for (int a = 0; a < 2; ++a)
#pragma unroll
        for (int b = 0; b < 2; ++b)
#pragma unroll
            for (int m = 0; m < 4; ++m)
#pragma unroll
                for (int n = 0; n < 2; ++n) acc[a][b][m][n] = (f32x4){0.f, 0.f, 0.f, 0.f};
    bf16x8 At[4][2], B0[2][2], B1[2][2];
    const char* cA = (const char*)g.A + (size_t)cur.pm * tstep + cur.ko; const char* cB = (const char*)g.Bt + (size_t)cur.pn * tstep + cur.ko;
    S.a_ready(cur);
    if constexpr (SP2) {
        PG8_STAGE(PG8_SB(0, 0), cB, voffB); PG8_STAGE(PG8_SB(0, 1), cB + hstep, voffB); PG8_STAGE(PG8_SA(0, 0), cA, voffA); PG8_STAGE(PG8_SA(0, 1), cA + hstep, voffA);
        if (wr == 1) PG8_BAR;
        PG8_WAIT_V(2); PG8_BAR;
        PG8_STAGE(PG8_SB(1, 0), cB + kstep, voffB); PG8_STAGE(PG8_SA(1, 0), cA + kstep, voffA); PG8_STAGE(PG8_SB(1, 1), cB + hstep + kstep, voffB);
        PG8_WAIT_V(6); PG8_BAR;
    } else {
        PG8_STAGE(PG8_SB(0, 0), cB, voffB); PG8_STAGE(PG8_SA(0, 0), cA, voffA); PG8_STAGE(PG8_SB(0, 1), cB + hstep, voffB); PG8_STAGE(PG8_SA(0, 1), cA + hstep, voffA);
        if (wr == 1) PG8_BAR;
        PG8_WAIT_V(4); PG8_BAR;
        PG8_STAGE(PG8_SB(1, 0), cB + kstep, voffB); PG8_STAGE(PG8_SA(1, 0), cA + kstep, voffA); PG8_STAGE(PG8_SB(1, 1), cB + hstep + kstep, voffB);
        PG8_WAIT_V(6); PG8_BAR;
    }
    for (;;) {
        const bool has_next = S.next(ui + 1, nxt);
        const char* nA = has_next ? (const char*)g.A + (size_t)nxt.pm * tstep + nxt.ko : cA; const char* nB = has_next ? (const char*)g.Bt + (size_t)nxt.pn * tstep + nxt.ko : cB;
        for (int t = 0; t < nt; t += 2) {
            const bool last = (t == nt - 2);
            const char* a1 = cA + (size_t)(t + 1) * kstep;
            const char* a2 = last ? nA : cA + (size_t)(t + 2) * kstep; const char* b2 = last ? nB : cB + (size_t)(t + 2) * kstep;
            const char* a3 = a2 + kstep; const char* b3 = b2 + kstep;
            if (last && has_next) S.a_ready(nxt);
            if constexpr (SP2) {
            PG8_LDB(B0, 0, 0); PG8_LDB(B1, 0, 1); PG8_SCHED; PG8_LDA(At, 0, 0); PG8_STAGE(PG8_SA(1, 1), a1 + hstep, voffA);
            PG8_WAIT_V(8); PG8_WAIT_L(0); PG8_BAR; PG8_MMA(0, 0, At, B0); PG8_MMA(0, 1, At, B1); PG8_BAR; PG8_SCHED;
            PG8_LDA(At, 0, 1); PG8_STAGE(PG8_SB(0, 0), b2, voffB); PG8_STAGE(PG8_SB(0, 1), b2 + hstep, voffB); PG8_STAGE(PG8_SA(0, 0), a2, voffA);
            PG8_WAIT_V(8); PG8_WAIT_L(0); PG8_BAR; PG8_MMA(1, 0, At, B0); PG8_MMA(1, 1, At, B1); PG8_BAR; PG8_SCHED;
            PG8_LDB(B0, 1, 0); PG8_LDB(B1, 1, 1); PG8_SCHED; PG8_LDA(At, 1, 0); PG8_STAGE(PG8_SA(0, 1), a2 + hstep, voffA);
            PG8_WAIT_V(8); PG8_WAIT_L(0); PG8_BAR; PG8_MMA(0, 0, At, B0); PG8_MMA(0, 1, At, B1); PG8_BAR; PG8_SCHED;
            PG8_LDA(At, 1, 1); PG8_STAGE(PG8_SB(1, 0), b3, voffB); PG8_STAGE(PG8_SB(1, 1), b3 + hstep, voffB); PG8_STAGE(PG8_SA(1, 0), a3, voffA);
            PG8_WAIT_V(8); PG8_WAIT_L(0); PG8_BAR; PG8_MMA(1, 0, At, B0); PG8_MMA(1, 1, At, B1); PG8_BAR; PG8_SCHED;
            } else {
            PG8_LDB(B0, 0, 0); PG8_SCHED; PG8_LDA(At, 0, 0); PG8_STAGE(PG8_SA(1, 1), a1 + hstep, voffA);
            PG8_WAIT_L(8); PG8_BAR; PG8_WAIT_L(0); PG8_MMA(0, 0, At, B0); PG8_BAR; PG8_SCHED;
            PG8_LDB(B1, 0, 1); PG8_STAGE(PG8_SB(0, 0), b2, voffB);
            PG8_BAR; PG8_WAIT_L(0); PG8_MMA(0, 1, At, B1); PG8_BAR;
            PG8_LDA(At, 0, 1); PG8_STAGE(PG8_SA(0, 0), a2, voffA);
            PG8_BAR; PG8_WAIT_L(0); PG8_MMA(1, 0, At, B0); PG8_BAR; PG8_SCHED;
            PG8_STAGE(PG8_SB(0, 1), b2 + hstep, voffB);
            PG8_WAIT_V(6); PG8_BAR; PG8_MMA(1, 1, At, B1); PG8_BAR;
            PG8_LDB(B0, 1, 0); PG8_SCHED; PG8_LDA(At, 1, 0); PG8_STAGE(PG8_SA(0, 1), a2 + hstep, voffA);
            PG8_WAIT_L(8); PG8_BAR; PG8_WAIT_L(0); PG8_MMA(0, 0, At, B0); PG8_BAR; PG8_SCHED;
            PG8_LDB(B1, 1, 1); PG8_STAGE(PG8_SB(1, 0), b3, voffB);
            PG8_BAR; PG8_WAIT_L(0); PG8_MMA(0, 1, At, B1); PG8_BAR;
            PG8_LDA(At, 1, 1); PG8_STAGE(PG8_SA(1, 0), a3, voffA);
            PG8_BAR; PG8_WAIT_L(0); PG8_MMA(1, 0, At, B0); PG8_BAR; PG8_SCHED;
            PG8_STAGE(PG8_SB(1, 1), b3 + hstep, voffB);
            PG8_WAIT_V(6); PG8_BAR; PG8_MMA(1, 1, At, B1); PG8_BAR;
            }
        }
        if constexpr (ALIGN_EPI) { if (wr == 0) PG8_BAR; }
        if constexpr (!Epi::AFTER_DRAIN) { E(acc, cur, wr, wc, fr, fq); S.done(cur); }
        if (!has_next) break;
#pragma unroll
        for (int a = 0; a < 2; ++a)
#pragma unroll
            for (int b = 0; b < 2; ++b)
#pragma unroll
                for (int m = 0; m < 4; ++m)
#pragma unroll
                    for (int n = 0; n < 2; ++n) acc[a][b][m][n] = (f32x4){0.f, 0.f, 0.f, 0.f};
        cur = nxt; cA = nA; cB = nB; ++ui;
        if constexpr (ALIGN_EPI) { if (wr == 1) PG8_BAR; }
    }
    PG8_WAIT_V(0);
    if constexpr (!ALIGN_EPI) { if (wr == 0) PG8_BAR; }
    PG8_BAR;
    if constexpr (Epi::AFTER_DRAIN) { E.fused(acc, cur, wr, wc, fr, fq, lds, wid, lane); S.done(cur); }
#undef PG8_SA
#undef PG8_SB
#undef PG8_STAGE
#undef PG8_LDA
#undef PG8_LDB
#undef PG8_MMA
#undef PG8_WAIT_V
#undef PG8_WAIT_L
#undef PG8_BAR
#undef PG8_SCHED
}
}

#define LAS __attribute__((address_space(3)))
typedef unsigned short bf16;
typedef short bf16x8 __attribute__((ext_vector_type(8)));
typedef float f32x4 __attribute__((ext_vector_type(4)));
typedef float f32x16 __attribute__((ext_vector_type(16)));
typedef unsigned v4u __attribute__((ext_vector_type(4)));
typedef unsigned v2u __attribute__((ext_vector_type(2)));
using pg8::cvt_pk_bf16;

constexpr int NB = 8, SEQ = 8192, DM = 1024, CTXL = 256, DFF = 4096, NIN = 1536;
constexpr int ML = NB * SEQ;
constexpr int MT = ML + NB * CTXL;
constexpr float EPSN = 1e-6f;
constexpr float LOG2E = 1.4426950408889634f;
constexpr float QSCALE = 0.125f * 1.4426950408889634f;
constexpr size_t MiB = 1u << 20;
constexpr size_t WS_WIN = 0;
constexpr size_t WS_WOUT = 7 * MiB;
constexpr size_t WS_WFF1 = 11 * MiB;
constexpr size_t WS_WFF2 = 27 * MiB;
constexpr size_t WS_DFT512 = 43 * MiB;
constexpr size_t WS_DFT256 = 45 * MiB;
constexpr size_t WS_TW = 45 * MiB + 256 * 1024;
constexpr size_t WS_ROPEC = WS_TW + 64 * 1024;
constexpr size_t WS_ROPES = WS_ROPEC + 8 * 1024;
constexpr size_t WS_MOD = 46 * MiB;
constexpr size_t WS_HX = 48 * MiB;
constexpr size_t WS_XR = WS_HX + 132 * MiB;
constexpr size_t WS_C = WS_XR + 264 * MiB;
constexpr size_t WS_H1 = WS_C;
constexpr size_t WS_QB = WS_C;
constexpr size_t WS_KB = WS_QB + 66 * MiB;
constexpr size_t WS_VT = WS_KB + 17 * MiB;
constexpr size_t WS_VTC = WS_VT + 16 * MiB;
constexpr size_t WS_UB = WS_VTC + 1 * MiB;
constexpr size_t WS_GVT = WS_UB + 33 * MiB;
constexpr size_t WS_GVTC = WS_GVT + 32 * MiB;
constexpr size_t WS_GT = WS_GVTC + 1 * MiB;
constexpr size_t WS_GTC = WS_GT + 64 * MiB;
constexpr size_t WS_TP = WS_GTC + 2 * MiB;
constexpr size_t WS_MIX = WS_TP + 64 * MiB;
constexpr size_t WS_END = WS_C + 528 * MiB;
static_assert(WS_MIX + 132 * MiB <= WS_END, "overlay region");
constexpr size_t WS_PART = WS_END;
constexpr size_t WS_TOTAL = WS_PART + 32 * MiB;
static_assert(WS_TOTAL <= 1024 * MiB, "workspace");
constexpr int LDS_BYTES = 147456;
constexpr size_t WS_BAR = 46 * MiB + 512 * 1024;
constexpr int LDS_BARST = LDS_BYTES - 64;

__device__ __forceinline__ float bf2f(unsigned short h) { return __builtin_bit_cast(float, (unsigned)h << 16); }
__device__ __forceinline__ float bflo(unsigned w) { return __builtin_bit_cast(float, w << 16); }
__device__ __forceinline__ float bfhi(unsigned w) { return __builtin_bit_cast(float, w & 0xffff0000u); }
__device__ __forceinline__ float wave_sum(float v) {
#pragma unroll
    for (int o = 1; o < 64; o <<= 1) v += __shfl_xor(v, o);
    return v;
}
#define LDS_WAIT() asm volatile("s_waitcnt lgkmcnt(0)" ::: "memory")
__host__ __device__ __forceinline__ int fsig(int p) { return (p & 1) ? ((p == 1) ? 32 : 64 - (p >> 1)) : (p >> 1); }

struct Args { const float* in[19]; float* out; unsigned char* ws; };

struct EpiIn {
    static constexpr bool PERM = true, AFTER_DRAIN = false;
    unsigned char* wsb; int last;
    __device__ __forceinline__ void operator()(const pg8::f32x4 (&acc)[2][2][4][2], const pg8::Unit& u, int wr, int wc, int fr, int fq) const {
        using namespace pg8;
        asm volatile("" : "+v"(fr), "+v"(fq));
        unsigned char* ws = wsb; asm volatile("" : "+s"(ws));
        bf16_t* const QB = (bf16_t*)(ws + WS_QB); bf16_t* const KB = (bf16_t*)(ws + WS_KB); bf16_t* const VT = (bf16_t*)(ws + WS_VT); bf16_t* const VTc = (bf16_t*)(ws + WS_VTC);
        bf16_t* const UB = (bf16_t*)(ws + WS_UB); bf16_t* const GVT = (bf16_t*)(ws + WS_GVT); bf16_t* const GVTc = (bf16_t*)(ws + WS_GVTC); bf16_t* const GT = (bf16_t*)(ws + WS_GT); bf16_t* const GTc = (bf16_t*)(ws + WS_GTC);
        const float* const ropeC = (const float*)(ws + WS_ROPEC); const float* const ropeS = (const float*)(ws + WS_ROPES);
        const int pm = u.pm, pn = u.pn; const bool isctx = pm >= 256;
        if (isctx && last && pn != 2) return;
        const int b = isctx ? pm - 256 : pm >> 5;
        const int sbase = (isctx ? 0 : (pm & 31) * 256) + wr * 64 + fr;
        const size_t grow0 = (size_t)pm * 256 + wr * 64 + fr;
        const int c8 = wc * 32 + 8 * fq;
        if (pn <= 2) {
#pragma unroll
            for (int bj = 0; bj < 2; ++bj) {
                if (pn == 2 && bj == 1) {
                    bf16_t* base = isctx ? VTc + (size_t)b * 128 * 256 : VT + (size_t)b * 128 * 8192; const int ld = isctx ? 256 : 8192;
#pragma unroll
                    for (int ai = 0; ai < 2; ++ai)
#pragma unroll
                        for (int m = 0; m < 4; ++m) { const int s = sbase + ai * HALF + m * 16;
#pragma unroll
                            for (int n = 0; n < 2; ++n)
#pragma unroll
                                for (int j = 0; j < 4; ++j) base[(size_t)(c8 + 4 * n + j) * ld + s] = f2bf1(acc[ai][1][m][n][j]); asm volatile("" ::: "memory"); }
                } else {
                    const int i0 = 8 * (fq & 1); const bool odd = (wc & 1) != 0; const float sgn = (fq < 2) ? -1.f : 1.f;
#pragma unroll
                    for (int ai = 0; ai < 2; ++ai)
#pragma unroll
                        for (int m = 0; m < 4; ++m) { const int s = sbase + ai * HALF + m * 16;
                            f32x4 v0 = acc[ai][bj][m][0], v1 = acc[ai][bj][m][1];
                            if (!isctx) {
                                const int pos = odd ? (s & 63) : (s >> 6);
                                const f32x4 c0 = *(const f32x4*)(ropeC + pos * 16 + i0), c1 = *(const f32x4*)(ropeC + pos * 16 + i0 + 4);
                                const f32x4 s0 = *(const f32x4*)(ropeS + pos * 16 + i0), s1 = *(const f32x4*)(ropeS + pos * 16 + i0 + 4);
#pragma unroll
                                for (int j = 0; j < 4; ++j) { const float p0 = __shfl_xor(v0[j], 32), p1 = __shfl_xor(v1[j], 32);
                                    v0[j] = v0[j] * c0[j] + sgn * p0 * s0[j]; v1[j] = v1[j] * c1[j] + sgn * p1 * s1[j]; }
                            }
                            if (pn < 2) { v0 = v0 * QSCALE; v1 = v1 * QSCALE; }
                            u32x4 w; w.x = cvt_pk_bf16(v0[0], v0[1]); w.y = cvt_pk_bf16(v0[2], v0[3]); w.z = cvt_pk_bf16(v1[0], v1[1]); w.w = cvt_pk_bf16(v1[2], v1[3]);
                            const size_t grow = grow0 + ai * HALF + m * 16;
                            if (pn < 2) *(u32x4*)(QB + grow * 512 + pn * 256 + bj * HALF + c8) = w; else *(u32x4*)(KB + grow * 128 + c8) = w; asm volatile("" ::: "memory"); }
                }
            }
        } else if (pn == 3) {
#pragma unroll
            for (int ai = 0; ai < 2; ++ai)
#pragma unroll
                for (int m = 0; m < 4; ++m) { const size_t grow = grow0 + ai * HALF + m * 16;
#pragma unroll
                    for (int bj = 0; bj < 2; ++bj) { f32x4 v0 = acc[ai][bj][m][0], v1 = acc[ai][bj][m][1];
#pragma unroll
                        for (int j = 0; j < 4; ++j) { v0[j] = gelu_tanh(v0[j]); v1[j] = gelu_tanh(v1[j]); }
                        u32x4 w; w.x = cvt_pk_bf16(v0[0], v0[1]); w.y = cvt_pk_bf16(v0[2], v0[3]); w.z = cvt_pk_bf16(v1[0], v1[1]); w.w = cvt_pk_bf16(v1[2], v1[3]);
                        *(u32x4*)(UB + grow * 256 + bj * HALF + c8) = w; } asm volatile("" ::: "memory"); }
        } else if (pn == 4) {
            bf16_t* base = isctx ? GVTc + (size_t)b * 256 * 256 : GVT + (size_t)b * 256 * 8192; const int ld = isctx ? 256 : 8192;
#pragma unroll
            for (int ai = 0; ai < 2; ++ai)
#pragma unroll
                for (int m = 0; m < 4; ++m) { const int s = sbase + ai * HALF + m * 16;
#pragma unroll
                    for (int bj = 0; bj < 2; ++bj)
#pragma unroll
                        for (int n = 0; n < 2; ++n)
#pragma unroll
                            for (int j = 0; j < 4; ++j) base[(size_t)(bj * HALF + c8 + 4 * n + j) * ld + s] = f2bf1(gelu_tanh(acc[ai][bj][m][n][j])); asm volatile("" ::: "memory"); }
        } else {
            if (!isctx) {
                bf16_t* base = GT + ((size_t)b * 256 * 16 + fr) * 512 + 16 * (pm & 31) + 4 * wr;
#pragma unroll
                for (int bj = 0; bj < 2; ++bj)
#pragma unroll
                    for (int n = 0; n < 2; ++n)
#pragma unroll
                        for (int j = 0; j < 4; ++j) { const int ch = bj * HALF + c8 + 4 * n + j;
#pragma unroll
                            for (int ai = 0; ai < 2; ++ai) { u32x2 w; w.x = cvt_pk_bf16(acc[ai][bj][0][n][j], acc[ai][bj][1][n][j]); w.y = cvt_pk_bf16(acc[ai][bj][2][n][j], acc[ai][bj][3][n][j]);
                                *(u32x2*)(base + (size_t)ch * 8192 + 8 * ai) = w; } asm volatile("" ::: "memory"); }
            } else {
                bf16_t* base = GTc + (size_t)b * 256 * 512;
#pragma unroll
                for (int ai = 0; ai < 2; ++ai)
#pragma unroll
                    for (int m = 0; m < 4; ++m) { const int s = sbase + ai * HALF + m * 16;
#pragma unroll
                        for (int bj = 0; bj < 2; ++bj)
#pragma unroll
                            for (int n = 0; n < 2; ++n)
#pragma unroll
                                for (int j = 0; j < 4; ++j) { const int ch = bj * HALF + c8 + 4 * n + j; const bool ity = (ch & 1) && ((ch & 63) != 1);
                                    base[(size_t)ch * 512 + (ity ? 256 : 0) + s] = f2bf1(acc[ai][bj][m][n][j]); base[(size_t)ch * 512 + (ity ? 0 : 256) + s] = 0; } asm volatile("" ::: "memory"); }
            }
        }
    }
};


template <bool PERMK = false>
__device__ __forceinline__ void p0_transpose_item(const float* W, int K, int N, bf16* WT, int nblk, LAS float* scr, int item, int lane) {
    const int kb = item / nblk, nb = item % nblk, k0 = 64 * kb, n0 = 32 * nb;
    float tv[32];
#pragma unroll
    for (int i = 0; i < 32; ++i) { int kr = k0 + 2 * i + (lane >> 5); if (PERMK && kr >= 768) kr = (kr & ~63) + fsig(kr & 63); tv[i] = W[(size_t)kr * N + n0 + (lane & 31)]; }
#pragma unroll
    for (int i = 0; i < 32; ++i) scr[(2 * i + (lane >> 5)) * 33 + (lane & 31)] = tv[i];
    LDS_WAIT();
    const int c = lane & 7;
#pragma unroll
    for (int j = 0; j < 4; ++j) { const int n = (lane >> 3) + 8 * j; const LAS float* s = scr + (8 * c) * 33 + n;
        v4u o; o.x = cvt_pk_bf16(s[0 * 33], s[1 * 33]); o.y = cvt_pk_bf16(s[2 * 33], s[3 * 33]); o.z = cvt_pk_bf16(s[4 * 33], s[5 * 33]); o.w = cvt_pk_bf16(s[6 * 33], s[7 * 33]);
        *(v4u*)(WT + (size_t)(n0 + n) * K + k0 + 8 * c) = o; }
    LDS_WAIT();
}
__device__ __forceinline__ void p0_fold_item(const float* Win  , bf16* WT  , LAS float* scr, int item, int lane) {
    const int g = item >> 6, k0 = ((item >> 2) & 15) * 64, q0 = (item & 3) * 16;
    LAS float* cs = scr + 64 * 65; LAS float* sn = cs + 64;
    cs[lane] = cospif((float)lane / 32.f); sn[lane] = -sinpif((float)lane / 32.f);
#pragma unroll 1
    for (int i0 = 0; i0 < 64; i0 += 32) { float tv[32];
#pragma unroll
        for (int i = 0; i < 32; ++i) tv[i] = Win[(size_t)(k0 + i0 + i) * 1536 + 1280 + g * 64 + lane];
#pragma unroll
        for (int i = 0; i < 32; ++i) scr[(i0 + i) * 65 + lane] = tv[i]; }
    LDS_WAIT();
    for (int q = q0; q < q0 + 16; ++q) {
        const bool rtype = !(q & 1) || q == 1; const int jm = q == 1 ? 32 : (q >> 1);
        const LAS float* tab = rtype ? cs : sn;
        float ar = 0.f;
#pragma unroll 8
        for (int c = 0; c < 64; ++c) ar += scr[lane * 65 + c] * tab[(jm * c) & 63];
        WT[(size_t)(1280 + g * 64 + q) * 1024 + k0 + lane] = pg8::f2bf1(ar);
    }
    LDS_WAIT();
}
__device__ __forceinline__ void p0_mod_item(LAS unsigned char* lds, int item, const float* w_ada, const float* b_ada, float* MOD, int tid) {
    LAS float* sl = (LAS float*)lds; LAS float* red = sl + 9 * 1024;
    const int wave = tid >> 6, lane = tid & 63;
    const int l = item / 96, n0 = (item % 96) * 64;
    f32x4 acc[9];
#pragma unroll
    for (int r = 0; r < 9; ++r) acc[r] = (f32x4){0.f, 0.f, 0.f, 0.f};
    const int kr = lane >> 4, c4 = lane & 15;
    const float* W = w_ada + (size_t)l * 1024 * 6144 + n0 + c4 * 4;
#pragma unroll 1
    for (int k0 = 0; k0 < 128; k0 += 32) {
        f32x4 wv[8];
#pragma unroll
        for (int i = 0; i < 8; ++i) wv[i] = *(const f32x4*)(W + (size_t)(wave * 128 + k0 + i * 4 + kr) * 6144);
#pragma unroll
        for (int i = 0; i < 8; ++i) { const int k = wave * 128 + k0 + i * 4 + kr;
#pragma unroll
            for (int r = 0; r < 9; ++r) acc[r] = acc[r] + wv[i] * sl[r * 1024 + k]; }
    }
#pragma unroll
    for (int r = 0; r < 9; ++r)
#pragma unroll
        for (int e = 0; e < 4; ++e) { float v = acc[r][e]; v += __shfl_xor(v, 16); v += __shfl_xor(v, 32); acc[r][e] = v; }
    if (kr == 0) {
#pragma unroll
        for (int r = 0; r < 9; ++r)
#pragma unroll
            for (int e = 0; e < 4; ++e) red[(wave * 9 + r) * 64 + c4 * 4 + e] = acc[r][e];
    }
    __syncthreads();
    for (int i = tid; i < 576; i += 512) { const int r = i >> 6, n = i & 63; float s = b_ada[l * 6144 + n0 + n];
#pragma unroll
        for (int w = 0; w < 8; ++w) s += red[(w * 9 + r) * 64 + n];
        MOD[(size_t)(l * 9 + r) * 6144 + n0 + n] = s; }
    __syncthreads();
}
__device__ __forceinline__ void p0_prologue(const Args& a, LAS unsigned char* lds, int bid, int G, int tid) {
    asm volatile("" : "+v"(tid));
    unsigned char* ws = a.ws;
    const int wave = tid >> 6, lane = tid & 63;
    if (bid < 192) {
        LAS float* sl = (LAS float*)lds;
        for (int i = tid; i < 9 * 1024; i += 512) { const int r = i >> 10, k = i & 1023; const float v = r < 8 ? a.in[1][r * 1024 + k] : a.in[3][k]; sl[i] = v / (1.f + __expf(-v)); }
        __syncthreads();
        for (int it = bid; it < 192; it += G) p0_mod_item(lds, it, a.in[4], a.in[5], (float*)(ws + WS_MOD), tid);
    }
    __syncthreads();
    {
        const int gt = bid * 512 + tid, NT = G * 512;
        float* rc = (float*)(ws + WS_ROPEC); float* rs = (float*)(ws + WS_ROPES);
        for (int i = gt; i < 2048; i += NT) { const int pos = i >> 4, f = i & 15; const float invf = exp2f(-(float)f * (13.287712379549449f / 16.f));
            const float ang = (float)pos * invf; float rev = ang * 0.15915494309189535f; rev -= floorf(rev); rc[i] = cospif(2.f * rev); rs[i] = sinpif(2.f * rev); }
        float* tw = (float*)(ws + WS_TW);
        for (int i = gt; i < 8192; i += NT) { tw[2 * i] = cospif((float)i / 4096.f); tw[2 * i + 1] = sinpif((float)i / 4096.f); }
        bf16* d5 = (bf16*)(ws + WS_DFT512);
        for (int i = gt; i < 1024 * 512; i += NT) { const int R = i >> 9, s1 = i & 511, pr = R >> 9, k1 = R & 511; const int m = (k1 * s1) & 511;
            d5[i] = pg8::f2bf1(pr == 0 ? cospif((float)m / 256.f) : -sinpif((float)m / 256.f)); }
        bf16* d2 = (bf16*)(ws + WS_DFT256);
        for (int i = gt; i < 256 * 512; i += NT) { const int k = i >> 9, C = i & 511, pc = C >> 8, s = C & 255; const int m = (k * s) & 255;
            d2[i] = pg8::f2bf1(pc == 0 ? cospif((float)m / 128.f) : sinpif((float)m / 128.f)); }
    }
    LAS float* scr = (LAS float*)(lds + wave * 17408);
    const int gw = bid * 8 + wave, NGW = G * 8;
    constexpr int PER = 640 + 256 + 512 + 2048 + 2048;
    for (int it = gw; it < 2 * PER; it += NGW) {
        const int l = it / PER; int r = it % PER;
        const float* win = a.in[7] + (size_t)l * 1024 * 1536; bf16* wtin = (bf16*)(ws + WS_WIN) + (size_t)l * NIN * 1024;
        if (r < 640) { p0_transpose_item(win, 1024, 1536, wtin, 40, scr, r, lane); continue; } r -= 640;
        if (r < 256) { p0_fold_item(win, wtin, scr, r, lane); continue; } r -= 256;
        if (r < 512) { p0_transpose_item<true>(a.in[13] + (size_t)l * 1024 * 1024, 1024, 1024, (bf16*)(ws + WS_WOUT) + (size_t)l * 1024 * 1024, 32, scr, r, lane); continue; } r -= 512;
        if (r < 2048) { p0_transpose_item(a.in[16] + (size_t)l * 1024 * 4096, 1024, 4096, (bf16*)(ws + WS_WFF1) + (size_t)l * 4096 * 1024, 128, scr, r, lane); continue; } r -= 2048;
        p0_transpose_item(a.in[17] + (size_t)l * 4096 * 1024, 4096, 1024, (bf16*)(ws + WS_WFF2) + (size_t)l * 1024 * 4096, 32, scr, r, lane);
    }
}

template <int NR, int NP = 0>
__device__ __forceinline__ void row_op(const float* xin, const bf16* upd, const float* gate, const float* gupd, float* xout, bf16* hxout,
                                       const float* gn, const float* sc, const float* sh, int lane,
                                       const bf16* upd2 = nullptr, const float* gate2 = nullptr, const float* gupd2 = nullptr) {
    asm volatile("" : "+v"(lane));
    f32x4 x[NR][4];
#pragma unroll
    for (int r = 0; r < NR; ++r)
#pragma unroll
        for (int j = 0; j < 4; ++j) x[r][j] = *(const f32x4*)(xin + (size_t)r * DM + j * 256 + lane * 4);
    if (upd) {
        f32x4 y[NR][4];
#pragma unroll
        for (int r = 0; r < NR; ++r)
#pragma unroll
            for (int j = 0; j < 4; ++j) {
                if (NP == 0) { const v2u w = *(const v2u*)(upd + (size_t)r * DM + j * 256 + lane * 4); y[r][j][0] = bflo(w.x); y[r][j][1] = bfhi(w.x); y[r][j][2] = bflo(w.y); y[r][j][3] = bfhi(w.y); }
                else { const float* pp = (const float*)upd + (size_t)r * DM + j * 256 + lane * 4; f32x4 t = *(const f32x4*)pp;
#pragma unroll
                    for (int p = 1; p < NP; ++p) t = t + *(const f32x4*)(pp + (size_t)p * 2048 * 1024);
                    y[r][j] = t; } }
        float rr[NR];
#pragma unroll
        for (int r = 0; r < NR; ++r) { float ss = 0.f;
#pragma unroll
            for (int j = 0; j < 4; ++j) ss += (y[r][j][0] * y[r][j][0] + y[r][j][1] * y[r][j][1]) + (y[r][j][2] * y[r][j][2] + y[r][j][3] * y[r][j][3]);
            rr[r] = ss; }
#pragma unroll
        for (int r = 0; r < NR; ++r) rr[r] = rsqrtf(wave_sum(rr[r]) * (1.f / 1024.f) + EPSN);
#pragma unroll
        for (int j = 0; j < 4; ++j) { const f32x4 g = *(const f32x4*)(gate + j * 256 + lane * 4) * *(const f32x4*)(gupd + j * 256 + lane * 4);
#pragma unroll
            for (int r = 0; r < NR; ++r) x[r][j] = x[r][j] + g * (y[r][j] * rr[r]); }
    }
    if (upd2) {
        f32x4 y[NR][4];
#pragma unroll
        for (int r = 0; r < NR; ++r)
#pragma unroll
            for (int j = 0; j < 4; ++j) { const v2u w = *(const v2u*)(upd2 + (size_t)r * DM + j * 256 + lane * 4); y[r][j][0] = bflo(w.x); y[r][j][1] = bfhi(w.x); y[r][j][2] = bflo(w.y); y[r][j][3] = bfhi(w.y); }
        float rr[NR];
#pragma unroll
        for (int r = 0; r < NR; ++r) { float ss = 0.f;
#pragma unroll
            for (int j = 0; j < 4; ++j) ss += (y[r][j][0] * y[r][j][0] + y[r][j][1] * y[r][j][1]) + (y[r][j][2] * y[r][j][2] + y[r][j][3] * y[r][j][3]);
            rr[r] = ss; }
#pragma unroll
        for (int r = 0; r < NR; ++r) rr[r] = rsqrtf(wave_sum(rr[r]) * (1.f / 1024.f) + EPSN);
#pragma unroll
        for (int j = 0; j < 4; ++j) { const f32x4 g = *(const f32x4*)(gate2 + j * 256 + lane * 4) * *(const f32x4*)(gupd2 + j * 256 + lane * 4);
#pragma unroll
            for (int r = 0; r < NR; ++r) x[r][j] = x[r][j] + g * (y[r][j] * rr[r]); }
    }
    if (xout) {
#pragma unroll
        for (int r = 0; r < NR; ++r)
#pragma unroll
            for (int j = 0; j < 4; ++j) *(f32x4*)(xout + (size_t)r * DM + j * 256 + lane * 4) = x[r][j];
    }
    if (hxout) {
        float rr[NR];
#pragma unroll
        for (int r = 0; r < NR; ++r) { float ss = 0.f;
#pragma unroll
            for (int j = 0; j < 4; ++j) ss += (x[r][j][0] * x[r][j][0] + x[r][j][1] * x[r][j][1]) + (x[r][j][2] * x[r][j][2] + x[r][j][3] * x[r][j][3]);
            rr[r] = ss; }
#pragma unroll
        for (int r = 0; r < NR; ++r) rr[r] = rsqrtf(wave_sum(rr[r]) * (1.f / 1024.f) + EPSN);
#pragma unroll
        for (int j = 0; j < 4; ++j) { const f32x4 g = *(const f32x4*)(gn + j * 256 + lane * 4) * (*(const f32x4*)(sc + j * 256 + lane * 4) + 1.f), s0 = *(const f32x4*)(sh + j * 256 + lane * 4);
#pragma unroll
            for (int r = 0; r < NR; ++r) { const f32x4 h = (x[r][j] * rr[r]) * g + s0; v2u w; w.x = cvt_pk_bf16(h[0], h[1]); w.y = cvt_pk_bf16(h[2], h[3]); *(v2u*)(hxout + (size_t)r * DM + j * 256 + lane * 4) = w; } }
    }
}
template <int NR>
__device__ __forceinline__ void mixnorm_rows(bf16* mix, const float* gmix, int lane, bf16* outp) {
    asm volatile("" : "+v"(lane));
    v4u w[NR][2];
#pragma unroll
    for (int r = 0; r < NR; ++r) { w[r][0] = *(const v4u*)(mix + (size_t)r * 1024 + lane * 16); w[r][1] = *(const v4u*)(mix + (size_t)r * 1024 + lane * 16 + 8); }
    f32x4 g[4];
#pragma unroll
    for (int q = 0; q < 4; ++q) g[q] = *(const f32x4*)(gmix + lane * 16 + q * 4);
    float rr[NR];
#pragma unroll
    for (int r = 0; r < NR; ++r) { float ss = 0.f;
#pragma unroll
        for (int h = 0; h < 2; ++h)
#pragma unroll
            for (int e = 0; e < 4; ++e) { const float a = bflo(w[r][h][e]), b = bfhi(w[r][h][e]); ss += a * a + b * b; }
        rr[r] = ss; }
#pragma unroll
    for (int r = 0; r < NR; ++r) { float ss = rr[r]; ss += __shfl_xor(ss, 1); ss += __shfl_xor(ss, 2); ss += __shfl_xor(ss, 4); ss += __shfl_xor(ss, 8);
        const float s16 = __shfl_xor(ss, 16); const float tot = lane < 32 ? ss + s16 : ss; const float cnt = lane < 32 ? 512.f : 256.f;
        rr[r] = rsqrtf(tot / cnt + EPSN); }
#pragma unroll
    for (int r = 0; r < NR; ++r) {
#pragma unroll
        for (int h = 0; h < 2; ++h)
#pragma unroll
            for (int e = 0; e < 4; ++e) { const int q = h * 2 + (e >> 1); const float a = bflo(w[r][h][e]) * rr[r] * g[q][(e & 1) * 2], b = bfhi(w[r][h][e]) * rr[r] * g[q][(e & 1) * 2 + 1]; w[r][h][e] = cvt_pk_bf16(a, b); }
        *(v4u*)(outp + (size_t)r * 1024 + lane * 16) = w[r][0]; *(v4u*)(outp + (size_t)r * 1024 + lane * 16 + 8) = w[r][1]; }
}

#define MFMA32(a, b, c) __builtin_amdgcn_mfma_f32_32x32x16_bf16(a, b, c, 0, 0, 0)
constexpr int AT_ST = 136;
constexpr int AT_HALF = 128 * AT_ST * 2;
constexpr int AT_BUF = 2 * AT_HALF;
constexpr int AT_RED = 2 * AT_BUF;
__device__ __forceinline__ void attn_units(LAS unsigned char* lds, const bf16* QB, const bf16* KB, const bf16* VT, const bf16* VTc, bf16* MIX, const float* sink, const float* gmix,
                                           int nunits, int G, int vb, int tid) {
    asm volatile("" : "+v"(tid));
    const int wave = __builtin_amdgcn_readfirstlane(tid >> 6), lane = tid & 63, h = wave >> 2, c = lane & 31, hh = lane >> 5;
    LAS float* red = (LAS float*)(lds + AT_RED);
    for (int L = vb; L < nunits; L += G) {
        const int uidx = (L < 1024 && (G & 7) == 0) ? (L & 7) * 128 + (L >> 3) : L;
        const bool isctx = uidx >= 1024; int b, nb, q0;
        if (!isctx) { b = uidx >> 7; nb = (uidx >> 1) & 63; q0 = nb * 128 + (uidx & 1) * 64; } else { const int v = uidx - 1024; b = v >> 2; nb = 0; q0 = (v & 3) * 64; }
        const size_t qrow0 = (size_t)(isctx ? ML + b * CTXL : b * SEQ) + q0;
        bf16x8 qf[2][4];
#pragma unroll
        for (int qs = 0; qs < 2; ++qs)
#pragma unroll
            for (int ks = 0; ks < 4; ++ks) qf[qs][ks] = *(const bf16x8*)(QB + (qrow0 + qs * 32 + c) * 512 + wave * 64 + ks * 16 + hh * 8);
        float mrun[2], lrun[2]; f32x16 o[2][2];
        const float sk = sink[wave] * LOG2E;
#pragma unroll
        for (int qs = 0; qs < 2; ++qs) { mrun[qs] = sk; lrun[qs] = 1.f;
#pragma unroll
            for (int dt = 0; dt < 2; ++dt)
#pragma unroll
                for (int r = 0; r < 16; ++r) o[qs][dt][r] = 0.f; }
        int s = isctx ? 3 : (nb == 0 ? 1 : 0);
        v4u pk[4], pv[4];
#define AT_ISSUE(ss) do { const bf16* kg; const bf16* vg; int ldv; \
            if ((ss) < 3) { const int kb0 = (nb - 1 + (ss)) * 128; kg = KB + (size_t)(b * SEQ + kb0) * 128; vg = VT + (size_t)(b * 128) * SEQ + kb0; ldv = SEQ; } \
            else { const int kb0 = ((ss) - 3) * 128; kg = KB + (size_t)(ML + b * CTXL + kb0) * 128; vg = VTc + (size_t)(b * 128) * CTXL + kb0; ldv = CTXL; } \
            _Pragma("unroll") for (int e = 0; e < 4; ++e) { const int i = tid + 512 * e, r = i >> 4, ch = i & 15; pk[e] = *(const v4u*)(kg + (size_t)r * 128 + ch * 8); pv[e] = *(const v4u*)(vg + (size_t)r * ldv + ch * 8); } } while (0)
#define AT_WRITE(bufo) do { _Pragma("unroll") for (int e = 0; e < 4; ++e) { const int i = tid + 512 * e, r = i >> 4, ch = i & 15; \
            *(LAS v4u*)(lds + (bufo) + (r * AT_ST + ch * 8) * 2) = pk[e]; *(LAS v4u*)(lds + (bufo) + AT_HALF + (r * AT_ST + ch * 8) * 2) = pv[e]; } } while (0)
        AT_ISSUE(s);
        __syncthreads();
        AT_WRITE(0);
        __syncthreads();
        int cur = 0;
        for (;;) {
            int sn = s + 1; if (sn == 2 && !isctx && nb == 63) sn = 3;
            if (sn <= 4) AT_ISSUE(sn);
            const LAS bf16* Ks = (const LAS bf16*)(lds + cur * AT_BUF); const LAS bf16* Vs = (const LAS bf16*)(lds + cur * AT_BUF + AT_HALF);
            int t_lo = 0, t_hi = 3; const int kb0 = (nb - 1 + s) * 128;
            if (s < 3) { const int a0 = q0 - 128 - kb0, a1 = q0 + 191 - kb0; t_lo = a0 > 0 ? a0 >> 5 : 0; t_hi = (a1 >> 5) < 3 ? (a1 >> 5) : 3; }
            for (int kt = t_lo; kt <= t_hi; ++kt) {
                bf16x8 kf[4];
#pragma unroll
                for (int ks = 0; ks < 4; ++ks) kf[ks] = *(const LAS bf16x8*)(Ks + (kt * 32 + c) * AT_ST + h * 64 + ks * 16 + hh * 8);
                bf16x8 vf[2][2];
#pragma unroll
                for (int dt = 0; dt < 2; ++dt)
#pragma unroll
                    for (int s2 = 0; s2 < 2; ++s2) { const LAS bf16* p = Vs + (h * 64 + dt * 32 + c) * AT_ST + kt * 32 + s2 * 16 + hh * 4;
                        const v2u lo = *(const LAS v2u*)p, hi = *(const LAS v2u*)(p + 8); v4u t; t.x = lo.x; t.y = lo.y; t.z = hi.x; t.w = hi.y; vf[dt][s2] = __builtin_bit_cast(bf16x8, t); }
                f32x16 st[2];
#pragma unroll
                for (int qs = 0; qs < 2; ++qs) {
                    const float nm = -mrun[qs];
#pragma unroll
                    for (int r = 0; r < 16; ++r) st[qs][r] = nm;
#pragma unroll
                    for (int ks = 0; ks < 4; ++ks) st[qs] = MFMA32(kf[ks], qf[qs][ks], st[qs]);
                }
                bf16x8 pb[2][2];
#pragma unroll
                for (int qs = 0; qs < 2; ++qs) {
                    float t[16];
#pragma unroll
                    for (int r = 0; r < 16; ++r) t[r] = st[qs][r];
                    const int kmin = kb0 + kt * 32, qmin = q0 + qs * 32;
                    if (s < 3 && (kmin - (qmin + 31) < -128 || kmin + 31 - qmin > 128)) {
                        const int base = kmin + 4 * hh - (qmin + c) + 128;
#pragma unroll
                        for (int r = 0; r < 16; ++r) { if ((unsigned)(base + (r & 3) + 8 * (r >> 2)) > 256u) t[r] = -1e30f; } }
                    float tmax = fmaxf(fmaxf(t[0], t[1]), t[2]);
#pragma unroll
                    for (int r = 3; r < 15; r += 2) tmax = fmaxf(fmaxf(tmax, t[r]), t[r + 1]);
                    tmax = fmaxf(tmax, t[15]);
                    { auto rr = __builtin_amdgcn_permlane32_swap(__float_as_uint(tmax), __float_as_uint(tmax), false, false); tmax = fmaxf(__uint_as_float(rr[0]), __uint_as_float(rr[1])); }
                    if (!__all(tmax <= 8.f)) {
                        const float delta = fmaxf(tmax, 0.f), alpha = __builtin_amdgcn_exp2f(-delta);
                        lrun[qs] *= alpha; mrun[qs] += delta;
#pragma unroll
                        for (int dt = 0; dt < 2; ++dt) o[qs][dt] = o[qs][dt] * alpha;
#pragma unroll
                        for (int r = 0; r < 16; ++r) t[r] -= delta;
                    }
                    float psum = 0.f;
#pragma unroll
                    for (int r = 0; r < 16; ++r) { t[r] = __builtin_amdgcn_exp2f(t[r]); psum += t[r]; }
                    { auto rr = __builtin_amdgcn_permlane32_swap(__float_as_uint(psum), __float_as_uint(psum), false, false); psum = __uint_as_float(rr[0]) + __uint_as_float(rr[1]); }
                    lrun[qs] += psum;
#pragma unroll
                    for (int s2 = 0; s2 < 2; ++s2) { v4u w; w.x = cvt_pk_bf16(t[8 * s2 + 0], t[8 * s2 + 1]); w.y = cvt_pk_bf16(t[8 * s2 + 2], t[8 * s2 + 3]); w.z = cvt_pk_bf16(t[8 * s2 + 4], t[8 * s2 + 5]); w.w = cvt_pk_bf16(t[8 * s2 + 6], t[8 * s2 + 7]);
                        pb[qs][s2] = __builtin_bit_cast(bf16x8, w); }
#pragma unroll
                    for (int s2 = 0; s2 < 2; ++s2)
#pragma unroll
                        for (int dt = 0; dt < 2; ++dt) o[qs][dt] = MFMA32(vf[dt][s2], pb[qs][s2], o[qs][dt]);
                    __builtin_amdgcn_sched_barrier(0);
                }
            }
            if (sn > 4) break;
            AT_WRITE((cur ^ 1) * AT_BUF);
            __syncthreads();
            cur ^= 1; s = sn;
        }
#undef AT_ISSUE
#undef AT_WRITE
        float ssq[2];
#pragma unroll
        for (int qs = 0; qs < 2; ++qs) { const float inv = 1.f / lrun[qs]; float ss = 0.f;
#pragma unroll
            for (int dt = 0; dt < 2; ++dt) { o[qs][dt] = o[qs][dt] * inv;
#pragma unroll
                for (int r = 0; r < 16; ++r) ss += o[qs][dt][r] * o[qs][dt][r]; }
            { auto rr = __builtin_amdgcn_permlane32_swap(__float_as_uint(ss), __float_as_uint(ss), false, false); ss = __uint_as_float(rr[0]) + __uint_as_float(rr[1]); }
            ssq[qs] = ss; if (hh == 0) red[wave * 64 + qs * 32 + c] = ss; }
        __syncthreads();
        LAS bf16* otile = (LAS bf16*)(lds + wave * 9216);
#pragma unroll
        for (int qs = 0; qs < 2; ++qs) { float tot = 0.f;
#pragma unroll
            for (int w = 0; w < 8; ++w) tot += red[w * 64 + qs * 32 + c];
            const float rn = rsqrtf(tot * (1.f / 512.f) + EPSN);
#pragma unroll
            for (int dt = 0; dt < 2; ++dt)
#pragma unroll
                for (int rg = 0; rg < 4; ++rg) { const f32x4 gm = *(const f32x4*)(gmix + wave * 64 + dt * 32 + rg * 8 + hh * 4);
                    v2u w; w.x = cvt_pk_bf16(o[qs][dt][4 * rg] * rn * gm[0], o[qs][dt][4 * rg + 1] * rn * gm[1]); w.y = cvt_pk_bf16(o[qs][dt][4 * rg + 2] * rn * gm[2], o[qs][dt][4 * rg + 3] * rn * gm[3]);
                    *(LAS v2u*)(otile + (qs * 32 + c) * 72 + dt * 32 + rg * 8 + hh * 4) = w; } }
        LDS_WAIT();
#pragma unroll
        for (int it = 0; it < 8; ++it) { const int r = it * 8 + (lane >> 3), ch = lane & 7; const v4u v = *(const LAS v4u*)(otile + r * 72 + ch * 8);
            *(v4u*)(MIX + (qrow0 + r) * 1024 + wave * 64 + ch * 8) = v; }
    }
    __syncthreads();
}

__device__ __forceinline__ void sgu_units(LAS unsigned char* lds, const bf16* UB, const bf16* GVT, const bf16* GVTc, bf16* MIX, const float* wsgu, const float* bsgu, const float* gsgu, const float* gmix,
                                          int nchunks, int G, int bid, int tid) {
    asm volatile("" : "+v"(tid));
    const int wave = __builtin_amdgcn_readfirstlane(tid >> 6), lane = tid & 63, hd = wave >> 1, ph = wave & 1, c = lane & 31, h2 = lane >> 5;
    LAS float* rq = (LAS float*)lds + wave * 128;
    bf16x8 bfr[2][8];
#pragma unroll
    for (int ps = 0; ps < 2; ++ps)
#pragma unroll
        for (int ks = 0; ks < 8; ++ks) { const float* wp = wsgu + ((size_t)(hd * 128 + ph * 64 + ps * 32 + c)) * 128 + ks * 16 + h2 * 8; const f32x4 w0 = *(const f32x4*)wp, w1 = *(const f32x4*)(wp + 4);
            v4u w; w.x = cvt_pk_bf16(w0[0], w0[1]); w.y = cvt_pk_bf16(w0[2], w0[3]); w.z = cvt_pk_bf16(w1[0], w1[1]); w.w = cvt_pk_bf16(w1[2], w1[3]); bfr[ps][ks] = __builtin_bit_cast(bf16x8, w); }
    for (int L = bid; L < nchunks; L += G) {
        const int chunk = (L < 512 && (G & 7) == 0) ? (L & 7) * 64 + (L >> 3) : L;
        const bool isctx = chunk >= 512; const int b = isctx ? (chunk - 512) >> 1 : chunk >> 6, s0 = isctx ? ((chunk - 512) & 1) * 128 : (chunk & 63) * 128;
        const int ld = isctx ? CTXL : SEQ;
        const bf16* Gt = (isctx ? GVTc + ((size_t)(b * 256 + hd * 64)) * CTXL : GVT + ((size_t)(b * 256 + hd * 64)) * SEQ) + s0;
        float sa = 0.f, sb = 0.f;
#pragma unroll 1
        for (int d0 = 0; d0 < 64; d0 += 32) { unsigned gv[32];
#pragma unroll
            for (int d = 0; d < 32; ++d) gv[d] = *(const unsigned*)(Gt + (size_t)(d0 + d) * ld + 2 * lane);
#pragma unroll
            for (int d = 0; d < 32; ++d) { const float x0 = bflo(gv[d]), x1 = bfhi(gv[d]); sa += x0 * x0; sb += x1 * x1; } }
        LDS_WAIT();
        rq[2 * lane] = rsqrtf(sa * (1.f / 64.f) + EPSN); rq[2 * lane + 1] = rsqrtf(sb * (1.f / 64.f) + EPSN);
        LDS_WAIT();
        f32x16 o[2][2];
#pragma unroll
        for (int dt = 0; dt < 2; ++dt)
#pragma unroll
            for (int ps = 0; ps < 2; ++ps)
#pragma unroll
                for (int r = 0; r < 16; ++r) o[dt][ps][r] = 0.f;
        v4u afr[2][8];
#pragma unroll
        for (int ks = 0; ks < 8; ++ks)
#pragma unroll
            for (int dt = 0; dt < 2; ++dt) afr[dt][ks] = *(const v4u*)(Gt + (size_t)(dt * 32 + c) * ld + ks * 16 + h2 * 8);
        LAS bf16* utile = (LAS bf16*)(lds + 8192 + wave * 9216);
        { v4u ut[8];
#pragma unroll
          for (int it = 0; it < 8; ++it) ut[it] = *(const v4u*)(UB + ((size_t)chunk * 128 + ph * 64 + it * 8 + (lane >> 3)) * 256 + hd * 64 + (lane & 7) * 8);
#pragma unroll
          for (int it = 0; it < 8; ++it) *(LAS v4u*)(utile + (it * 8 + (lane >> 3)) * 72 + (lane & 7) * 8) = ut[it]; }
#pragma unroll
        for (int ks = 0; ks < 8; ++ks) {
            const f32x4 r0 = *(const LAS f32x4*)(rq + ks * 16 + h2 * 8), r1 = *(const LAS f32x4*)(rq + ks * 16 + h2 * 8 + 4);
#pragma unroll
            for (int dt = 0; dt < 2; ++dt) { const v4u g = afr[dt][ks]; v4u w;
                w.x = cvt_pk_bf16(bflo(g.x) * r0[0], bfhi(g.x) * r0[1]); w.y = cvt_pk_bf16(bflo(g.y) * r0[2], bfhi(g.y) * r0[3]); w.z = cvt_pk_bf16(bflo(g.z) * r1[0], bfhi(g.z) * r1[1]); w.w = cvt_pk_bf16(bflo(g.w) * r1[2], bfhi(g.w) * r1[3]);
                const bf16x8 af = __builtin_bit_cast(bf16x8, w);
#pragma unroll
                for (int ps = 0; ps < 2; ++ps) o[dt][ps] = MFMA32(af, bfr[ps][ks], o[dt][ps]); }
        }
        LAS float* red2 = (LAS float*)(lds + 4096);
#pragma unroll
        for (int ps = 0; ps < 2; ++ps) { const int p = ph * 64 + ps * 32 + c; const size_t row = (size_t)chunk * 128 + p; const float bs = bsgu[hd * 128 + p]; float ss = 0.f;
#pragma unroll
            for (int dt = 0; dt < 2; ++dt)
#pragma unroll
                for (int rg = 0; rg < 4; ++rg) { const int d0 = dt * 32 + rg * 8 + h2 * 4; const f32x4 gs = *(const f32x4*)(gsgu + hd * 64 + d0);
                    const v2u uw = *(const LAS v2u*)(utile + (ps * 32 + c) * 72 + d0);
                    const float o0 = bflo(uw.x) * (gs[0] * o[dt][ps][4 * rg] + bs), o1 = bfhi(uw.x) * (gs[1] * o[dt][ps][4 * rg + 1] + bs), o2 = bflo(uw.y) * (gs[2] * o[dt][ps][4 * rg + 2] + bs), o3 = bfhi(uw.y) * (gs[3] * o[dt][ps][4 * rg + 3] + bs);
                    o[dt][ps][4 * rg] = o0; o[dt][ps][4 * rg + 1] = o1; o[dt][ps][4 * rg + 2] = o2; o[dt][ps][4 * rg + 3] = o3; ss += (o0 * o0 + o1 * o1) + (o2 * o2 + o3 * o3); }
            { auto rr = __builtin_amdgcn_permlane32_swap(__float_as_uint(ss), __float_as_uint(ss), false, false); ss = __uint_as_float(rr[0]) + __uint_as_float(rr[1]); }
            if (h2 == 0) red2[hd * 128 + p] = ss; }
        __syncthreads();
        LAS bf16* otile = (LAS bf16*)(lds + 8192 + wave * 9216);
#pragma unroll
        for (int ps = 0; ps < 2; ++ps) { const int p = ph * 64 + ps * 32 + c;
            const float rn = rsqrtf((red2[p] + red2[128 + p] + red2[256 + p] + red2[384 + p]) * (1.f / 256.f) + EPSN);
#pragma unroll
            for (int dt = 0; dt < 2; ++dt)
#pragma unroll
                for (int rg = 0; rg < 4; ++rg) { const int d0 = dt * 32 + rg * 8 + h2 * 4; const f32x4 gm = *(const f32x4*)(gmix + 512 + hd * 64 + d0);
                    v2u w; w.x = cvt_pk_bf16(o[dt][ps][4 * rg] * rn * gm[0], o[dt][ps][4 * rg + 1] * rn * gm[1]); w.y = cvt_pk_bf16(o[dt][ps][4 * rg + 2] * rn * gm[2], o[dt][ps][4 * rg + 3] * rn * gm[3]);
                    *(LAS v2u*)(otile + (ps * 32 + c) * 72 + d0) = w; } }
        LDS_WAIT();
#pragma unroll
        for (int it = 0; it < 8; ++it) { const int r = it * 8 + (lane >> 3), ch = lane & 7; const v4u v = *(const LAS v4u*)(otile + r * 72 + ch * 8);
            *(v4u*)(MIX + ((size_t)chunk * 128 + ph * 64 + r) * 1024 + 512 + hd * 64 + ch * 8) = v; }
        LDS_WAIT();
        __syncthreads();
    }
}

__device__ __forceinline__ void fourier_stage2(LAS unsigned char* lds, int wave, const bf16* Tp, bf16* MIX, const float* gmix, int gw, int NGW, int lane) {
    asm volatile("" : "+v"(lane));
    LAS bf16* slab = (LAS bf16*)(lds + wave * 8448);
    const int k2 = lane & 15, kq = lane >> 4, prt = kq >> 1, s2b = (kq & 1) * 8;
    constexpr float NRM = 0.0013810679320049757f;
    for (int item = gw; item < 4096; item += NGW) {
        const int k1 = item >> 3, b = item & 7, k = k1 + 512 * k2;
        unsigned wr_[4], wi_[4];
#pragma unroll
        for (int jj = 0; jj < 4; ++jj) { float c[2], sn[2];
#pragma unroll
            for (int u = 0; u < 2; ++u) { const int n = (k * (s2b + 2 * jj + u)) & 8191; const float rev = (float)n * (1.f / 8192.f); c[u] = __builtin_amdgcn_cosf(rev); sn[u] = __builtin_amdgcn_sinf(rev); }
            wr_[jj] = prt == 0 ? cvt_pk_bf16(c[0], c[1]) : cvt_pk_bf16(sn[0], sn[1]);
            wi_[jj] = prt == 0 ? cvt_pk_bf16(sn[0], sn[1]) : cvt_pk_bf16(-c[0], -c[1]); }
        v4u t0; t0.x = wr_[0]; t0.y = wr_[1]; t0.z = wr_[2]; t0.w = wr_[3]; const bf16x8 bR = __builtin_bit_cast(bf16x8, t0);
        v4u t1; t1.x = wi_[0]; t1.y = wi_[1]; t1.z = wi_[2]; t1.w = wi_[3]; const bf16x8 bI = __builtin_bit_cast(bf16x8, t1);
        const bf16* ap = Tp + (size_t)(prt * 512 + k1) * 32768 + ((size_t)(b * 256 + k2) * 16 + s2b);
        bf16x8 af[16];
#pragma unroll
        for (int t = 0; t < 16; ++t) af[t] = *(const bf16x8*)(ap + t * 256);
        f32x4 y[16]; float ss = 0.f;
#pragma unroll
        for (int t = 0; t < 16; ++t) {
            const f32x4 z4 = {0.f, 0.f, 0.f, 0.f};
            const f32x4 aR = __builtin_amdgcn_mfma_f32_16x16x32_bf16(af[t], bR, z4, 0, 0, 0), aI = __builtin_amdgcn_mfma_f32_16x16x32_bf16(af[t], bI, z4, 0, 0, 0);
            const bool special = ((t & 3) == 0) && kq == 0;
            const float p0 = aR[0] * NRM, p1 = (special ? aR[1] : aI[1]) * NRM, p2 = aR[2] * NRM, p3 = aI[3] * NRM;
            f32x4 o; o[0] = special ? p0 : p0 + p1; o[1] = special ? p1 : p0 - p1; o[2] = p2 + p3; o[3] = p2 - p3;
            y[t] = o; ss += (o[0] * o[0] + o[1] * o[1]) + (o[2] * o[2] + o[3] * o[3]); }
        ss += __shfl_xor(ss, 16); ss += __shfl_xor(ss, 32);
        const float rn = rsqrtf(ss * (1.f / 256.f) + EPSN);
#pragma unroll
        for (int t = 0; t < 16; ++t) { const float* gb = gmix + 768 + (t >> 2) * 64; const int p = 16 * (t & 3) + 4 * kq;
            v2u w; w.x = cvt_pk_bf16(y[t][0] * rn * gb[fsig(p)], y[t][1] * rn * gb[fsig(p + 1)]); w.y = cvt_pk_bf16(y[t][2] * rn * gb[fsig(p + 2)], y[t][3] * rn * gb[fsig(p + 3)]);
            *(LAS v2u*)(slab + k2 * 264 + 16 * t + 4 * kq) = w; }
        LDS_WAIT();
#pragma unroll
        for (int it = 0; it < 8; ++it) { const int r = it * 2 + (lane >> 5), ch = lane & 31; const v4u v = *(const LAS v4u*)(slab + r * 264 + ch * 8);
            *(v4u*)(MIX + ((size_t)b * SEQ + k1 + 512 * r) * 1024 + 768 + ch * 8) = v; }
        LDS_WAIT();
    }
}
__device__ __forceinline__ void ctx_fourier_norm(bf16* MIX, const float* gmix, int gw, int NGW, int lane) {
    asm volatile("" : "+v"(lane));
    const int pg = (lane * 4) & 63, grp = lane >> 4;
    for (int row = ML + gw; row < MT; row += NGW) { bf16* p = MIX + (size_t)row * 1024 + 768 + lane * 4;
        const v2u w = *(const v2u*)p; const float a0 = bflo(w.x), b0 = bfhi(w.x), a1 = bflo(w.y), b1 = bfhi(w.y);
        const bool pass = pg == 0;
        const float v0 = pass ? a0 : a0 + b0, v1 = pass ? b0 : a0 - b0, v2 = a1 + b1, v3 = a1 - b1;
        const float rn = rsqrtf(wave_sum((v0 * v0 + v1 * v1) + (v2 * v2 + v3 * v3)) * (1.f / 256.f) + EPSN);
        const float* gb = gmix + 768 + grp * 64;
        v2u o; o.x = cvt_pk_bf16(v0 * rn * gb[fsig(pg)], v1 * rn * gb[fsig(pg + 1)]); o.y = cvt_pk_bf16(v2 * rn * gb[fsig(pg + 2)], v3 * rn * gb[fsig(pg + 3)]); *(v2u*)p = o; }
}

#define XB_TMO      128
#define XB_XCNT(j)  (256  + 64 * (j))
#define XB_XSUB(j)  (1280 + 64 * (j))
#define XB_XGEN(j)  (2304 + 64 * (j))
#define XB_TOP      3328
#define XB_TOPGEN   3392
#define XCD_BAR_WORDS 3456
#define XB_SPIN_CAP (1u << 18)

__device__ __forceinline__ unsigned xb_ld(unsigned* p)              { return __hip_atomic_load(p, __ATOMIC_RELAXED, __HIP_MEMORY_SCOPE_AGENT); }
__device__ __forceinline__ unsigned xb_add(unsigned* p, unsigned v) { return __hip_atomic_fetch_add(p, v, __ATOMIC_RELAXED, __HIP_MEMORY_SCOPE_AGENT); }
__device__ __forceinline__ unsigned xb_xcc_id() { return (unsigned)__builtin_amdgcn_s_getreg((3 << 11) | 20) & 0xFu; }
#define XB_SPIN(cond, bar) do { unsigned _sp = 0; while (cond) { __builtin_amdgcn_s_sleep(1); \
    if ((++_sp & 255u) == 0u) { if (xb_ld(&(bar)[XB_TMO])) break; if (_sp > XB_SPIN_CAP) { atomicAdd(&(bar)[XB_TMO], 1u); break; } } } } while (0)

struct XcdBarrier {
    unsigned* bar; unsigned x;
    volatile LAS unsigned* st;
};

__device__ __forceinline__ XcdBarrier xcd_barrier_post(unsigned* bar, volatile LAS unsigned* st) {
    XcdBarrier b; b.bar = bar; b.x = xb_xcc_id(); b.st = st;
    if (threadIdx.x == 0) (void)xb_add(&bar[XB_XCNT(b.x)], 1u);
    return b;
}
__device__ __forceinline__ void xcd_barrier_complete(unsigned* bar, unsigned x, unsigned& nloc, unsigned& nx) {
    const unsigned G = gridDim.x * gridDim.y * gridDim.z;
    unsigned sum, cnt, mine, sp = 0u;
    for (;;) {
        sum = 0u; cnt = 0u; mine = 0u;
#pragma unroll
        for (unsigned j = 0; j < 16; ++j) { const unsigned c = xb_ld(&bar[XB_XCNT(j)]); sum += c; cnt += (c > 0u) ? 1u : 0u; mine = (j == x) ? c : mine; }
        if (sum == G) break;
        __builtin_amdgcn_s_sleep(1);
        if ((++sp & 255u) == 0u) { if (xb_ld(&bar[XB_TMO])) break; if (sp > XB_SPIN_CAP) { atomicAdd(&bar[XB_TMO], 1u); break; } }
    }
    nloc = mine > 0u ? mine : 1u; nx = cnt > 0u ? cnt : 1u;
}

__device__ __forceinline__ void xcd_barrier(const XcdBarrier& b) {
    asm volatile("s_waitcnt vmcnt(0)" ::: "memory");
    __syncthreads();
    if (threadIdx.x == 0) {
        unsigned* bar = b.bar;
        __builtin_amdgcn_s_waitcnt(0);
        unsigned nloc = b.st[0], nx = b.st[1];
        if (nloc == 0u) { xcd_barrier_complete(bar, b.x, nloc, nx); b.st[0] = nloc; b.st[1] = nx; }
        const unsigned old = xb_add(&bar[XB_XSUB(b.x)], 1u);
        const unsigned gen = old / nloc;
        if (old + 1u == (gen + 1u) * nloc) {
            __builtin_amdgcn_fence(__ATOMIC_RELEASE, "agent");
            asm volatile("s_waitcnt vmcnt(0)" ::: "memory");
            const unsigned og = xb_add(&bar[XB_TOP], 1u);
            const unsigned tg = og / nx;
            if (og + 1u == (tg + 1u) * nx) xb_add(&bar[XB_TOPGEN], 1u);
            else XB_SPIN(xb_ld(&bar[XB_TOPGEN]) == tg, bar);
            __builtin_amdgcn_fence(__ATOMIC_ACQUIRE, "agent");
            xb_add(&bar[XB_XGEN(b.x)], 1u);
            asm volatile("s_waitcnt vmcnt(0)" ::: "memory");
        } else {
            XB_SPIN(xb_ld(&bar[XB_XGEN(b.x)]) == gen, bar);
            __builtin_amdgcn_fence(__ATOMIC_ACQUIRE, "agent");
            asm volatile("s_waitcnt vmcnt(0)" ::: "memory");
        }
    }
    __syncthreads();
}

__global__ void __launch_bounds__(512, 2) fwd_megakernel(Args a) {
    extern __shared__ __attribute__((aligned(16))) unsigned char lds_raw[];
    LAS unsigned char* lds = (LAS unsigned char*)lds_raw;
    cg::grid_group grid = cg::this_grid();
#define GSYNC() do { XcdBarrier xb_; xb_.bar = (unsigned*)(ws + WS_BAR); xb_.x = xb_xcc_id(); xb_.st = (volatile LAS unsigned*)(lds + LDS_BARST); xcd_barrier(xb_); } while (0)
    const int tid = threadIdx.x, lane = tid & 63, wave = __builtin_amdgcn_readfirstlane(tid >> 6);
    const int bid = blockIdx.x, G = gridDim.x;
    const int gw = bid * 8 + wave, NGW = G * 8;
    unsigned char* ws = a.ws;
    const float* MOD = (const float*)(ws + WS_MOD);
    bf16* HX = (bf16*)(ws + WS_HX); bf16* YB = (bf16*)(ws + WS_XR);
    float* X1C = (float*)(ws + WS_XR + 132 * MiB) - (size_t)ML * DM;
    bf16* MIX = (bf16*)(ws + WS_MIX);
    if (bid == 0) { for (int i = tid; i < XCD_BAR_WORDS; i += 512) __hip_atomic_store((unsigned*)(ws + WS_BAR) + i, 0u, __ATOMIC_RELAXED, __HIP_MEMORY_SCOPE_AGENT); }

#ifndef SKIP_P0
    p0_prologue(a, lds, bid, G, tid);
#endif
    __syncthreads();
    if (tid < 2) ((volatile LAS unsigned*)(lds + LDS_BARST))[tid] = 0u;
    grid.sync();
    (void)xcd_barrier_post((unsigned*)(ws + WS_BAR), (volatile LAS unsigned*)(lds + LDS_BARST));
    __syncthreads();
    for (int row = gw * 4; row < MT; row += NGW * 4) {
        const int mr = row < ML ? row >> 13 : 8; const float* md = MOD + (size_t)mr * 6144;
        const float* xin = row < ML ? a.in[0] + (size_t)row * DM : a.in[2] + (size_t)(row - ML) * DM;
#ifdef PROBE_ROWS
        row_op<4>(xin, nullptr, nullptr, nullptr, nullptr, (bf16*)(ws + WS_C) + (size_t)row * DM, a.in[6], md + 1024, md, lane);
#endif
        row_op<4>(xin, nullptr, nullptr, nullptr, nullptr, HX + (size_t)row * DM, a.in[6], md + 1024, md, lane);
    }
    GSYNC();
#pragma unroll 1
    for (int l = 0; l < 2; ++l) {
        const bool last = l == 1;
        const int MR = last ? ML : MT;
        const float* modl = MOD + (size_t)l * 9 * 6144;
#ifndef SKIP_G1
        {
            int fM = MT, fN = NIN, fK = DM; asm volatile("" : "+s"(fM), "+s"(fN), "+s"(fK));
            pg8::Gemm g{HX, (const bf16*)(ws + WS_WIN) + (size_t)l * NIN * 1024, fM, fN, fK}; pg8::StaticOrder S; S.init(fM, fN, G, bid);
            EpiIn E{ws, last ? 1 : 0};
            pg8::gemm_phase<EpiIn, pg8::StaticOrder, true, true>(lds, g, S, E);
        }
#endif
        GSYNC();
        const float* gmixl = a.in[12] + l * 1024;
        attn_units(lds, (const bf16*)(ws + WS_QB), (const bf16*)(ws + WS_KB), (const bf16*)(ws + WS_VT), (const bf16*)(ws + WS_VTC), MIX, a.in[8] + l * 8, gmixl, last ? 1024 : 1056, G, bid, tid);
        sgu_units(lds, (const bf16*)(ws + WS_UB), (const bf16*)(ws + WS_GVT), (const bf16*)(ws + WS_GVTC), MIX, a.in[9] + (size_t)l * 4 * 128 * 128, a.in[10] + l * 512, a.in[11] + l * 256, gmixl,
                  last ? 512 : 528, G, (bid + 224) % G, tid);
        __syncthreads();
#ifndef SKIP_F1
        {
            int fM = 1024, fN = 32768, fK = 512; asm volatile("" : "+s"(fM), "+s"(fN), "+s"(fK));
            pg8::Gemm g{(const bf16*)(ws + WS_DFT512), (const bf16*)(ws + WS_GT), fM, fN, fK}; pg8::StaticOrder S; S.init(fM, fN, G, bid);
            pg8::EpiPlain<0, false> E{(bf16*)(ws + WS_TP), fN, 1.f};
            pg8::gemm_phase<pg8::EpiPlain<0, false>, pg8::StaticOrder, true, true>(lds, g, S, E);
        }
#endif
#ifndef SKIP_CF
        if (!last) {
            int fM = 256, fN = 2048, fK = 512, fL = 1024; asm volatile("" : "+s"(fM), "+s"(fN), "+s"(fK), "+s"(fL));
            pg8::Gemm g{(const bf16*)(ws + WS_DFT256), (const bf16*)(ws + WS_GTC), fM, fN, fK}; pg8::StaticOrder S; S.init(fM, fN, G, (bid + 208) % G);
            pg8::EpiPlain<0, true> E{MIX + (size_t)ML * 1024 + 768, fL, 0.0078125f};
            pg8::gemm_phase<pg8::EpiPlain<0, true>, pg8::StaticOrder, true, true>(lds, g, S, E);
        }
#endif
        GSYNC();
        fourier_stage2(lds, wave, (const bf16*)(ws + WS_TP), MIX, gmixl, gw, NGW, lane);
        if (!last) ctx_fourier_norm(MIX, gmixl, gw, NGW, lane);
        GSYNC();
#ifndef SKIP_G2
        {
            pg8::Gemm g{MIX, (const bf16*)(ws + WS_WOUT) + (size_t)l * 1024 * 1024, ML, DM, DM, 0}; pg8::StaticOrder S; S.init(ML, DM, G, bid);
            pg8::EpiPlain<0, false> E{YB, DM, 1.f};
            pg8::gemm_phase<pg8::EpiPlain<0, false>, pg8::StaticOrder, true, true>(lds, g, S, E);
        }
        if (!last) {
            int fK = 256, fL = DM; asm volatile("" : "+s"(fK), "+s"(fL));
            pg8::Gemm g{MIX, (const bf16*)(ws + WS_WOUT) + (size_t)l * 1024 * 1024, MT, DM, fK, fL}; pg8::SplitKOrder S{G, bid, 256, 8, 4, 4, fK * 2};
            pg8::EpiPart E{(float*)(ws + WS_PART), fL, fK * 2, 256, (size_t)2048 * 1024};
            pg8::gemm_phase<pg8::EpiPart, pg8::SplitKOrder, true, true>(lds, g, S, E);
        }
#endif
        GSYNC();
        for (int row = gw * 4; row < ML; row += NGW * 4) {
            const float* md = modl + (size_t)(row >> 13) * 6144;
            const float* xin = l == 0 ? a.in[0] + (size_t)row * DM : a.out + (size_t)row * DM;
            row_op<4>(xin, YB + (size_t)row * DM, md + 2048, a.in[14] + l * 1024, nullptr, HX + (size_t)row * DM, a.in[15] + l * 1024, md + 4096, md + 3072, lane);
        }
        if (!last) for (int row = ML + gw * 2; row < MT; row += NGW * 2) {
            const float* md = modl + (size_t)8 * 6144;
            row_op<2, 4>(a.in[2] + (size_t)(row - ML) * DM, (const bf16*)((const float*)(ws + WS_PART) + (size_t)(row - ML) * DM), md + 2048, a.in[14] + l * 1024, X1C + (size_t)row * DM, HX + (size_t)row * DM, a.in[15] + l * 1024, md + 4096, md + 3072, lane);
        }
        GSYNC();
#ifndef SKIP_G3
        {
            pg8::Gemm g{HX, (const bf16*)(ws + WS_WFF1) + (size_t)l * 4096 * 1024, MR, DFF, DM}; pg8::StaticOrder S; S.init(MR, DFF, G, bid);
            pg8::EpiPlain<1, false> E{(bf16*)(ws + WS_H1), DFF, 1.f};
            pg8::gemm_phase<pg8::EpiPlain<1, false>, pg8::StaticOrder, true, true>(lds, g, S, E);
        }
#endif
        GSYNC();
#ifndef SKIP_G4
        {
            pg8::Gemm g{(const bf16*)(ws + WS_H1), (const bf16*)(ws + WS_WFF2) + (size_t)l * 1024 * 4096, ML, DM, DFF, 0}; pg8::StaticOrder S; S.init(ML, DM, G, bid);
            pg8::EpiPlain<0, false> E{HX, DM, 1.f};
            pg8::gemm_phase<pg8::EpiPlain<0, false>, pg8::StaticOrder, true, true>(lds, g, S, E);
        }
        if (!last) {
            int fK = 1024, fL = DFF, fC = DM; asm volatile("" : "+s"(fK), "+s"(fL), "+s"(fC));
            pg8::Gemm g{(const bf16*)(ws + WS_H1), (const bf16*)(ws + WS_WFF2) + (size_t)l * 1024 * 4096, MT, DM, fK, fL}; pg8::SplitKOrder S{G, bid, 256, 8, 4, 4, fK * 2};
            pg8::EpiPart E{(float*)(ws + WS_PART), fC, fK * 2, 256, (size_t)2048 * 1024};
            pg8::gemm_phase<pg8::EpiPart, pg8::SplitKOrder, true, true>(lds, g, S, E);
        }
#endif
        GSYNC();
        for (int row = gw * 4; row < ML; row += NGW * 4) {
            const int mr = row >> 13; const float* md = modl + (size_t)mr * 6144;
            const float* xin = l == 0 ? a.in[0] + (size_t)row * DM : a.out + (size_t)row * DM;
            if (!last) { const float* mdn = MOD + (size_t)(9 + mr) * 6144;
                row_op<4>(xin, YB + (size_t)row * DM, md + 2048, a.in[14] + l * 1024, a.out + (size_t)row * DM, HX + (size_t)row * DM, a.in[6] + 1024, mdn + 1024, mdn, lane,
                          HX + (size_t)row * DM, md + 5120, a.in[18] + l * 1024);
            } else row_op<4>(xin, YB + (size_t)row * DM, md + 2048, a.in[14] + l * 1024, a.out + (size_t)row * DM, nullptr, nullptr, nullptr, nullptr, lane,
                             HX + (size_t)row * DM, md + 5120, a.in[18] + l * 1024);
        }
        if (!last) for (int row = ML + gw * 2; row < MT; row += NGW * 2) {
            const float* md = modl + (size_t)8 * 6144; const float* mdn = MOD + (size_t)(9 + 8) * 6144;
            row_op<2, 4>(X1C + (size_t)row * DM, (const bf16*)((const float*)(ws + WS_PART) + (size_t)(row - ML) * DM), md + 5120, a.in[18] + l * 1024, nullptr, HX + (size_t)row * DM, a.in[6] + 1024, mdn + 1024, mdn, lane);
        }
        if (!last) GSYNC();
    }
}

extern "C" void kernel_launch(void* const* d_in, const int* in_sizes, int n_in, void* d_out, int out_size, void* d_ws, size_t ws_size, hipStream_t stream) {
    static int grid = 0;
    if (grid == 0) {
        if (n_in != 19 || ws_size < WS_TOTAL) { fprintf(stderr, "kernel_launch: unexpected n_in %d / ws %zu\n", n_in, ws_size); grid = -1; return; }
        int dev = 0, cus = 0, per_cu = 0;
        hipGetDevice(&dev);
        hipDeviceGetAttribute(&cus, hipDeviceAttributeMultiprocessorCount, dev);
        hipFuncSetAttribute((const void*)fwd_megakernel, hipFuncAttributeMaxDynamicSharedMemorySize, LDS_BYTES);
        hipOccupancyMaxActiveBlocksPerMultiprocessor(&per_cu, (const void*)fwd_megakernel, 512, LDS_BYTES);
        if (per_cu < 1) per_cu = 1;
        grid = cus * per_cu;
        (void)hipGetLastError();
    }
    if (grid < 0) return;
    Args a{};
    for (int i = 0; i < 19; ++i) a.in[i] = (const float*)d_in[i];
    a.out = (float*)d_out; a.ws = (unsigned char*)d_ws;
    void* args[] = {&a};
    hipError_t e = hipLaunchCooperativeKernel((const void*)fwd_megakernel, dim3(grid), dim3(512), args, LDS_BYTES, stream);
    if (e != hipSuccess) fprintf(stderr, "cooperative launch failed: %s (grid %d)\n", hipGetErrorString(e), grid);
}
```

```cpp
#include <hip/hip_runtime.h>
#include <hip/hip_cooperative_groups.h>
#include <cstdio>
#include <cstdint>
namespace cg = cooperative_groups;
namespace pg8 {
#define PG8_LAS __attribute__((address_space(3)))
typedef unsigned short bf16_t;
typedef short bf16x8 __attribute__((ext_vector_type(8)));
typedef float f32x4 __attribute__((ext_vector_type(4)));
typedef unsigned u32x4 __attribute__((ext_vector_type(4)));
constexpr int BM = 256, BK = 64, HALF = 128, HTB = HALF * BK * 2  , STAGE_BYTES = 8 * HTB, NXCD = 8, WGM = 8;

__host__ __device__ __forceinline__ int lds_byte(int r, int c) { const int st = (r >> 4) * 2 + (c >> 5), rr = r & 15, cc = c & 31, ob = rr * 64 + cc * 2; return st * 1024 + (ob ^ (((ob >> 9) & 1) << 5)); }
__host__ __device__ __forceinline__ void stage_rc(int b, int& R, int& C) { const int st = b / 1024, sb = b % 1024, swz = sb ^ (((sb >> 9) & 1) << 5); R = (st >> 1) * 16 + swz / 64; C = (st & 1) * 32 + (swz % 64) / 2; }
__host__ __device__ __forceinline__ int perm32(int rho) { const int n = rho >> 4, i = rho & 15; return 8 * (i >> 2) + 4 * n + (i & 3); }

struct Unit { int pm, pn, ko; };
struct Gemm { const bf16_t* A; const bf16_t* Bt; int M, N, K, ld; };

struct StaticOrder {
    int nM, nN, nwg, G, c;
    __host__ __device__ void init(int M, int N, int G_, int c_) { nM = M / BM; nN = N / BM; nwg = nM * nN; G = G_; c = c_; }
    __host__ __device__ bool next(int i, Unit& u) const {
        const long L = (long)i * G + c; if (L >= nwg) return false;
        int wgid = (int)L; { const int q = nwg / NXCD, r = nwg % NXCD, xcd = wgid % NXCD, off = wgid / NXCD; wgid = (xcd < r ? xcd * (q + 1) : r * (q + 1) + (xcd - r) * q) + off; }
        const int nig = WGM * nN, gid = wgid / nig, fm = gid * WGM, gsz = (nM - fm) < WGM ? (nM - fm) : WGM;
        u.pm = fm + ((wgid % nig) % gsz); u.pn = (wgid % nig) / gsz; u.ko = 0; return true;
    }
    __device__ __forceinline__ void a_ready(const Unit&) const {}
    __device__ __forceinline__ void done(const Unit&) const {}
};

__device__ __forceinline__ unsigned cvt_pk_bf16(float lo, float hi) { unsigned r; asm volatile("v_cvt_pk_bf16_f32 %0, %1, %2" : "=v"(r) : "v"(lo), "v"(hi)); return r; }
typedef float f32x2 __attribute__((ext_vector_type(2)));
typedef unsigned u32x2 __attribute__((ext_vector_type(2)));
__device__ __forceinline__ unsigned short f2bf1(float f) { return (unsigned short)(cvt_pk_bf16(f, 0.f) & 0xffffu); }
__device__ __forceinline__ float gelu_tanh(float x) {
    const float u = 0.7978845608f * (x + 0.044715f * x * x * x);
    return x * __builtin_amdgcn_rcpf(1.0f + __builtin_amdgcn_exp2f(-2.885390082f * u));
}
template <int ACT, bool REMAP> struct EpiPlain {
    static constexpr bool PERM = true, AFTER_DRAIN = false;
    bf16_t* O; int ldc; float scale;
    __device__ __forceinline__ void operator()(const f32x4 (&acc)[2][2][4][2], const Unit& u, int wr, int wc, int fr, int fq) const {
        asm volatile("" : "+v"(fr), "+v"(fq));
        const int row0 = (REMAP ? u.pn * BM : u.pm * BM) + wr * 64 + fr; const int col0 = (REMAP ? 0 : u.pn * BM) + wc * 32 + 8 * fq;
#pragma unroll
        for (int ai = 0; ai < 2; ++ai)
#pragma unroll
            for (int m = 0; m < 4; ++m) { bf16_t* rowp = O + (size_t)(row0 + ai * HALF + m * 16) * ldc + col0;
#pragma unroll
                for (int bj = 0; bj < 2; ++bj) { f32x4 v0 = acc[ai][bj][m][0], v1 = acc[ai][bj][m][1];
                    if (ACT == 1) {
#pragma unroll
                        for (int j = 0; j < 4; ++j) { float a = fmaxf(v0[j], 0.f), b = fmaxf(v1[j], 0.f); v0[j] = a * a; v1[j] = b * b; } }
                    v0 = v0 * scale; v1 = v1 * scale;
                    u32x4 w; w.x = cvt_pk_bf16(v0[0], v0[1]); w.y = cvt_pk_bf16(v0[2], v0[3]); w.z = cvt_pk_bf16(v1[0], v1[1]); w.w = cvt_pk_bf16(v1[2], v1[3]);
                    *(u32x4*)(rowp + bj * HALF) = w; } }
    }
};

struct SplitKOrder {
    int G, c, pm0, npm, npn, nks, ksub_bytes;
    __device__ bool next(int i, Unit& u) const {
        const int L = i * G + c; if (L >= npm * npn * nks) return false;
        u.ko = (L % nks) * ksub_bytes; const int t = L / nks; u.pn = t % npn; u.pm = pm0 + t / npn; return true;
    }
    __device__ __forceinline__ void a_ready(const Unit&) const {}
    __device__ __forceinline__ void done(const Unit&) const {}
};
struct EpiPart {
    static constexpr bool PERM = true, AFTER_DRAIN = false;
    float* P; int ldc, ksub_bytes, pm0; size_t slice;
    __device__ __forceinline__ void operator()(const f32x4 (&acc)[2][2][4][2], const Unit& u, int wr, int wc, int fr, int fq) const {
        asm volatile("" : "+v"(fr), "+v"(fq));
        float* base = P + (size_t)(u.ko / ksub_bytes) * slice;
        const int row0 = (u.pm - pm0) * BM + wr * 64 + fr, col0 = u.pn * BM + wc * 32 + 8 * fq;
#pragma unroll
        for (int ai = 0; ai < 2; ++ai)
#pragma unroll
            for (int m = 0; m < 4; ++m) { float* rowp = base + (size_t)(row0 + ai * HALF + m * 16) * ldc + col0;
#pragma unroll
                for (int bj = 0; bj < 2; ++bj) { *(f32x4*)(rowp + bj * HALF) = acc[ai][bj][m][0]; *(f32x4*)(rowp + bj * HALF + 4) = acc[ai][bj][m][1]; } }
    }
};
template <class Epi, class Sched, bool ALIGN_EPI = false, bool SP2 = false>
__device__ __forceinline__ void gemm_phase(PG8_LAS unsigned char* lds, const Gemm g, const Sched& S, const Epi& E) {
    int tid_l = threadIdx.x; asm volatile("" : "+v"(tid_l));
    const int tid = tid_l, wid = __builtin_amdgcn_readfirstlane(tid >> 6), lane = tid & 63, wr = wid >> 2, wc = wid & 3, fr = lane & 15, fq = lane >> 4;
    const int K = g.K, LD = g.ld ? g.ld : g.K, nt = K / BK;
    unsigned voffA[2], voffB[2];
#pragma unroll
    for (int i = 0; i < 2; ++i) { int R, C; stage_rc(tid * 16 + i * 8192, R, C); const int Rb = Epi::PERM ? ((R & ~31) + perm32(R & 31)) : R;
        voffA[i] = (unsigned)(R * LD + C) * 2u; voffB[i] = (unsigned)(Rb * LD + C) * 2u; }
    const size_t kstep = (size_t)(BK * 2);
    const size_t hstep = (size_t)HALF * LD * 2;
    const size_t tstep = 2 * hstep;
    const unsigned ldsw = (unsigned)wid * 1024u;
    const int aoff = lds_byte(wr * 64 + fr, fq * 8), boff = lds_byte(wc * 32 + fr, fq * 8);
#define PG8_SA(b, h) (((b) * 2 + (h)) * HTB)
#define PG8_SB(b, h) ((4 + (b) * 2 + (h)) * HTB)
#define PG8_STAGE(bufoff, gbase, voff) do { _Pragma("unroll") for (int _i = 0; _i < 2; ++_i) \
        __builtin_amdgcn_global_load_lds((const unsigned*)((const char*)(gbase) + (voff)[_i]), (PG8_LAS unsigned*)(lds + (bufoff) + ldsw + _i * 8192), 16, 0, 0); } while (0)
#define PG8_LDA(dst, b, h) do { _Pragma("unroll") for (int m = 0; m < 4; ++m) _Pragma("unroll") for (int k = 0; k < 2; ++k) dst[m][k] = *(const PG8_LAS bf16x8*)(lds + PG8_SA(b, h) + aoff + m * 2048 + k * 1024); } while (0)
#define PG8_LDB(dst, b, h) do { _Pragma("unroll") for (int n = 0; n < 2; ++n) _Pragma("unroll") for (int k = 0; k < 2; ++k) dst[n][k] = *(const PG8_LAS bf16x8*)(lds + PG8_SB(b, h) + boff + n * 2048 + k * 1024); } while (0)
#define PG8_MMA(ai, bj, At, Bt) do { __builtin_amdgcn_s_setprio(1); _Pragma("unroll") for (int m = 0; m < 4; ++m) _Pragma("unroll") for (int n = 0; n < 2; ++n) _Pragma("unroll") for (int k = 0; k < 2; ++k) \
        acc[ai][bj][m][n] = __builtin_amdgcn_mfma_f32_16x16x32_bf16(Bt[n][k], At[m][k], acc[ai][bj][m][n], 0, 0, 0); __builtin_amdgcn_s_setprio(0); } while (0)
#define PG8_WAIT_V(n) asm volatile("s_waitcnt vmcnt(" #n ")" ::: "memory")
#define PG8_WAIT_L(n) asm volatile("s_waitcnt lgkmcnt(" #n ")" ::: "memory")
#define PG8_BAR __builtin_amdgcn_s_barrier()
#define PG8_SCHED __builtin_amdgcn_sched_barrier(0)
    Unit cur, nxt; int ui = 0;
    if (!S.next(0, cur)) return;
    f32x4 acc[2][2][4][2];
#pragma unroll
    for (int a = 0; a < 2; ++a)
#pragma unroll
        for (int b = 0; b < 2; ++b)
#pragma unroll
            for (int m = 0; m < 4; ++m)
#pragma unroll
                for (int n = 0; n < 2; ++n) acc[a][b][m][n] = (f32x4){0.f, 0.f, 0.f, 0.f};
    bf16x8 At[4][2], B0[2][2], B1[2][2];
    const char* cA = (const char*)g.A + (size_t)cur.pm * tstep + cur.ko; const char* cB = (const char*)g.Bt + (size_t)cur.pn * tstep + cur.ko;
    S.a_ready(cur);
    if constexpr (SP2) {
        PG8_STAGE(PG8_SB(0, 0), cB, voffB); PG8_STAGE(PG8_SB(0, 1), cB + hstep, voffB); PG8_STAGE(PG8_SA(0, 0), cA, voffA); PG8_STAGE(PG8_SA(0, 1), cA + hstep, voffA);
        if (wr == 1) PG8_BAR;
        PG8_WAIT_V(2); PG8_BAR;
        PG8_STAGE(PG8_SB(1, 0), cB + kstep, voffB); PG8_STAGE(PG8_SA(1, 0), cA + kstep, voffA); PG8_STAGE(PG8_SB(1, 1), cB + hstep + kstep, voffB);
        PG8_WAIT_V(6); PG8_BAR;
    } else {
        PG8_STAGE(PG8_SB(0, 0), cB, voffB); PG8_STAGE(PG8_SA(0, 0), cA, voffA); PG8_STAGE(PG8_SB(0, 1), cB + hstep, voffB); PG8_STAGE(PG8_SA(0, 1), cA + hstep, voffA);
        if (wr == 1) PG8_BAR;
        PG8_WAIT_V(4); PG8_BAR;
        PG8_STAGE(PG8_SB(1, 0), cB + kstep, voffB); PG8_STAGE(PG8_SA(1, 0), cA + kstep, voffA); PG8_STAGE(PG8_SB(1, 1), cB + hstep + kstep, voffB);
        PG8_WAIT_V(6); PG8_BAR;
    }
    for (;;) {
        const bool has_next = S.next(ui + 1, nxt);
        const char* nA = has_next ? (const char*)g.A + (size_t)nxt.pm * tstep + nxt.ko : cA; const char* nB = has_next ? (const char*)g.Bt + (size_t)nxt.pn * tstep + nxt.ko : cB;
        for (int t = 0; t < nt; t += 2) {
            const bool last = (t == nt - 2);
            const char* a1 = cA + (size_t)(t + 1) * kstep;
            const char* a2 = last ? nA : cA + (size_t)(t + 2) * kstep; const char* b2 = last ? nB : cB + (size_t)(t + 2) * kstep;
            const char* a3 = a2 + kstep; const char* b3 = b2 + kstep;
            if (last && has_next) S.a_ready(nxt);
            if constexpr (SP2) {
            PG8_LDB(B0, 0, 0); PG8_LDB(B1, 0, 1); PG8_SCHED; PG8_LDA(At, 0, 0); PG8_STAGE(PG8_SA(1, 1), a1 + hstep, voffA);
            PG8_WAIT_V(8); PG8_WAIT_L(0); PG8_BAR; PG8_MMA(0, 0, At, B0); PG8_MMA(0, 1, At, B1); PG8_BAR; PG8_SCHED;
            PG8_LDA(At, 0, 1); PG8_STAGE(PG8_SB(0, 0), b2, voffB); PG8_STAGE(PG8_SB(0, 1), b2 + hstep, voffB); PG8_STAGE(PG8_SA(0, 0), a2, voffA);
            PG8_WAIT_V(8); PG8_WAIT_L(0); PG8_BAR; PG8_MMA(1, 0, At, B0); PG8_MMA(1, 1, At, B1); PG8_BAR; PG8_SCHED;
            PG8_LDB(B0, 1, 0); PG8_LDB(B1, 1, 1); PG8_SCHED; PG8_LDA(At, 1, 0); PG8_STAGE(PG8_SA(0, 1), a2 + hstep, voffA);
            PG8_WAIT_V(8); PG8_WAIT_L(0); PG8_BAR; PG8_MMA(0, 0, At, B0); PG8_MMA(0, 1, At, B1); PG8_BAR; PG8_SCHED;
            PG8_LDA(At, 1, 1); PG8_STAGE(PG8_SB(1, 0), b3, voffB); PG8_STAGE(PG8_SB(1, 1), b3 + hstep, voffB); PG8_STAGE(PG8_SA(1, 0), a3, voffA);
            PG8_WAIT_V(8); PG8_WAIT_L(0); PG8_BAR; PG8_MMA(1, 0, At, B0); PG8_MMA(1, 1, At, B1); PG8_BAR; PG8_SCHED;
            } else {
            PG8_LDB(B0, 0, 0); PG8_SCHED; PG8_LDA(At, 0, 0); PG8_STAGE(PG8_SA(1, 1), a1 + hstep, voffA);
            PG8_WAIT_L(8); PG8_BAR; PG8_WAIT_L(0); PG8_MMA(0, 0, At, B0); PG8_BAR; PG8_SCHED;
            PG8_LDB(B1, 0, 1); PG8_STAGE(PG8_SB(0, 0), b2, voffB);
            PG8_BAR; PG8_WAIT_L(0); PG8_MMA(0, 1, At, B1); PG8_BAR;
            PG8_LDA(At, 0, 1); PG8_STAGE(PG8_SA(0, 0), a2, voffA);
            PG8_BAR; PG8_WAIT_L(0); PG8_MMA(1, 0, At, B0); PG8_BAR; PG8_SCHED;
            PG8_STAGE(PG8_SB(0, 1), b2 + hstep, voffB);
            PG8_WAIT_V(6); PG8_BAR; PG8_MMA(1, 1, At, B1); PG8_BAR;
            PG8_LDB(B0, 1, 0); PG8_SCHED; PG8_LDA(At, 1, 0); PG8_STAGE(PG8_SA(0, 1), a2 + hstep, voffA);
            PG8_WAIT_L(8); PG8_BAR; PG8_WAIT_L(0); PG8_MMA(0, 0, At, B0); PG8_BAR; PG8_SCHED;
            PG8_LDB(B1, 1, 1); PG8_STAGE(PG8_SB(1, 0), b3, voffB);
            PG8_BAR; PG8_WAIT_L(0); PG8_MMA(0, 1, At, B1); PG8_BAR;
            PG8_LDA(At, 1, 1); PG8_STAGE(PG8_SA(1, 0), a3, voffA);
            PG8_BAR; PG8_WAIT_L(0); PG8_MMA(1, 0, At, B0); PG8_BAR; PG8_SCHED;
            PG8_STAGE(PG8_SB(1, 1), b3 + hstep, voffB);
            PG8_WAIT_V(6); PG8_BAR; PG8_MMA(1, 1, At, B1); PG8_BAR;
            }
        }
        if constexpr (ALIGN_EPI) { if (wr == 0) PG8_BAR; }
        if constexpr (!Epi::AFTER_DRAIN) { E(acc, cur, wr, wc, fr, fq); S.done(cur); }
        if (!has_next) break;
#pragma unroll
        for (int a = 0; a < 2; ++a)
#pragma unroll
            for (int b = 0; b < 2; ++b)
#pragma unroll
                for (int m = 0; m < 4; ++m)
#pragma unroll
                    for (int n = 0; n < 2; ++n) acc[a][b][m][n] = (f32x4){0.f, 0.f, 0.f, 0.f};
        cur = nxt; cA = nA; cB = nB; ++ui;
        if constexpr (ALIGN_EPI) { if (wr == 1) PG8_BAR; }
    }
    PG8_WAIT_V(0);
    if constexpr (!ALIGN_EPI) { if (wr == 0) PG8_BAR; }
    PG8_BAR;
    if constexpr (Epi::AFTER_DRAIN) { E.fused(acc, cur, wr, wc, fr, fq, lds, wid, lane); S.done(cur); }
#undef PG8_SA
#undef PG8_SB
#undef PG8_STAGE
#undef PG8_LDA
#undef PG8_LDB
#undef PG8_MMA
#undef PG8_WAIT_V
#undef PG8_WAIT_L
#undef PG8_BAR
#undef PG8_SCHED
}
}

#define LAS __attribute__((address_space(3)))
typedef unsigned short bf16;
typedef short bf16x8 __attribute__((ext_vector_type(8)));
typedef float f32x4 __attribute__((ext_vector_type(4)));
typedef float f32x16 __attribute__((ext_vector_type(16)));
typedef unsigned v4u __attribute__((ext_vector_type(4)));
typedef unsigned v2u __attribute__((ext_vector_type(2)));
using pg8::cvt_pk_bf16;

constexpr int NB = 8, SEQ = 8192, DM = 1024, CTXL = 256, DFF = 4096, NIN = 1536;
constexpr int ML = NB * SEQ;
constexpr int MT = ML + NB * CTXL;
constexpr float EPSN = 1e-6f;
constexpr float LOG2E = 1.4426950408889634f;
constexpr float QSCALE = 0.125f * 1.4426950408889634f;
constexpr size_t MiB = 1u << 20;
constexpr size_t WS_WIN = 0;
constexpr size_t WS_WOUT = 7 * MiB;
constexpr size_t WS_WFF1 = 11 * MiB;
constexpr size_t WS_WFF2 = 27 * MiB;
constexpr size_t WS_DFT512 = 43 * MiB;
constexpr size_t WS_DFT256 = 45 * MiB;
constexpr size_t WS_TW = 45 * MiB + 256 * 1024;
constexpr size_t WS_ROPEC = WS_TW + 64 * 1024;
constexpr size_t WS_ROPES = WS_ROPEC + 8 * 1024;
constexpr size_t WS_MOD = 46 * MiB;
constexpr size_t WS_HX = 48 * MiB;
constexpr size_t WS_XR = WS_HX + 132 * MiB;
constexpr size_t WS_C = WS_XR + 264 * MiB;
constexpr size_t WS_H1 = WS_C;
constexpr size_t WS_QB = WS_C;
constexpr size_t WS_KB = WS_QB + 66 * MiB;
constexpr size_t WS_VT = WS_KB + 17 * MiB;
constexpr size_t WS_VTC = WS_VT + 16 * MiB;
constexpr size_t WS_UB = WS_VTC + 1 * MiB;
constexpr size_t WS_GVT = WS_UB + 33 * MiB;
constexpr size_t WS_GVTC = WS_GVT + 32 * MiB;
constexpr size_t WS_GT = WS_GVTC + 1 * MiB;
constexpr size_t WS_GTC = WS_GT + 64 * MiB;
constexpr size_t WS_TP = WS_GTC + 2 * MiB;
constexpr size_t WS_MIX = WS_TP + 64 * MiB;
constexpr size_t WS_END = WS_C + 528 * MiB;
static_assert(WS_MIX + 132 * MiB <= WS_END, "overlay region");
constexpr size_t WS_PART = WS_END;
constexpr size_t WS_TOTAL = WS_PART + 32 * MiB;
static_assert(WS_TOTAL <= 1024 * MiB, "workspace");
constexpr int LDS_BYTES = 147456;
constexpr size_t WS_BAR = 46 * MiB + 512 * 1024;
constexpr int LDS_BARST = LDS_BYTES - 64;

__device__ __forceinline__ float bf2f(unsigned short h) { return __builtin_bit_cast(float, (unsigned)h << 16); }
__device__ __forceinline__ float bflo(unsigned w) { return __builtin_bit_cast(float, w << 16); }
__device__ __forceinline__ float bfhi(unsigned w) { return __builtin_bit_cast(float, w & 0xffff0000u); }
__device__ __forceinline__ float wave_sum(float v) {
#pragma unroll
    for (int o = 1; o < 64; o <<= 1) v += __shfl_xor(v, o);
    return v;
}
#define LDS_WAIT() asm volatile("s_waitcnt lgkmcnt(0)" ::: "memory")
__host__ __device__ __forceinline__ int fsig(int p) { return (p & 1) ? ((p == 1) ? 32 : 64 - (p >> 1)) : (p >> 1); }

struct Args { const float* in[19]; float* out; unsigned char* ws; };

struct EpiIn {
    static constexpr bool PERM = true, AFTER_DRAIN = false;
    unsigned char* wsb; int last;
    __device__ __forceinline__ void operator()(const pg8::f32x4 (&acc)[2][2][4][2], const pg8::Unit& u, int wr, int wc, int fr, int fq) const {
        using namespace pg8;
        asm volatile("" : "+v"(fr), "+v"(fq));
        unsigned char* ws = wsb; asm volatile("" : "+s"(ws));
        bf16_t* const QB = (bf16_t*)(ws + WS_QB); bf16_t* const KB = (bf16_t*)(ws + WS_KB); bf16_t* const VT = (bf16_t*)(ws + WS_VT); bf16_t* const VTc = (bf16_t*)(ws + WS_VTC);
        bf16_t* const UB = (bf16_t*)(ws + WS_UB); bf16_t* const GVT = (bf16_t*)(ws + WS_GVT); bf16_t* const GVTc = (bf16_t*)(ws + WS_GVTC); bf16_t* const GT = (bf16_t*)(ws + WS_GT); bf16_t* const GTc = (bf16_t*)(ws + WS_GTC);
        const float* const ropeC = (const float*)(ws + WS_ROPEC); const float* const ropeS = (const float*)(ws + WS_ROPES);
        const int pm = u.pm, pn = u.pn; const bool isctx = pm >= 256;
        if (isctx && last && pn != 2) return;
        const int b = isctx ? pm - 256 : pm >> 5;
        const int sbase = (isctx ? 0 : (pm & 31) * 256) + wr * 64 + fr;
        const size_t grow0 = (size_t)pm * 256 + wr * 64 + fr;
        const int c8 = wc * 32 + 8 * fq;
        if (pn <= 2) {
#pragma unroll
            for (int bj = 0; bj < 2; ++bj) {
                if (pn == 2 && bj == 1) {
                    bf16_t* base = isctx ? VTc + (size_t)b * 128 * 256 : VT + (size_t)b * 128 * 8192; const int ld = isctx ? 256 : 8192;
#pragma unroll
                    for (int ai = 0; ai < 2; ++ai)
#pragma unroll
                        for (int m = 0; m < 4; ++m) { const int s = sbase + ai * HALF + m * 16;
#pragma unroll
                            for (int n = 0; n < 2; ++n)
#pragma unroll
                                for (int j = 0; j < 4; ++j) base[(size_t)(c8 + 4 * n + j) * ld + s] = f2bf1(acc[ai][1][m][n][j]); asm volatile("" ::: "memory"); }
                } else {
                    const int i0 = 8 * (fq & 1); const bool odd = (wc & 1) != 0; const float sgn = (fq < 2) ? -1.f : 1.f;
#pragma unroll
                    for (int ai = 0; ai < 2; ++ai)
#pragma unroll
                        for (int m = 0; m < 4; ++m) { const int s = sbase + ai * HALF + m * 16;
                            f32x4 v0 = acc[ai][bj][m][0], v1 = acc[ai][bj][m][1];
                            if (!isctx) {
                                const int pos = odd ? (s & 63) : (s >> 6);
                                const f32x4 c0 = *(const f32x4*)(ropeC + pos * 16 + i0), c1 = *(const f32x4*)(ropeC + pos * 16 + i0 + 4);
                                const f32x4 s0 = *(const f32x4*)(ropeS + pos * 16 + i0), s1 = *(const f32x4*)(ropeS + pos * 16 + i0 + 4);
#pragma unroll
                                for (int j = 0; j < 4; ++j) { const float p0 = __shfl_xor(v0[j], 32), p1 = __shfl_xor(v1[j], 32);
                                    v0[j] = v0[j] * c0[j] + sgn * p0 * s0[j]; v1[j] = v1[j] * c1[j] + sgn * p1 * s1[j]; }
                            }
                            if (pn < 2) { v0 = v0 * QSCALE; v1 = v1 * QSCALE; }
                            u32x4 w; w.x = cvt_pk_bf16(v0[0], v0[1]); w.y = cvt_pk_bf16(v0[2], v0[3]); w.z = cvt_pk_bf16(v1[0], v1[1]); w.w = cvt_pk_bf16(v1[2], v1[3]);
                            const size_t grow = grow0 + ai * HALF + m * 16;
                            if (pn < 2) *(u32x4*)(QB + grow * 512 + pn * 256 + bj * HALF + c8) = w; else *(u32x4*)(KB + grow * 128 + c8) = w; asm volatile("" ::: "memory"); }
                }
            }
        } else if (pn == 3) {
#pragma unroll
            for (int ai = 0; ai < 2; ++ai)
#pragma unroll
                for (int m = 0; m < 4; ++m) { const size_t grow = grow0 + ai * HALF + m * 16;
#pragma unroll
                    for (int bj = 0; bj < 2; ++bj) { f32x4 v0 = acc[ai][bj][m][0], v1 = acc[ai][bj][m][1];
#pragma unroll
                        for (int j = 0; j < 4; ++j) { v0[j] = gelu_tanh(v0[j]); v1[j] = gelu_tanh(v1[j]); }
                        u32x4 w; w.x = cvt_pk_bf16(v0[0], v0[1]); w.y = cvt_pk_bf16(v0[2], v0[3]); w.z = cvt_pk_bf16(v1[0], v1[1]); w.w = cvt_pk_bf16(v1[2], v1[3]);
                        *(u32x4*)(UB + grow * 256 + bj * HALF + c8) = w; } asm volatile("" ::: "memory"); }
        } else if (pn == 4) {
            bf16_t* base = isctx ? GVTc + (size_t)b * 256 * 256 : GVT + (size_t)b * 256 * 8192; const int ld = isctx ? 256 : 8192;
#pragma unroll
            for (int ai = 0; ai < 2; ++ai)
#pragma unroll
                for (int m = 0; m < 4; ++m) { const int s = sbase + ai * HALF + m * 16;
#pragma unroll
                    for (int bj = 0; bj < 2; ++bj)
#pragma unroll
                        for (int n = 0; n < 2; ++n)
#pragma unroll
                            for (int j = 0; j < 4; ++j) base[(size_t)(bj * HALF + c8 + 4 * n + j) * ld + s] = f2bf1(gelu_tanh(acc[ai][bj][m][n][j])); asm volatile("" ::: "memory"); }
        } else {
            if (!isctx) {
                bf16_t* base = GT + ((size_t)b * 256 * 16 + fr) * 512 + 16 * (pm & 31) + 4 * wr;
#pragma unroll
                for (int bj = 0; bj < 2; ++bj)
#pragma unroll
                    for (int n = 0; n < 2; ++n)
#pragma unroll
                        for (int j = 0; j < 4; ++j) { const int ch = bj * HALF + c8 + 4 * n + j;
#pragma unroll
                            for (int ai = 0; ai < 2; ++ai) { u32x2 w; w.x = cvt_pk_bf16(acc[ai][bj][0][n][j], acc[ai][bj][1][n][j]); w.y = cvt_pk_bf16(acc[ai][bj][2][n][j], acc[ai][bj][3][n][j]);
                                *(u32x2*)(base + (size_t)ch * 8192 + 8 * ai) = w; } asm volatile("" ::: "memory"); }
            } else {
                bf16_t* base = GTc + (size_t)b * 256 * 512;
#pragma unroll
                for (int ai = 0; ai < 2; ++ai)
#pragma unroll
                    for (int m = 0; m < 4; ++m) { const int s = sbase + ai * HALF + m * 16;
#pragma unroll
                        for (int bj = 0; bj < 2; ++bj)
#pragma unroll
                            for (int n = 0; n < 2; ++n)
#pragma unroll
                                for (int j = 0; j < 4; ++j) { const int ch = bj * HALF + c8 + 4 * n + j; const bool ity = (ch & 1) && ((ch & 63) != 1);
                                    base[(size_t)ch * 512 + (ity ? 256 : 0) + s] = f2bf1(acc[ai][bj][m][n][j]); base[(size_t)ch * 512 + (ity ? 0 : 256) + s] = 0; } asm volatile("" ::: "memory"); }
            }
        }
    }
};


template <bool PERMK = false>
__device__ __forceinline__ void p0_transpose_item(const float* W, int K, int N, bf16* WT, int nblk, LAS float* scr, int item, int lane) {
    const int kb = item / nblk, nb = item % nblk, k0 = 64 * kb, n0 = 32 * nb;
    float tv[32];
#pragma unroll
    for (int i = 0; i < 32; ++i) { int kr = k0 + 2 * i + (lane >> 5); if (PERMK && kr >= 768) kr = (kr & ~63) + fsig(kr & 63); tv[i] = W[(size_t)kr * N + n0 + (lane & 31)]; }
#pragma unroll
    for (int i = 0; i < 32; ++i) scr[(2 * i + (lane >> 5)) * 33 + (lane & 31)] = tv[i];
    LDS_WAIT();
    const int c = lane & 7;
#pragma unroll
    for (int j = 0; j < 4; ++j) { const int n = (lane >> 3) + 8 * j; const LAS float* s = scr + (8 * c) * 33 + n;
        v4u o; o.x = cvt_pk_bf16(s[0 * 33], s[1 * 33]); o.y = cvt_pk_bf16(s[2 * 33], s[3 * 33]); o.z = cvt_pk_bf16(s[4 * 33], s[5 * 33]); o.w = cvt_pk_bf16(s[6 * 33], s[7 * 33]);
        *(v4u*)(WT + (size_t)(n0 + n) * K + k0 + 8 * c) = o; }
    LDS_WAIT();
}
__device__ __forceinline__ void p0_fold_item(const float* Win  , bf16* WT  , LAS float* scr, int item, int lane) {
    const int g = item >> 6, k0 = ((item >> 2) & 15) * 64, q0 = (item & 3) * 16;
    LAS float* cs = scr + 64 * 65; LAS float* sn = cs + 64;
    cs[lane] = cospif((float)lane / 32.f); sn[lane] = -sinpif((float)lane / 32.f);
#pragma unroll 1
    for (int i0 = 0; i0 < 64; i0 += 32) { float tv[32];
#pragma unroll
        for (int i = 0; i < 32; ++i) tv[i] = Win[(size_t)(k0 + i0 + i) * 1536 + 1280 + g * 64 + lane];
#pragma unroll
        for (int i = 0; i < 32; ++i) scr[(i0 + i) * 65 + lane] = tv[i]; }
    LDS_WAIT();
    for (int q = q0; q < q0 + 16; ++q) {
        const bool rtype = !(q & 1) || q == 1; const int jm = q == 1 ? 32 : (q >> 1);
        const LAS float* tab = rtype ? cs : sn;
        float ar = 0.f;
#pragma unroll 8
        for (int c = 0; c < 64; ++c) ar += scr[lane * 65 + c] * tab[(jm * c) & 63];
        WT[(size_t)(1280 + g * 64 + q) * 1024 + k0 + lane] = pg8::f2bf1(ar);
    }
    LDS_WAIT();
}
__device__ __forceinline__ void p0_mod_item(LAS unsigned char* lds, int item, const float* w_ada, const float* b_ada, float* MOD, int tid) {
    LAS float* sl = (LAS float*)lds; LAS float* red = sl + 9 * 1024;
    const int wave = tid >> 6, lane = tid & 63;
    const int l = item / 96, n0 = (item % 96) * 64;
    f32x4 acc[9];
#pragma unroll
    for (int r = 0; r < 9; ++r) acc[r] = (f32x4){0.f, 0.f, 0.f, 0.f};
    const int kr = lane >> 4, c4 = lane & 15;
    const float* W = w_ada + (size_t)l * 1024 * 6144 + n0 + c4 * 4;
#pragma unroll 1
    for (int k0 = 0; k0 < 128; k0 += 32) {
        f32x4 wv[8];
#pragma unroll
        for (int i = 0; i < 8; ++i) wv[i] = *(const f32x4*)(W + (size_t)(wave * 128 + k0 + i * 4 + kr) * 6144);
#pragma unroll
        for (int i = 0; i < 8; ++i) { const int k = wave * 128 + k0 + i * 4 + kr;
#pragma unroll
            for (int r = 0; r < 9; ++r) acc[r] = acc[r] + wv[i] * sl[r * 1024 + k]; }
    }
#pragma unroll
    for (int r = 0; r < 9; ++r)
#pragma unroll
        for (int e = 0; e < 4; ++e) { float v = acc[r][e]; v += __shfl_xor(v, 16); v += __shfl_xor(v, 32); acc[r][e] = v; }
    if (kr == 0) {
#pragma unroll
        for (int r = 0; r < 9; ++r)
#pragma unroll
            for (int e = 0; e < 4; ++e) red[(wave * 9 + r) * 64 + c4 * 4 + e] = acc[r][e];
    }
    __syncthreads();
    for (int i = tid; i < 576; i += 512) { const int r = i >> 6, n = i & 63; float s = b_ada[l * 6144 + n0 + n];
#pragma unroll
        for (int w = 0; w < 8; ++w) s += red[(w * 9 + r) * 64 + n];
        MOD[(size_t)(l * 9 + r) * 6144 + n0 + n] = s; }
    __syncthreads();
}
__device__ __forceinline__ void p0_prologue(const Args& a, LAS unsigned char* lds, int bid, int G, int tid) {
    asm volatile("" : "+v"(tid));
    unsigned char* ws = a.ws;
    const int wave = tid >> 6, lane = tid & 63;
    if (bid < 192) {
        LAS float* sl = (LAS float*)lds;
        for (int i = tid; i < 9 * 1024; i += 512) { const int r = i >> 10, k = i & 1023; const float v = r < 8 ? a.in[1][r * 1024 + k] : a.in[3][k]; sl[i] = v / (1.f + __expf(-v)); }
        __syncthreads();
        for (int it = bid; it < 192; it += G) p0_mod_item(lds, it, a.in[4], a.in[5], (float*)(ws + WS_MOD), tid);
    }
    __syncthreads();
    {
        const int gt = bid * 512 + tid, NT = G * 512;
        float* rc = (float*)(ws + WS_ROPEC); float* rs = (float*)(ws + WS_ROPES);
        for (int i = gt; i < 2048; i += NT) { const int pos = i >> 4, f = i & 15; const float invf = exp2f(-(float)f * (13.287712379549449f / 16.f));
            const float ang = (float)pos * invf; float rev = ang * 0.15915494309189535f; rev -= floorf(rev); rc[i] = cospif(2.f * rev); rs[i] = sinpif(2.f * rev); }
        float* tw = (float*)(ws + WS_TW);
        for (int i = gt; i < 8192; i += NT) { tw[2 * i] = cospif((float)i / 4096.f); tw[2 * i + 1] = sinpif((float)i / 4096.f); }
        bf16* d5 = (bf16*)(ws + WS_DFT512);
        for (int i = gt; i < 1024 * 512; i += NT) { const int R = i >> 9, s1 = i & 511, pr = R >> 9, k1 = R & 511; const int m = (k1 * s1) & 511;
            d5[i] = pg8::f2bf1(pr == 0 ? cospif((float)m / 256.f) : -sinpif((float)m / 256.f)); }
        bf16* d2 = (bf16*)(ws + WS_DFT256);
        for (int i = gt; i < 256 * 512; i += NT) { const int k = i >> 9, C = i & 511, pc = C >> 8, s = C & 255; const int m = (k * s) & 255;
            d2[i] = pg8::f2bf1(pc == 0 ? cospif((float)m / 128.f) : sinpif((float)m / 128.f)); }
    }
    LAS float* scr = (LAS float*)(lds + wave * 17408);
    const int gw = bid * 8 + wave, NGW = G * 8;
    constexpr int PER = 640 + 256 + 512 + 2048 + 2048;
    for (int it = gw; it < 2 * PER; it += NGW) {
        const int l = it / PER; int r = it % PER;
        const float* win = a.in[7] + (size_t)l * 1024 * 1536; bf16* wtin = (bf16*)(ws + WS_WIN) + (size_t)l * NIN * 1024;
        if (r < 640) { p0_transpose_item(win, 1024, 1536, wtin, 40, scr, r, lane); continue; } r -= 640;
        if (r < 256) { p0_fold_item(win, wtin, scr, r, lane); continue; } r -= 256;
        if (r < 512) { p0_transpose_item<true>(a.in[13] + (size_t)l * 1024 * 1024, 1024, 1024, (bf16*)(ws + WS_WOUT) + (size_t)l * 1024 * 1024, 32, scr, r, lane); continue; } r -= 512;
        if (r < 2048) { p0_transpose_item(a.in[16] + (size_t)l * 1024 * 4096, 1024, 4096, (bf16*)(ws + WS_WFF1) + (size_t)l * 4096 * 1024, 128, scr, r, lane); continue; } r -= 2048;
        p0_transpose_item(a.in[17] + (size_t)l * 4096 * 1024, 4096, 1024, (bf16*)(ws + WS_WFF2) + (size_t)l * 1024 * 4096, 32, scr, r, lane);
    }
}

template <int NR, int NP = 0>
__device__ __forceinline__ void row_op(const float* xin, const bf16* upd, const float* gate, const float* gupd, float* xout, bf16* hxout,
                                       const float* gn, const float* sc, const float* sh, int lane,
                                       const bf16* upd2 = nullptr, const float* gate2 = nullptr, const float* gupd2 = nullptr) {
    asm volatile("" : "+v"(lane));
    f32x4 x[NR][4];
#pragma unroll
    for (int r = 0; r < NR; ++r)
#pragma unroll
        for (int j = 0; j < 4; ++j) x[r][j] = *(const f32x4*)(xin + (size_t)r * DM + j * 256 + lane * 4);
    if (upd) {
        f32x4 y[NR][4];
#pragma unroll
        for (int r = 0; r < NR; ++r)
#pragma unroll
            for (int j = 0; j < 4; ++j) {
                if (NP == 0) { const v2u w = *(const v2u*)(upd + (size_t)r * DM + j * 256 + lane * 4); y[r][j][0] = bflo(w.x); y[r][j][1] = bfhi(w.x); y[r][j][2] = bflo(w.y); y[r][j][3] = bfhi(w.y); }
                else { const float* pp = (const float*)upd + (size_t)r * DM + j * 256 + lane * 4; f32x4 t = *(const f32x4*)pp;
#pragma unroll
                    for (int p = 1; p < NP; ++p) t = t + *(const f32x4*)(pp + (size_t)p * 2048 * 1024);
                    y[r][j] = t; } }
        float rr[NR];
#pragma unroll
        for (int r = 0; r < NR; ++r) { float ss = 0.f;
#pragma unroll
            for (int j = 0; j < 4; ++j) ss += (y[r][j][0] * y[r][j][0] + y[r][j][1] * y[r][j][1]) + (y[r][j][2] * y[r][j][2] + y[r][j][3] * y[r][j][3]);
            rr[r] = ss; }
#pragma unroll
        for (int r = 0; r < NR; ++r) rr[r] = rsqrtf(wave_sum(rr[r]) * (1.f / 1024.f) + EPSN);
#pragma unroll
        for (int j = 0; j < 4; ++j) { const f32x4 g = *(const f32x4*)(gate + j * 256 + lane * 4) * *(const f32x4*)(gupd + j * 256 + lane * 4);
#pragma unroll
            for (int r = 0; r < NR; ++r) x[r][j] = x[r][j] + g * (y[r][j] * rr[r]); }
    }
    if (upd2) {
        f32x4 y[NR][4];
#pragma unroll
        for (int r = 0; r < NR; ++r)
#pragma unroll
            for (int j = 0; j < 4; ++j) { const v2u w = *(const v2u*)(upd2 + (size_t)r * DM + j * 256 + lane * 4); y[r][j][0] = bflo(w.x); y[r][j][1] = bfhi(w.x); y[r][j][2] = bflo(w.y); y[r][j][3] = bfhi(w.y); }
        float rr[NR];
#pragma unroll
        for (int r = 0; r < NR; ++r) { float ss = 0.f;
#pragma unroll
            for (int j = 0; j < 4; ++j) ss += (y[r][j][0] * y[r][j][0] + y[r][j][1] * y[r][j][1]) + (y[r][j][2] * y[r][j][2] + y[r][j][3] * y[r][j][3]);
            rr[r] = ss; }
#pragma unroll
        for (int r = 0; r < NR; ++r) rr[r] = rsqrtf(wave_sum(rr[r]) * (1.f / 1024.f) + EPSN);
#pragma unroll
        for (int j = 0; j < 4; ++j) { const f32x4 g = *(const f32x4*)(gate2 + j * 256 + lane * 4) * *(const f32x4*)(gupd2 + j * 256 + lane * 4);
#pragma unroll
            for (int r = 0; r < NR; ++r) x[r][j] = x[r][j] + g * (y[r][j] * rr[r]); }
    }
    if (xout) {
#pragma unroll
        for (int r = 0; r < NR; ++r)
#pragma unroll
            for (int j = 0; j < 4; ++j) *(f32x4*)(xout + (size_t)r * DM + j * 256 + lane * 4) = x[r][j];
    }
    if (hxout) {
        float rr[NR];
#pragma unroll
        for (int r = 0; r < NR; ++r) { float ss = 0.f;
#pragma unroll
            for (int j = 0; j < 4; ++j) ss += (x[r][j][0] * x[r][j][0] + x[r][j][1] * x[r][j][1]) + (x[r][j][2] * x[r][j][2] + x[r][j][3] * x[r][j][3]);
            rr[r] = ss; }
#pragma unroll
        for (int r = 0; r < NR; ++r) rr[r] = rsqrtf(wave_sum(rr[r]) * (1.f / 1024.f) + EPSN);
#pragma unroll
        for (int j = 0; j < 4; ++j) { const f32x4 g = *(const f32x4*)(gn + j * 256 + lane * 4) * (*(const f32x4*)(sc + j * 256 + lane * 4) + 1.f), s0 = *(const f32x4*)(sh + j * 256 + lane * 4);
#pragma unroll
            for (int r = 0; r < NR; ++r) { const f32x4 h = (x[r][j] * rr[r]) * g + s0; v2u w; w.x = cvt_pk_bf16(h[0], h[1]); w.y = cvt_pk_bf16(h[2], h[3]); *(v2u*)(hxout + (size_t)r * DM + j * 256 + lane * 4) = w; } }
    }
}
template <int NR>
__device__ __forceinline__ void mixnorm_rows(bf16* mix, const float* gmix, int lane, bf16* outp) {
    asm volatile("" : "+v"(lane));
    v4u w[NR][2];
#pragma unroll
    for (int r = 0; r < NR; ++r) { w[r][0] = *(const v4u*)(mix + (size_t)r * 1024 + lane * 16); w[r][1] = *(const v4u*)(mix + (size_t)r * 1024 + lane * 16 + 8); }
    f32x4 g[4];
#pragma unroll
    for (int q = 0; q < 4; ++q) g[q] = *(const f32x4*)(gmix + lane * 16 + q * 4);
    float rr[NR];
#pragma unroll
    for (int r = 0; r < NR; ++r) { float ss = 0.f;
#pragma unroll
        for (int h = 0; h < 2; ++h)
#pragma unroll
            for (int e = 0; e < 4; ++e) { const float a = bflo(w[r][h][e]), b = bfhi(w[r][h][e]); ss += a * a + b * b; }
        rr[r] = ss; }
#pragma unroll
    for (int r = 0; r < NR; ++r) { float ss = rr[r]; ss += __shfl_xor(ss, 1); ss += __shfl_xor(ss, 2); ss += __shfl_xor(ss, 4); ss += __shfl_xor(ss, 8);
        const float s16 = __shfl_xor(ss, 16); const float tot = lane < 32 ? ss + s16 : ss; const float cnt = lane < 32 ? 512.f : 256.f;
        rr[r] = rsqrtf(tot / cnt + EPSN); }
#pragma unroll
    for (int r = 0; r < NR; ++r) {
#pragma unroll
        for (int h = 0; h < 2; ++h)
#pragma unroll
            for (int e = 0; e < 4; ++e) { const int q = h * 2 + (e >> 1); const float a = bflo(w[r][h][e]) * rr[r] * g[q][(e & 1) * 2], b = bfhi(w[r][h][e]) * rr[r] * g[q][(e & 1) * 2 + 1]; w[r][h][e] = cvt_pk_bf16(a, b); }
        *(v4u*)(outp + (size_t)r * 1024 + lane * 16) = w[r][0]; *(v4u*)(outp + (size_t)r * 1024 + lane * 16 + 8) = w[r][1]; }
}

#define MFMA32(a, b, c) __builtin_amdgcn_mfma_f32_32x32x16_bf16(a, b, c, 0, 0, 0)
constexpr int AT_ST = 136;
constexpr int AT_HALF = 128 * AT_ST * 2;
constexpr int AT_BUF = 2 * AT_HALF;
constexpr int AT_RED = 2 * AT_BUF;
__device__ __forceinline__ void attn_units(LAS unsigned char* lds, const bf16* QB, const bf16* KB, const bf16* VT, const bf16* VTc, bf16* MIX, const float* sink, const float* gmix,
                                           int nunits, int G, int vb, int tid) {
    asm volatile("" : "+v"(tid));
    const int wave = __builtin_amdgcn_readfirstlane(tid >> 6), lane = tid & 63, h = wave >> 2, c = lane & 31, hh = lane >> 5;
    LAS float* red = (LAS float*)(lds + AT_RED);
    for (int L = vb; L < nunits; L += G) {
        const int uidx = (L < 1024 && (G & 7) == 0) ? (L & 7) * 128 + (L >> 3) : L;
        const bool isctx = uidx >= 1024; int b, nb, q0;
        if (!isctx) { b = uidx >> 7; nb = (uidx >> 1) & 63; q0 = nb * 128 + (uidx & 1) * 64; } else { const int v = uidx - 1024; b = v >> 2; nb = 0; q0 = (v & 3) * 64; }
        const size_t qrow0 = (size_t)(isctx ? ML + b * CTXL : b * SEQ) + q0;
        bf16x8 qf[2][4];
#pragma unroll
        for (int qs = 0; qs < 2; ++qs)
#pragma unroll
            for (int ks = 0; ks < 4; ++ks) qf[qs][ks] = *(const bf16x8*)(QB + (qrow0 + qs * 32 + c) * 512 + wave * 64 + ks * 16 + hh * 8);
        float mrun[2], lrun[2]; f32x16 o[2][2];
        const float sk = sink[wave] * LOG2E;
#pragma unroll
        for (int qs = 0; qs < 2; ++qs) { mrun[qs] = sk; lrun[qs] = 1.f;
#pragma unroll
            for (int dt = 0; dt < 2; ++dt)
#pragma unroll
                for (int r = 0; r < 16; ++r) o[qs][dt][r] = 0.f; }
        int s = isctx ? 3 : (nb == 0 ? 1 : 0);
        v4u pk[4], pv[4];
#define AT_ISSUE(ss) do { const bf16* kg; const bf16* vg; int ldv; \
            if ((ss) < 3) { const int kb0 = (nb - 1 + (ss)) * 128; kg = KB + (size_t)(b * SEQ + kb0) * 128; vg = VT + (size_t)(b * 128) * SEQ + kb0; ldv = SEQ; } \
            else { const int kb0 = ((ss) - 3) * 128; kg = KB + (size_t)(ML + b * CTXL + kb0) * 128; vg = VTc + (size_t)(b * 128) * CTXL + kb0; ldv = CTXL; } \
            _Pragma("unroll") for (int e = 0; e < 4; ++e) { const int i = tid + 512 * e, r = i >> 4, ch = i & 15; pk[e] = *(const v4u*)(kg + (size_t)r * 128 + ch * 8); pv[e] = *(const v4u*)(vg + (size_t)r * ldv + ch * 8); } } while (0)
#define AT_WRITE(bufo) do { _Pragma("unroll") for (int e = 0; e < 4; ++e) { const int i = tid + 512 * e, r = i >> 4, ch = i & 15; \
            *(LAS v4u*)(lds + (bufo) + (r * AT_ST + ch * 8) * 2) = pk[e]; *(LAS v4u*)(lds + (bufo) + AT_HALF + (r * AT_ST + ch * 8) * 2) = pv[e]; } } while (0)
        AT_ISSUE(s);
        __syncthreads();
        AT_WRITE(0);
        __syncthreads();
        int cur = 0;
        for (;;) {
            int sn = s + 1; if (sn == 2 && !isctx && nb == 63) sn = 3;
            if (sn <= 4) AT_ISSUE(sn);
            const LAS bf16* Ks = (const LAS bf16*)(lds + cur * AT_BUF); const LAS bf16* Vs = (const LAS bf16*)(lds + cur * AT_BUF + AT_HALF);
            int t_lo = 0, t_hi = 3; const int kb0 = (nb - 1 + s) * 128;
            if (s < 3) { const int a0 = q0 - 128 - kb0, a1 = q0 + 191 - kb0; t_lo = a0 > 0 ? a0 >> 5 : 0; t_hi = (a1 >> 5) < 3 ? (a1 >> 5) : 3; }
#pragma unroll 2
            for (int kt = t_lo; kt <= t_hi; ++kt) {
                bf16x8 kf[4];
#pragma unroll
                for (int ks = 0; ks < 4; ++ks) kf[ks] = *(const LAS bf16x8*)(Ks + (kt * 32 + c) * AT_ST + h * 64 + ks * 16 + hh * 8);
                bf16x8 vf[2][2];
#pragma unroll
                for (int dt = 0; dt < 2; ++dt)
#pragma unroll
                    for (int s2 = 0; s2 < 2; ++s2) { const LAS bf16* p = Vs + (h * 64 + dt * 32 + c) * AT_ST + kt * 32 + s2 * 16 + hh * 4;
                        const v2u lo = *(const LAS v2u*)p, hi = *(const LAS v2u*)(p + 8); v4u t; t.x = lo.x; t.y = lo.y; t.z = hi.x; t.w = hi.y; vf[dt][s2] = __builtin_bit_cast(bf16x8, t); }
                f32x16 st[2];
#pragma unroll
                for (int qs = 0; qs < 2; ++qs) {
                    const float nm = -mrun[qs];
#pragma unroll
                    for (int r = 0; r < 16; ++r) st[qs][r] = nm;
#pragma unroll
                    for (int ks = 0; ks < 4; ++ks) st[qs] = MFMA32(kf[ks], qf[qs][ks], st[qs]);
                }
                bf16x8 pb[2][2];
#pragma unroll
                for (int qs = 0; qs < 2; ++qs) {
                    float t[16];
#pragma unroll
                    for (int r = 0; r < 16; ++r) t[r] = st[qs][r];
                    const int kmin = kb0 + kt * 32, qmin = q0 + qs * 32;
                    if (s < 3 && (kmin - (qmin + 31) < -128 || kmin + 31 - qmin > 128)) {
                        const int base = kmin + 4 * hh - (qmin + c) + 128;
#pragma unroll
                        for (int r = 0; r < 16; ++r) { if ((unsigned)(base + (r & 3) + 8 * (r >> 2)) > 256u) t[r] = -1e30f; } }
                    float tmax = fmaxf(fmaxf(t[0], t[1]), t[2]);
#pragma unroll
                    for (int r = 3; r < 15; r += 2) tmax = fmaxf(fmaxf(tmax, t[r]), t[r + 1]);
                    tmax = fmaxf(tmax, t[15]);
                    { auto rr = __builtin_amdgcn_permlane32_swap(__float_as_uint(tmax), __float_as_uint(tmax), false, false); tmax = fmaxf(__uint_as_float(rr[0]), __uint_as_float(rr[1])); }
                    if (!__all(tmax <= 8.f)) {
                        const float delta = fmaxf(tmax, 0.f), alpha = __builtin_amdgcn_exp2f(-delta);
                        lrun[qs] *= alpha; mrun[qs] += delta;
#pragma unroll
                        for (int dt = 0; dt < 2; ++dt) o[qs][dt] = o[qs][dt] * alpha;
#pragma unroll
                        for (int r = 0; r < 16; ++r) t[r] -= delta;
                    }
                    float psum = 0.f;
#pragma unroll
                    for (int r = 0; r < 16; ++r) { t[r] = __builtin_amdgcn_exp2f(t[r]); psum += t[r]; }
                    { auto rr = __builtin_amdgcn_permlane32_swap(__float_as_uint(psum), __float_as_uint(psum), false, false); psum = __uint_as_float(rr[0]) + __uint_as_float(rr[1]); }
                    lrun[qs] += psum;
#pragma unroll
                    for (int s2 = 0; s2 < 2; ++s2) { v4u w; w.x = cvt_pk_bf16(t[8 * s2 + 0], t[8 * s2 + 1]); w.y = cvt_pk_bf16(t[8 * s2 + 2], t[8 * s2 + 3]); w.z = cvt_pk_bf16(t[8 * s2 + 4], t[8 * s2 + 5]); w.w = cvt_pk_bf16(t[8 * s2 + 6], t[8 * s2 + 7]);
                        pb[qs][s2] = __builtin_bit_cast(bf16x8, w); }
#pragma unroll
                    for (int s2 = 0; s2 < 2; ++s2)
#pragma unroll
                        for (int dt = 0; dt < 2; ++dt) o[qs][dt] = MFMA32(vf[dt][s2], pb[qs][s2], o[qs][dt]);
                    __builtin_amdgcn_sched_barrier(0);
                }
            }
            if (sn > 4) break;
            AT_WRITE((cur ^ 1) * AT_BUF);
            __syncthreads();
            cur ^= 1; s = sn;
        }
#undef AT_ISSUE
#undef AT_WRITE
        float ssq[2];
#pragma unroll
        for (int qs = 0; qs < 2; ++qs) { const float inv = 1.f / lrun[qs]; float ss = 0.f;
#pragma unroll
            for (int dt = 0; dt < 2; ++dt) { o[qs][dt] = o[qs][dt] * inv;
#pragma unroll
                for (int r = 0; r < 16; ++r) ss += o[qs][dt][r] * o[qs][dt][r]; }
            { auto rr = __builtin_amdgcn_permlane32_swap(__float_as_uint(ss), __float_as_uint(ss), false, false); ss = __uint_as_float(rr[0]) + __uint_as_float(rr[1]); }
            ssq[qs] = ss; if (hh == 0) red[wave * 64 + qs * 32 + c] = ss; }
        __syncthreads();
        LAS bf16* otile = (LAS bf16*)(lds + wave * 9216);
#pragma unroll
        for (int qs = 0; qs < 2; ++qs) { float tot = 0.f;
#pragma unroll
            for (int w = 0; w < 8; ++w) tot += red[w * 64 + qs * 32 + c];
            const float rn = rsqrtf(tot * (1.f / 512.f) + EPSN);
#pragma unroll
            for (int dt = 0; dt < 2; ++dt)
#pragma unroll
                for (int rg = 0; rg < 4; ++rg) { const f32x4 gm = *(const f32x4*)(gmix + wave * 64 + dt * 32 + rg * 8 + hh * 4);
                    v2u w; w.x = cvt_pk_bf16(o[qs][dt][4 * rg] * rn * gm[0], o[qs][dt][4 * rg + 1] * rn * gm[1]); w.y = cvt_pk_bf16(o[qs][dt][4 * rg + 2] * rn * gm[2], o[qs][dt][4 * rg + 3] * rn * gm[3]);
                    *(LAS v2u*)(otile + (qs * 32 + c) * 72 + dt * 32 + rg * 8 + hh * 4) = w; } }
        LDS_WAIT();
#pragma unroll
        for (int it = 0; it < 8; ++it) { const int r = it * 8 + (lane >> 3), ch = lane & 7; const v4u v = *(const LAS v4u*)(otile + r * 72 + ch * 8);
            *(v4u*)(MIX + (qrow0 + r) * 1024 + wave * 64 + ch * 8) = v; }
    }
    __syncthreads();
}

__device__ __forceinline__ void sgu_units(LAS unsigned char* lds, const bf16* UB, const bf16* GVT, const bf16* GVTc, bf16* MIX, const float* wsgu, const float* bsgu, const float* gsgu, const float* gmix,
                                          int nchunks, int G, int bid, int tid) {
    asm volatile("" : "+v"(tid));
    const int wave = __builtin_amdgcn_readfirstlane(tid >> 6), lane = tid & 63, hd = wave >> 1, ph = wave & 1, c = lane & 31, h2 = lane >> 5;
    LAS float* rq = (LAS float*)lds + wave * 128;
    bf16x8 bfr[2][8];
#pragma unroll
    for (int ps = 0; ps < 2; ++ps)
#pragma unroll
        for (int ks = 0; ks < 8; ++ks) { const float* wp = wsgu + ((size_t)(hd * 128 + ph * 64 + ps * 32 + c)) * 128 + ks * 16 + h2 * 8; const f32x4 w0 = *(const f32x4*)wp, w1 = *(const f32x4*)(wp + 4);
            v4u w; w.x = cvt_pk_bf16(w0[0], w0[1]); w.y = cvt_pk_bf16(w0[2], w0[3]); w.z = cvt_pk_bf16(w1[0], w1[1]); w.w = cvt_pk_bf16(w1[2], w1[3]); bfr[ps][ks] = __builtin_bit_cast(bf16x8, w); }
    for (int L = bid; L < nchunks; L += G) {
        const int chunk = (L < 512 && (G & 7) == 0) ? (L & 7) * 64 + (L >> 3) : L;
        const bool isctx = chunk >= 512; const int b = isctx ? (chunk - 512) >> 1 : chunk >> 6, s0 = isctx ? ((chunk - 512) & 1) * 128 : (chunk & 63) * 128;
        const int ld = isctx ? CTXL : SEQ;
        const bf16* Gt = (isctx ? GVTc + ((size_t)(b * 256 + hd * 64)) * CTXL : GVT + ((size_t)(b * 256 + hd * 64)) * SEQ) + s0;
        float sa = 0.f, sb = 0.f;
#pragma unroll 1
        for (int d0 = 0; d0 < 64; d0 += 32) { unsigned gv[32];
#pragma unroll
            for (int d = 0; d < 32; ++d) gv[d] = *(const unsigned*)(Gt + (size_t)(d0 + d) * ld + 2 * lane);
#pragma unroll
            for (int d = 0; d < 32; ++d) { const float x0 = bflo(gv[d]), x1 = bfhi(gv[d]); sa += x0 * x0; sb += x1 * x1; } }
        LDS_WAIT();
        rq[2 * lane] = rsqrtf(sa * (1.f / 64.f) + EPSN); rq[2 * lane + 1] = rsqrtf(sb * (1.f / 64.f) + EPSN);
        LDS_WAIT();
        f32x16 o[2][2];
#pragma unroll
        for (int dt = 0; dt < 2; ++dt)
#pragma unroll
            for (int ps = 0; ps < 2; ++ps)
#pragma unroll
                for (int r = 0; r < 16; ++r) o[dt][ps][r] = 0.f;
        v4u afr[2][8];
#pragma unroll
        for (int ks = 0; ks < 8; ++ks)
#pragma unroll
            for (int dt = 0; dt < 2; ++dt) afr[dt][ks] = *(const v4u*)(Gt + (size_t)(dt * 32 + c) * ld + ks * 16 + h2 * 8);
        LAS bf16* utile = (LAS bf16*)(lds + 8192 + wave * 9216);
        { v4u ut[8];
#pragma unroll
          for (int it = 0; it < 8; ++it) ut[it] = *(const v4u*)(UB + ((size_t)chunk * 128 + ph * 64 + it * 8 + (lane >> 3)) * 256 + hd * 64 + (lane & 7) * 8);
#pragma unroll
          for (int it = 0; it < 8; ++it) *(LAS v4u*)(utile + (it * 8 + (lane >> 3)) * 72 + (lane & 7) * 8) = ut[it]; }
#pragma unroll
        for (int ks = 0; ks < 8; ++ks) {
            const f32x4 r0 = *(const LAS f32x4*)(rq + ks * 16 + h2 * 8), r1 = *(const LAS f32x4*)(rq + ks * 16 + h2 * 8 + 4);
#pragma unroll
            for (int dt = 0; dt < 2; ++dt) { const v4u g = afr[dt][ks]; v4u w;
                w.x = cvt_pk_bf16(bflo(g.x) * r0[0], bfhi(g.x) * r0[1]); w.y = cvt_pk_bf16(bflo(g.y) * r0[2], bfhi(g.y) * r0[3]); w.z = cvt_pk_bf16(bflo(g.z) * r1[0], bfhi(g.z) * r1[1]); w.w = cvt_pk_bf16(bflo(g.w) * r1[2], bfhi(g.w) * r1[3]);
                const bf16x8 af = __builtin_bit_cast(bf16x8, w);
#pragma unroll
                for (int ps = 0; ps < 2; ++ps) o[dt][ps] = MFMA32(af, bfr[ps][ks], o[dt][ps]); }
        }
        LAS float* red2 = (LAS float*)(lds + 4096);
#pragma unroll
        for (int ps = 0; ps < 2; ++ps) { const int p = ph * 64 + ps * 32 + c; const size_t row = (size_t)chunk * 128 + p; const float bs = bsgu[hd * 128 + p]; float ss = 0.f;
#pragma unroll
            for (int dt = 0; dt < 2; ++dt)
#pragma unroll
                for (int rg = 0; rg < 4; ++rg) { const int d0 = dt * 32 + rg * 8 + h2 * 4; const f32x4 gs = *(const f32x4*)(gsgu + hd * 64 + d0);
                    const v2u uw = *(const LAS v2u*)(utile + (ps * 32 + c) * 72 + d0);
                    const float o0 = bflo(uw.x) * (gs[0] * o[dt][ps][4 * rg] + bs), o1 = bfhi(uw.x) * (gs[1] * o[dt][ps][4 * rg + 1] + bs), o2 = bflo(uw.y) * (gs[2] * o[dt][ps][4 * rg + 2] + bs), o3 = bfhi(uw.y) * (gs[3] * o[dt][ps][4 * rg + 3] + bs);
                    o[dt][ps][4 * rg] = o0; o[dt][ps][4 * rg + 1] = o1; o[dt][ps][4 * rg + 2] = o2; o[dt][ps][4 * rg + 3] = o3; ss += (o0 * o0 + o1 * o1) + (o2 * o2 + o3 * o3); }
            { auto rr = __builtin_amdgcn_permlane32_swap(__float_as_uint(ss), __float_as_uint(ss), false, false); ss = __uint_as_float(rr[0]) + __uint_as_float(rr[1]); }
            if (h2 == 0) red2[hd * 128 + p] = ss; }
        __syncthreads();
        LAS bf16* otile = (LAS bf16*)(lds + 8192 + wave * 9216);
#pragma unroll
        for (int ps = 0; ps < 2; ++ps) { const int p = ph * 64 + ps * 32 + c;
            const float rn = rsqrtf((red2[p] + red2[128 + p] + red2[256 + p] + red2[384 + p]) * (1.f / 256.f) + EPSN);
#pragma unroll
            for (int dt = 0; dt < 2; ++dt)
#pragma unroll
                for (int rg = 0; rg < 4; ++rg) { const int d0 = dt * 32 + rg * 8 + h2 * 4; const f32x4 gm = *(const f32x4*)(gmix + 512 + hd * 64 + d0);
                    v2u w; w.x = cvt_pk_bf16(o[dt][ps][4 * rg] * rn * gm[0], o[dt][ps][4 * rg + 1] * rn * gm[1]); w.y = cvt_pk_bf16(o[dt][ps][4 * rg + 2] * rn * gm[2], o[dt][ps][4 * rg + 3] * rn * gm[3]);
                    *(LAS v2u*)(otile + (ps * 32 + c) * 72 + d0) = w; } }
        LDS_WAIT();
#pragma unroll
        for (int it = 0; it < 8; ++it) { const int r = it * 8 + (lane >> 3), ch = lane & 7; const v4u v = *(const LAS v4u*)(otile + r * 72 + ch * 8);
            *(v4u*)(MIX + ((size_t)chunk * 128 + ph * 64 + r) * 1024 + 512 + hd * 64 + ch * 8) = v; }
        LDS_WAIT();
        __syncthreads();
    }
}

__device__ __forceinline__ void fourier_stage2(LAS unsigned char* lds, int wave, const bf16* Tp, bf16* MIX, const float* gmix, int gw, int NGW, int lane) {
    asm volatile("" : "+v"(lane));
    LAS bf16* slab = (LAS bf16*)(lds + wave * 8448);
    const int k2 = lane & 15, kq = lane >> 4, prt = kq >> 1, s2b = (kq & 1) * 8;
    constexpr float NRM = 0.0013810679320049757f;
    for (int item = gw; item < 4096; item += NGW) {
        const int k1 = item >> 3, b = item & 7, k = k1 + 512 * k2;
        unsigned wr_[4], wi_[4];
#pragma unroll
        for (int jj = 0; jj < 4; ++jj) { float c[2], sn[2];
#pragma unroll
            for (int u = 0; u < 2; ++u) { const int n = (k * (s2b + 2 * jj + u)) & 8191; const float rev = (float)n * (1.f / 8192.f); c[u] = __builtin_amdgcn_cosf(rev); sn[u] = __builtin_amdgcn_sinf(rev); }
            wr_[jj] = prt == 0 ? cvt_pk_bf16(c[0], c[1]) : cvt_pk_bf16(sn[0], sn[1]);
            wi_[jj] = prt == 0 ? cvt_pk_bf16(sn[0], sn[1]) : cvt_pk_bf16(-c[0], -c[1]); }
        v4u t0; t0.x = wr_[0]; t0.y = wr_[1]; t0.z = wr_[2]; t0.w = wr_[3]; const bf16x8 bR = __builtin_bit_cast(bf16x8, t0);
        v4u t1; t1.x = wi_[0]; t1.y = wi_[1]; t1.z = wi_[2]; t1.w = wi_[3]; const bf16x8 bI = __builtin_bit_cast(bf16x8, t1);
        const bf16* ap = Tp + (size_t)(prt * 512 + k1) * 32768 + ((size_t)(b * 256 + k2) * 16 + s2b);
        bf16x8 af[16];
#pragma unroll
        for (int t = 0; t < 16; ++t) af[t] = *(const bf16x8*)(ap + t * 256);
        f32x4 y[16]; float ss = 0.f;
#pragma unroll
        for (int t = 0; t < 16; ++t) {
            const f32x4 z4 = {0.f, 0.f, 0.f, 0.f};
            const f32x4 aR = __builtin_amdgcn_mfma_f32_16x16x32_bf16(af[t], bR, z4, 0, 0, 0), aI = __builtin_amdgcn_mfma_f32_16x16x32_bf16(af[t], bI, z4, 0, 0, 0);
            const bool special = ((t & 3) == 0) && kq == 0;
            const float p0 = aR[0] * NRM, p1 = (special ? aR[1] : aI[1]) * NRM, p2 = aR[2] * NRM, p3 = aI[3] * NRM;
            f32x4 o; o[0] = special ? p0 : p0 + p1; o[1] = special ? p1 : p0 - p1; o[2] = p2 + p3; o[3] = p2 - p3;
            y[t] = o; ss += (o[0] * o[0] + o[1] * o[1]) + (o[2] * o[2] + o[3] * o[3]); }
        ss += __shfl_xor(ss, 16); ss += __shfl_xor(ss, 32);
        const float rn = rsqrtf(ss * (1.f / 256.f) + EPSN);
#pragma unroll
        for (int t = 0; t < 16; ++t) { const float* gb = gmix + 768 + (t >> 2) * 64; const int p = 16 * (t & 3) + 4 * kq;
            v2u w; w.x = cvt_pk_bf16(y[t][0] * rn * gb[fsig(p)], y[t][1] * rn * gb[fsig(p + 1)]); w.y = cvt_pk_bf16(y[t][2] * rn * gb[fsig(p + 2)], y[t][3] * rn * gb[fsig(p + 3)]);
            *(LAS v2u*)(slab + k2 * 264 + 16 * t + 4 * kq) = w; }
        LDS_WAIT();
#pragma unroll
        for (int it = 0; it < 8; ++it) { const int r = it * 2 + (lane >> 5), ch = lane & 31; const v4u v = *(const LAS v4u*)(slab + r * 264 + ch * 8);
            *(v4u*)(MIX + ((size_t)b * SEQ + k1 + 512 * r) * 1024 + 768 + ch * 8) = v; }
        LDS_WAIT();
    }
}
__device__ __forceinline__ void ctx_fourier_norm(bf16* MIX, const float* gmix, int gw, int NGW, int lane) {
    asm volatile("" : "+v"(lane));
    const int pg = (lane * 4) & 63, grp = lane >> 4;
    for (int row = ML + gw; row < MT; row += NGW) { bf16* p = MIX + (size_t)row * 1024 + 768 + lane * 4;
        const v2u w = *(const v2u*)p; const float a0 = bflo(w.x), b0 = bfhi(w.x), a1 = bflo(w.y), b1 = bfhi(w.y);
        const bool pass = pg == 0;
        const float v0 = pass ? a0 : a0 + b0, v1 = pass ? b0 : a0 - b0, v2 = a1 + b1, v3 = a1 - b1;
        const float rn = rsqrtf(wave_sum((v0 * v0 + v1 * v1) + (v2 * v2 + v3 * v3)) * (1.f / 256.f) + EPSN);
        const float* gb = gmix + 768 + grp * 64;
        v2u o; o.x = cvt_pk_bf16(v0 * rn * gb[fsig(pg)], v1 * rn * gb[fsig(pg + 1)]); o.y = cvt_pk_bf16(v2 * rn * gb[fsig(pg + 2)], v3 * rn * gb[fsig(pg + 3)]); *(v2u*)p = o; }
}

#define XB_TMO      128
#define XB_XCNT(j)  (256  + 64 * (j))
#define XB_XSUB(j)  (1280 + 64 * (j))
#define XB_XGEN(j)  (2304 + 64 * (j))
#define XB_TOP      3328
#define XB_TOPGEN   3392
#define XCD_BAR_WORDS 3456
#define XB_SPIN_CAP (1u << 18)

__device__ __forceinline__ unsigned xb_ld(unsigned* p)              { return __hip_atomic_load(p, __ATOMIC_RELAXED, __HIP_MEMORY_SCOPE_AGENT); }
__device__ __forceinline__ unsigned xb_add(unsigned* p, unsigned v) { return __hip_atomic_fetch_add(p, v, __ATOMIC_RELAXED, __HIP_MEMORY_SCOPE_AGENT); }
__device__ __forceinline__ unsigned xb_xcc_id() { return (unsigned)__builtin_amdgcn_s_getreg((3 << 11) | 20) & 0xFu; }
#define XB_SPIN(cond, bar) do { unsigned _sp = 0; while (cond) { __builtin_amdgcn_s_sleep(1); \
    if ((++_sp & 255u) == 0u) { if (xb_ld(&(bar)[XB_TMO])) break; if (_sp > XB_SPIN_CAP) { atomicAdd(&(bar)[XB_TMO], 1u); break; } } } } while (0)

struct XcdBarrier {
    unsigned* bar; unsigned x;
    volatile LAS unsigned* st;
};

__device__ __forceinline__ XcdBarrier xcd_barrier_post(unsigned* bar, volatile LAS unsigned* st) {
    XcdBarrier b; b.bar = bar; b.x = xb_xcc_id(); b.st = st;
    if (threadIdx.x == 0) (void)xb_add(&bar[XB_XCNT(b.x)], 1u);
    return b;
}
__device__ __forceinline__ void xcd_barrier_complete(unsigned* bar, unsigned x, unsigned& nloc, unsigned& nx) {
    const unsigned G = gridDim.x * gridDim.y * gridDim.z;
    unsigned sum, cnt, mine, sp = 0u;
    for (;;) {
        sum = 0u; cnt = 0u; mine = 0u;
#pragma unroll
        for (unsigned j = 0; j < 16; ++j) { const unsigned c = xb_ld(&bar[XB_XCNT(j)]); sum += c; cnt += (c > 0u) ? 1u : 0u; mine = (j == x) ? c : mine; }
        if (sum == G) break;
        __builtin_amdgcn_s_sleep(1);
        if ((++sp & 255u) == 0u) { if (xb_ld(&bar[XB_TMO])) break; if (sp > XB_SPIN_CAP) { atomicAdd(&bar[XB_TMO], 1u); break; } }
    }
    nloc = mine > 0u ? mine : 1u; nx = cnt > 0u ? cnt : 1u;
}

__device__ __forceinline__ void xcd_barrier(const XcdBarrier& b) {
    asm volatile("s_waitcnt vmcnt(0)" ::: "memory");
    __syncthreads();
    if (threadIdx.x == 0) {
        unsigned* bar = b.bar;
        __builtin_amdgcn_s_waitcnt(0);
        unsigned nloc = b.st[0], nx = b.st[1];
        if (nloc == 0u) { xcd_barrier_complete(bar, b.x, nloc, nx); b.st[0] = nloc; b.st[1] = nx; }
        const unsigned old = xb_add(&bar[XB_XSUB(b.x)], 1u);
        const unsigned gen = old / nloc;
        if (old + 1u == (gen + 1u) * nloc) {
            __builtin_amdgcn_fence(__ATOMIC_RELEASE, "agent");
            asm volatile("s_waitcnt vmcnt(0)" ::: "memory");
            const unsigned og = xb_add(&bar[XB_TOP], 1u);
            const unsigned tg = og / nx;
            if (og + 1u == (tg + 1u) * nx) xb_add(&bar[XB_TOPGEN], 1u);
            else XB_SPIN(xb_ld(&bar[XB_TOPGEN]) == tg, bar);
            __builtin_amdgcn_fence(__ATOMIC_ACQUIRE, "agent");
            xb_add(&bar[XB_XGEN(b.x)], 1u);
            asm volatile("s_waitcnt vmcnt(0)" ::: "memory");
        } else {
            XB_SPIN(xb_ld(&bar[XB_XGEN(b.x)]) == gen, bar);
            __builtin_amdgcn_fence(__ATOMIC_ACQUIRE, "agent");
            asm volatile("s_waitcnt vmcnt(0)" ::: "memory");
        }
    }
    __syncthreads();
}

__global__ void __launch_bounds__(512, 2) fwd_megakernel(Args a) {
    extern __shared__ __attribute__((aligned(16))) unsigned char lds_raw[];
    LAS unsigned char* lds = (LAS unsigned char*)lds_raw;
    cg::grid_group grid = cg::this_grid();
#define GSYNC() do { XcdBarrier xb_; xb_.bar = (unsigned*)(ws + WS_BAR); xb_.x = xb_xcc_id(); xb_.st = (volatile LAS unsigned*)(lds + LDS_BARST); xcd_barrier(xb_); } while (0)
    const int tid = threadIdx.x, lane = tid & 63, wave = __builtin_amdgcn_readfirstlane(tid >> 6);
    const int bid = blockIdx.x, G = gridDim.x;
    const int gw = bid * 8 + wave, NGW = G * 8;
    unsigned char* ws = a.ws;
    const float* MOD = (const float*)(ws + WS_MOD);
    bf16* HX = (bf16*)(ws + WS_HX); bf16* YB = (bf16*)(ws + WS_XR);
    float* X1C = (float*)(ws + WS_XR + 132 * MiB) - (size_t)ML * DM;
    bf16* MIX = (bf16*)(ws + WS_MIX);
    if (bid == 0) { for (int i = tid; i < XCD_BAR_WORDS; i += 512) __hip_atomic_store((unsigned*)(ws + WS_BAR) + i, 0u, __ATOMIC_RELAXED, __HIP_MEMORY_SCOPE_AGENT); }

#ifndef SKIP_P0
    p0_prologue(a, lds, bid, G, tid);
#endif
    __syncthreads();
    if (tid < 2) ((volatile LAS unsigned*)(lds + LDS_BARST))[tid] = 0u;
    grid.sync();
    (void)xcd_barrier_post((unsigned*)(ws + WS_BAR), (volatile LAS unsigned*)(lds + LDS_BARST));
    __syncthreads();
    for (int row = gw * 4; row < MT; row += NGW * 4) {
        const int mr = row < ML ? row >> 13 : 8; const float* md = MOD + (size_t)mr * 6144;
        const float* xin = row < ML ? a.in[0] + (size_t)row * DM : a.in[2] + (size_t)(row - ML) * DM;
#ifdef PROBE_ROWS
        row_op<4>(xin, nullptr, nullptr, nullptr, nullptr, (bf16*)(ws + WS_C) + (size_t)row * DM, a.in[6], md + 1024, md, lane);
#endif
        row_op<4>(xin, nullptr, nullptr, nullptr, nullptr, HX + (size_t)row * DM, a.in[6], md + 1024, md, lane);
    }
    GSYNC();
#pragma unroll 1
    for (int l = 0; l < 2; ++l) {
        const bool last = l == 1;
        const int MR = last ? ML : MT;
        const float* modl = MOD + (size_t)l * 9 * 6144;
#ifndef SKIP_G1
        {
            int fM = MT, fN = NIN, fK = DM; asm volatile("" : "+s"(fM), "+s"(fN), "+s"(fK));
            pg8::Gemm g{HX, (const bf16*)(ws + WS_WIN) + (size_t)l * NIN * 1024, fM, fN, fK}; pg8::StaticOrder S; S.init(fM, fN, G, bid);
            EpiIn E{ws, last ? 1 : 0};
            pg8::gemm_phase<EpiIn, pg8::StaticOrder, true, true>(lds, g, S, E);
        }
#endif
        GSYNC();
        const float* gmixl = a.in[12] + l * 1024;
        attn_units(lds, (const bf16*)(ws + WS_QB), (const bf16*)(ws + WS_KB), (const bf16*)(ws + WS_VT), (const bf16*)(ws + WS_VTC), MIX, a.in[8] + l * 8, gmixl, last ? 1024 : 1056, G, bid, tid);
        sgu_units(lds, (const bf16*)(ws + WS_UB), (const bf16*)(ws + WS_GVT), (const bf16*)(ws + WS_GVTC), MIX, a.in[9] + (size_t)l * 4 * 128 * 128, a.in[10] + l * 512, a.in[11] + l * 256, gmixl,
                  last ? 512 : 528, G, (bid + 224) % G, tid);
        __syncthreads();
#ifndef SKIP_F1
        {
            int fM = 1024, fN = 32768, fK = 512; asm volatile("" : "+s"(fM), "+s"(fN), "+s"(fK));
            pg8::Gemm g{(const bf16*)(ws + WS_DFT512), (const bf16*)(ws + WS_GT), fM, fN, fK}; pg8::StaticOrder S; S.init(fM, fN, G, bid);
            pg8::EpiPlain<0, false> E{(bf16*)(ws + WS_TP), fN, 1.f};
            pg8::gemm_phase<pg8::EpiPlain<0, false>, pg8::StaticOrder, true, true>(lds, g, S, E);
        }
#endif
#ifndef SKIP_CF
        if (!last) {
            int fM = 256, fN = 2048, fK = 512, fL = 1024; asm volatile("" : "+s"(fM), "+s"(fN), "+s"(fK), "+s"(fL));
            pg8::Gemm g{(const bf16*)(ws + WS_DFT256), (const bf16*)(ws + WS_GTC), fM, fN, fK}; pg8::StaticOrder S; S.init(fM, fN, G, (bid + 208) % G);
            pg8::EpiPlain<0, true> E{MIX + (size_t)ML * 1024 + 768, fL, 0.0078125f};
            pg8::gemm_phase<pg8::EpiPlain<0, true>, pg8::StaticOrder, true, true>(lds, g, S, E);
        }
#endif
        GSYNC();
        fourier_stage2(lds, wave, (const bf16*)(ws + WS_TP), MIX, gmixl, gw, NGW, lane);
        if (!last) ctx_fourier_norm(MIX, gmixl, gw, NGW, lane);
        GSYNC();
#ifndef SKIP_G2
        {
            pg8::Gemm g{MIX, (const bf16*)(ws + WS_WOUT) + (size_t)l * 1024 * 1024, ML, DM, DM, 0}; pg8::StaticOrder S; S.init(ML, DM, G, bid);
            pg8::EpiPlain<0, false> E{YB, DM, 1.f};
            pg8::gemm_phase<pg8::EpiPlain<0, false>, pg8::StaticOrder, true, true>(lds, g, S, E);
        }
        if (!last) {
            int fK = 256, fL = DM; asm volatile("" : "+s"(fK), "+s"(fL));
            pg8::Gemm g{MIX, (const bf16*)(ws + WS_WOUT) + (size_t)l * 1024 * 1024, MT, DM, fK, fL}; pg8::SplitKOrder S{G, bid, 256, 8, 4, 4, fK * 2};
            pg8::EpiPart E{(float*)(ws + WS_PART), fL, fK * 2, 256, (size_t)2048 * 1024};
            pg8::gemm_phase<pg8::EpiPart, pg8::SplitKOrder, true, true>(lds, g, S, E);
        }
#endif
        GSYNC();
        for (int row = gw * 4; row < ML; row += NGW * 4) {
            const float* md = modl + (size_t)(row >> 13) * 6144;
            const float* xin = l == 0 ? a.in[0] + (size_t)row * DM : a.out + (size_t)row * DM;
            row_op<4>(xin, YB + (size_t)row * DM, md + 2048, a.in[14] + l * 1024, nullptr, HX + (size_t)row * DM, a.in[15] + l * 1024, md + 4096, md + 3072, lane);
        }
        if (!last) for (int row = ML + gw * 2; row < MT; row += NGW * 2) {
            const float* md = modl + (size_t)8 * 6144;
            row_op<2, 4>(a.in[2] + (size_t)(row - ML) * DM, (const bf16*)((const float*)(ws + WS_PART) + (size_t)(row - ML) * DM), md + 2048, a.in[14] + l * 1024, X1C + (size_t)row * DM, HX + (size_t)row * DM, a.in[15] + l * 1024, md + 4096, md + 3072, lane);
        }
        GSYNC();
#ifndef SKIP_G3
        {
            pg8::Gemm g{HX, (const bf16*)(ws + WS_WFF1) + (size_t)l * 4096 * 1024, MR, DFF, DM}; pg8::StaticOrder S; S.init(MR, DFF, G, bid);
            pg8::EpiPlain<1, false> E{(bf16*)(ws + WS_H1), DFF, 1.f};
            pg8::gemm_phase<pg8::EpiPlain<1, false>, pg8::StaticOrder, true, true>(lds, g, S, E);
        }
#endif
        GSYNC();
#ifndef SKIP_G4
        {
            pg8::Gemm g{(const bf16*)(ws + WS_H1), (const bf16*)(ws + WS_WFF2) + (size_t)l * 1024 * 4096, ML, DM, DFF, 0}; pg8::StaticOrder S; S.init(ML, DM, G, bid);
            pg8::EpiPlain<0, false> E{HX, DM, 1.f};
            pg8::gemm_phase<pg8::EpiPlain<0, false>, pg8::StaticOrder, true, true>(lds, g, S, E);
        }
        if (!last) {
            int fK = 1024, fL = DFF, fC = DM; asm volatile("" : "+s"(fK), "+s"(fL), "+s"(fC));
            pg8::Gemm g{(const bf16*)(ws + WS_H1), (const bf16*)(ws + WS_WFF2) + (size_t)l * 1024 * 4096, MT, DM, fK, fL}; pg8::SplitKOrder S{G, bid, 256, 8, 4, 4, fK * 2};
            pg8::EpiPart E{(float*)(ws + WS_PART), fC, fK * 2, 256, (size_t)2048 * 1024};
            pg8::gemm_phase<pg8::EpiPart, pg8::SplitKOrder, true, true>(lds, g, S, E);
        }
#endif
        GSYNC();
        for (int row = gw * 4; row < ML; row += NGW * 4) {
            const int mr = row >> 13; const float* md = modl + (size_t)mr * 6144;
            const float* xin = l == 0 ? a.in[0] + (size_t)row * DM : a.out + (size_t)row * DM;
            if (!last) { const float* mdn = MOD + (size_t)(9 + mr) * 6144;
                row_op<4>(xin, YB + (size_t)row * DM, md + 2048, a.in[14] + l * 1024, a.out + (size_t)row * DM, HX + (size_t)row * DM, a.in[6] + 1024, mdn + 1024, mdn, lane,
                          HX + (size_t)row * DM, md + 5120, a.in[18] + l * 1024);
            } else row_op<4>(xin, YB + (size_t)row * DM, md + 2048, a.in[14] + l * 1024, a.out + (size_t)row * DM, nullptr, nullptr, nullptr, nullptr, lane,
                             HX + (size_t)row * DM, md + 5120, a.in[18] + l * 1024);
        }
        if (!last) for (int row = ML + gw * 2; row < MT; row += NGW * 2) {
            const float* md = modl + (size_t)8 * 6144; const float* mdn = MOD + (size_t)(9 + 8) * 6144;
            row_op<2, 4>(X1C + (size_t)row * DM, (const bf16*)((const float*)(ws + WS_PART) + (size_t)(row - ML) * DM), md + 5120, a.in[18] + l * 1024, nullptr, HX + (size_t)row * DM, a.in[6] + 1024, mdn + 1024, mdn, lane);
        }
        if (!last) GSYNC();
    }
}

extern "C" void kernel_launch(void* const* d_in, const int* in_sizes, int n_in, void* d_out, int out_size, void* d_ws, size_t ws_size, hipStream_t stream) {
    static int grid = 0;
    if (grid == 0) {
        if (n_in != 19 || ws_size < WS_TOTAL) { fprintf(stderr, "kernel_launch: unexpected n_in %d / ws %zu\n", n_in, ws_size); grid = -1; return; }
        int dev = 0, cus = 0, per_cu = 0;
        hipGetDevice(&dev);
        hipDeviceGetAttribute(&cus, hipDeviceAttributeMultiprocessorCount, dev);
        hipFuncSetAttribute((const void*)fwd_megakernel, hipFuncAttributeMaxDynamicSharedMemorySize, LDS_BYTES);
        hipOccupancyMaxActiveBlocksPerMultiprocessor(&per_cu, (const void*)fwd_megakernel, 512, LDS_BYTES);
        if (per_cu < 1) per_cu = 1;
        grid = cus * per_cu;
        (void)hipGetLastError();
    }
    if (grid < 0) return;
    Args a{};
    for (int i = 0; i < 19; ++i) a.in[i] = (const float*)d_in[i];
    a.out = (float*)d_out; a.ws = (unsigned char*)d_ws;
    void* args[] = {&a};
    hipError_t e = hipLaunchCooperativeKernel((const void*)fwd_megakernel, dim3(grid), dim3(512), args, LDS_BYTES, stream);
    if (e != hipSuccess) fprintf(stderr, "cooperative launch failed: %s (grid %d)\n", hipGetErrorString(e), grid);
}
```

```cpp
#include <hip/hip_runtime.h>
#include <hip/hip_cooperative_groups.h>
#include <cstdio>
#include <cstdint>
namespace cg = cooperative_groups;
namespace pg8 {
#define PG8_LAS __attribute__((address_space(3)))
typedef unsigned short bf16_t;
typedef short bf16x8 __attribute__((ext_vector_type(8)));
typedef float f32x4 __attribute__((ext_vector_type(4)));
typedef unsigned u32x4 __attribute__((ext_vector_type(4)));
constexpr int BM = 256, BK = 64, HALF = 128, HTB = HALF * BK * 2  , STAGE_BYTES = 8 * HTB, NXCD = 8, WGM = 8;

__host__ __device__ __forceinline__ int lds_byte(int r, int c) { const int st = (r >> 4) * 2 + (c >> 5), rr = r & 15, cc = c & 31, ob = rr * 64 + cc * 2; return st * 1024 + (ob ^ (((ob >> 9) & 1) << 5)); }
__host__ __device__ __forceinline__ void stage_rc(int b, int& R, int& C) { const int st = b / 1024, sb = b % 1024, swz = sb ^ (((sb >> 9) & 1) << 5); R = (st >> 1) * 16 + swz / 64; C = (st & 1) * 32 + (swz % 64) / 2; }
__host__ __device__ __forceinline__ int perm32(int rho) { const int n = rho >> 4, i = rho & 15; return 8 * (i >> 2) + 4 * n + (i & 3); }

struct Unit { int pm, pn, ko; };
struct Gemm { const bf16_t* A; const bf16_t* Bt; int M, N, K, ld; };

struct StaticOrder {
    int nM, nN, nwg, G, c;
    __host__ __device__ void init(int M, int N, int G_, int c_) { nM = M / BM; nN = N / BM; nwg = nM * nN; G = G_; c = c_; }
    __host__ __device__ bool next(int i, Unit& u) const {
        const long L = (long)i * G + c; if (L >= nwg) return false;
        int wgid = (int)L; { const int q = nwg / NXCD, r = nwg % NXCD, xcd = wgid % NXCD, off = wgid / NXCD; wgid = (xcd < r ? xcd * (q + 1) : r * (q + 1) + (xcd - r) * q) + off; }
        const int nig = WGM * nN, gid = wgid / nig, fm = gid * WGM, gsz = (nM - fm) < WGM ? (nM - fm) : WGM;
        u.pm = fm + ((wgid % nig) % gsz); u.pn = (wgid % nig) / gsz; u.ko = 0; return true;
    }
    __device__ __forceinline__ void a_ready(const Unit&) const {}
    __device__ __forceinline__ void done(const Unit&) const {}
};

__device__ __forceinline__ unsigned cvt_pk_bf16(float lo, float hi) { unsigned r; asm volatile("v_cvt_pk_bf16_f32 %0, %1, %2" : "=v"(r) : "v"(lo), "v"(hi)); return r; }
typedef float f32x2 __attribute__((ext_vector_type(2)));
typedef unsigned u32x2 __attribute__((ext_vector_type(2)));
__device__ __forceinline__ unsigned short f2bf1(float f) { return (unsigned short)(cvt_pk_bf16(f, 0.f) & 0xffffu); }
__device__ __forceinline__ float gelu_tanh(float x) {
    const float u = 0.7978845608f * (x + 0.044715f * x * x * x);
    return x * __builtin_amdgcn_rcpf(1.0f + __builtin_amdgcn_exp2f(-2.885390082f * u));
}
template <int ACT, bool REMAP> struct EpiPlain {
    static constexpr bool PERM = true, AFTER_DRAIN = false;
    bf16_t* O; int ldc; float scale;
    __device__ __forceinline__ void operator()(const f32x4 (&acc)[2][2][4][2], const Unit& u, int wr, int wc, int fr, int fq) const {
        asm volatile("" : "+v"(fr), "+v"(fq));
        const int row0 = (REMAP ? u.pn * BM : u.pm * BM) + wr * 64 + fr; const int col0 = (REMAP ? 0 : u.pn * BM) + wc * 32 + 8 * fq;
#pragma unroll
        for (int ai = 0; ai < 2; ++ai)
#pragma unroll
            for (int m = 0; m < 4; ++m) { bf16_t* rowp = O + (size_t)(row0 + ai * HALF + m * 16) * ldc + col0;
#pragma unroll
                for (int bj = 0; bj < 2; ++bj) { f32x4 v0 = acc[ai][bj][m][0], v1 = acc[ai][bj][m][1];
                    if (ACT == 1) {
#pragma unroll
                        for (int j = 0; j < 4; ++j) { float a = fmaxf(v0[j], 0.f), b = fmaxf(v1[j], 0.f); v0[j] = a * a; v1[j] = b * b; } }
                    v0 = v0 * scale; v1 = v1 * scale;
                    u32x4 w; w.x = cvt_pk_bf16(v0[0], v0[1]); w.y = cvt_pk_bf16(v0[2], v0[3]); w.z = cvt_pk_bf16(v1[0], v1[1]); w.w = cvt_pk_bf16(v1[2], v1[3]);
                    *(u32x4*)(rowp + bj * HALF) = w; } }
    }
};

struct SplitKOrder {
    int G, c, pm0, npm, npn, nks, ksub_bytes;
    __device__ bool next(int i, Unit& u) const {
        const int L = i * G + c; if (L >= npm * npn * nks) return false;
        u.ko = (L % nks) * ksub_bytes; const int t = L / nks; u.pn = t % npn; u.pm = pm0 + t / npn; return true;
    }
    __device__ __forceinline__ void a_ready(const Unit&) const {}
    __device__ __forceinline__ void done(const Unit&) const {}
};
struct EpiPart {
    static constexpr bool PERM = true, AFTER_DRAIN = false;
    float* P; int ldc, ksub_bytes, pm0; size_t slice;
    __device__ __forceinline__ void operator()(const f32x4 (&acc)[2][2][4][2], const Unit& u, int wr, int wc, int fr, int fq) const {
        asm volatile("" : "+v"(fr), "+v"(fq));
        float* base = P + (size_t)(u.ko / ksub_bytes) * slice;
        const int row0 = (u.pm - pm0) * BM + wr * 64 + fr, col0 = u.pn * BM + wc * 32 + 8 * fq;
#pragma unroll
        for (int ai = 0; ai < 2; ++ai)
#pragma unroll
            for (int m = 0; m < 4; ++m) { float* rowp = base + (size_t)(row0 + ai * HALF + m * 16) * ldc + col0;
#pragma unroll
                for (int bj = 0; bj < 2; ++bj) { *(f32x4*)(rowp + bj * HALF) = acc[ai][bj][m][0]; *(f32x4*)(rowp + bj * HALF + 4) = acc[ai][bj][m][1]; } }
    }
};
template <class Epi, class Sched, bool ALIGN_EPI = false, bool SP2 = false>
__device__ __forceinline__ void gemm_phase(PG8_LAS unsigned char* lds, const Gemm g, const Sched& S, const Epi& E) {
    int tid_l = threadIdx.x; asm volatile("" : "+v"(tid_l));
    const int tid = tid_l, wid = __builtin_amdgcn_readfirstlane(tid >> 6), lane = tid & 63, wr = wid >> 2, wc = wid & 3, fr = lane & 15, fq = lane >> 4;
    const int K = g.K, LD = g.ld ? g.ld : g.K, nt = K / BK;
    unsigned voffA[2], voffB[2];
#pragma unroll
    for (int i = 0; i < 2; ++i) { int R, C; stage_rc(tid * 16 + i * 8192, R, C); const int Rb = Epi::PERM ? ((R & ~31) + perm32(R & 31)) : R;
        voffA[i] = (unsigned)(R * LD + C) * 2u; voffB[i] = (unsigned)(Rb * LD + C) * 2u; }
    const size_t kstep = (size_t)(BK * 2);
    const size_t hstep = (size_t)HALF * LD * 2;
    const size_t tstep = 2 * hstep;
    const unsigned ldsw = (unsigned)wid * 1024u;
    const int aoff = lds_byte(wr * 64 + fr, fq * 8), boff = lds_byte(wc * 32 + fr, fq * 8);
#define PG8_SA(b, h) (((b) * 2 + (h)) * HTB)
#define PG8_SB(b, h) ((4 + (b) * 2 + (h)) * HTB)
#define PG8_STAGE(bufoff, gbase, voff) do { _Pragma("unroll") for (int _i = 0; _i < 2; ++_i) \
        __builtin_amdgcn_global_load_lds((const unsigned*)((const char*)(gbase) + (voff)[_i]), (PG8_LAS unsigned*)(lds + (bufoff) + ldsw + _i * 8192), 16, 0, 0); } while (0)
#define PG8_LDA(dst, b, h) do { _Pragma("unroll") for (int m = 0; m < 4; ++m) _Pragma("unroll") for (int k = 0; k < 2; ++k) dst[m][k] = *(const PG8_LAS bf16x8*)(lds + PG8_SA(b, h) + aoff + m * 2048 + k * 1024); } while (0)
#define PG8_LDB(dst, b, h) do { _Pragma("unroll") for (int n = 0; n < 2; ++n) _Pragma("unroll") for (int k = 0; k < 2; ++k) dst[n][k] = *(const PG8_LAS bf16x8*)(lds + PG8_SB(b, h) + boff + n * 2048 + k * 1024); } while (0)
#define PG8_MMA(ai, bj, At, Bt) do { __builtin_amdgcn_s_setprio(1); _Pragma("unroll") for (int m = 0; m < 4; ++m) _Pragma("unroll") for (int n = 0; n < 2; ++n) _Pragma("unroll") for (int k = 0; k < 2; ++k) \
        acc[ai][bj][m][n] = __builtin_amdgcn_mfma_f32_16x16x32_bf16(Bt[n][k], At[m][k], acc[ai][bj][m][n], 0, 0, 0); __builtin_amdgcn_s_setprio(0); } while (0)
#define PG8_WAIT_V(n) asm volatile("s_waitcnt vmcnt(" #n ")" ::: "memory")
#define PG8_WAIT_L(n) asm volatile("s_waitcnt lgkmcnt(" #n ")" ::: "memory")
#define PG8_BAR __builtin_amdgcn_s_barrier()
#define PG8_SCHED __builtin_amdgcn_sched_barrier(0)
    Unit cur, nxt; int ui = 0;
    if (!S.next(0, cur)) return;
    f32x4 acc[2][2][4][2];
#pragma unroll
    for (int a = 0; a < 2; ++a)
#pragma unroll
        for (int b = 0; b < 2; ++b)
#pragma unroll
            for (int m = 0; m < 4; ++m)
#pragma unroll
                for (int n = 0; n < 2; ++n) acc[a][b][m][n] = (f32x4){0.f, 0.f, 0.f, 0.f};
    bf16x8 At[4][2], B0[2][2], B1[2][2];
    const char* cA = (const char*)g.A + (size_t)cur.pm * tstep + cur.ko; const char* cB = (const char*)g.Bt + (size_t)cur.pn * tstep + cur.ko;
    S.a_ready(cur);
    if constexpr (SP2) {
        PG8_STAGE(PG8_SB(0, 0), cB, voffB); PG8_STAGE(PG8_SB(0, 1), cB + hstep, voffB); PG8_STAGE(PG8_SA(0, 0), cA, voffA); PG8_STAGE(PG8_SA(0, 1), cA + hstep, voffA);
        if (wr == 1) PG8_BAR;
        PG8_WAIT_V(2); PG8_BAR;
        PG8_STAGE(PG8_SB(1, 0), cB + kstep, voffB); PG8_STAGE(PG8_SA(1, 0), cA + kstep, voffA); PG8_STAGE(PG8_SB(1, 1), cB + hstep + kstep, voffB);
        PG8_WAIT_V(6); PG8_BAR;
    } else {
        PG8_STAGE(PG8_SB(0, 0), cB, voffB); PG8_STAGE(PG8_SA(0, 0), cA, voffA); PG8_STAGE(PG8_SB(0, 1), cB + hstep, voffB); PG8_STAGE(PG8_SA(0, 1), cA + hstep, voffA);
        if (wr == 1) PG8_BAR;
        PG8_WAIT_V(4); PG8_BAR;
        PG8_STAGE(PG8_SB(1, 0), cB + kstep, voffB); PG8_STAGE(PG8_SA(1, 0), cA + kstep, voffA); PG8_STAGE(PG8_SB(1, 1), cB + hstep + kstep, voffB);
        PG8_WAIT_V(6); PG8_BAR;
    }
    for (;;) {
        const bool has_next = S.next(ui + 1, nxt);
        const char* nA = has_next ? (const char*)g.A + (size_t)nxt.pm * tstep + nxt.ko : cA; const char* nB = has_next ? (const char*)g.Bt + (size_t)nxt.pn * tstep + nxt.ko : cB;
        for (int t = 0; t < nt; t += 2) {
            const bool last = (t == nt - 2);
            const char* a1 = cA + (size_t)(t + 1) * kstep;
            const char* a2 = last ? nA : cA + (size_t)(t + 2) * kstep; const char* b2 = last ? nB : cB + (size_t)(t + 2) * kstep;
            const char* a3 = a2 + kstep; const char* b3 = b2 + kstep;
            if (last && has_next) S.a_ready(nxt);
            if constexpr (SP2) {
            PG8_LDB(B0, 0, 0); PG8_LDB(B1, 0, 1); PG8_SCHED; PG8_LDA(At, 0, 0); PG8_STAGE(PG8_SA(1, 1), a1 + hstep, voffA);
            PG8_WAIT_V(8); PG8_WAIT_L(0); PG8_BAR; PG8_MMA(0, 0, At, B0); PG8_MMA(0, 1, At, B1); PG8_BAR; PG8_SCHED;
            PG8_LDA(At, 0, 1); PG8_STAGE(PG8_SB(0, 0), b2, voffB); PG8_STAGE(PG8_SB(0, 1), b2 + hstep, voffB); PG8_STAGE(PG8_SA(0, 0), a2, voffA);
            PG8_WAIT_V(8); PG8_WAIT_L(0); PG8_BAR; PG8_MMA(1, 0, At, B0); PG8_MMA(1, 1, At, B1); PG8_BAR; PG8_SCHED;
            PG8_LDB(B0, 1, 0); PG8_LDB(B1, 1, 1); PG8_SCHED; PG8_LDA(At, 1, 0); PG8_STAGE(PG8_SA(0, 1), a2 + hstep, voffA);
            PG8_WAIT_V(8); PG8_WAIT_L(0); PG8_BAR; PG8_MMA(0, 0, At, B0); PG8_MMA(0, 1, At, B1); PG8_BAR; PG8_SCHED;
            PG8_LDA(At, 1, 1); PG8_STAGE(PG8_SB(1, 0), b3, voffB); PG8_STAGE(PG8_SB(1, 1), b3 + hstep, voffB); PG8_STAGE(PG8_SA(1, 0), a3, voffA);
            PG8_WAIT_V(8); PG8_WAIT_L(0); PG8_BAR; PG8_MMA(1, 0, At, B0); PG8_MMA(1, 1, At, B1); PG8_BAR; PG8_SCHED;
            } else {
            PG8_LDB(B0, 0, 0); PG8_SCHED; PG8_LDA(At, 0, 0); PG8_STAGE(PG8_SA(1, 1), a1 + hstep, voffA);
            PG8_WAIT_L(8); PG8_BAR; PG8_WAIT_L(0); PG8_MMA(0, 0, At, B0); PG8_BAR; PG8_SCHED;
            PG8_LDB(B1, 0, 1); PG8_STAGE(PG8_SB(0, 0), b2, voffB);
            PG8_BAR; PG8_WAIT_L(0); PG8_MMA(0, 1, At, B1); PG8_BAR;
            PG8_LDA(At, 0, 1); PG8_STAGE(PG8_SA(0, 0), a2, voffA);
            PG8_BAR; PG8_WAIT_L(0); PG8_MMA(1, 0, At, B0); PG8_BAR; PG8_SCHED;
            PG8_STAGE(PG8_SB(0, 1), b2 + hstep, voffB);
            PG8_WAIT_V(6); PG8_BAR; PG8_MMA(1, 1, At, B1); PG8_BAR;
            PG8_LDB(B0, 1, 0); PG8_SCHED; PG8_LDA(At, 1, 0); PG8_STAGE(PG8_SA(0, 1), a2 + hstep, voffA);
            PG8_WAIT_L(8); PG8_BAR; PG8_WAIT_L(0); PG8_MMA(0, 0, At, B0); PG8_BAR; PG8_SCHED;
            PG8_LDB(B1, 1, 1); PG8_STAGE(PG8_SB(1, 0), b3, voffB);
            PG8_BAR; PG8_WAIT_L(0); PG8_MMA(0, 1, At, B1); PG8_BAR;
            PG8_LDA(At, 1, 1); PG8_STAGE(PG8_SA(1, 0), a3, voffA);
            PG8_BAR; PG8_WAIT_L(0); PG8_MMA(1, 0, At, B0); PG8_BAR; PG8_SCHED;
            PG8_STAGE(PG8_SB(1, 1), b3 + hstep, voffB);
            PG8_WAIT_V(6); PG8_BAR; PG8_MMA(1, 1, At, B1); PG8_BAR;
            }
        }
        if constexpr (ALIGN_EPI) { if (wr == 0) PG8_BAR; }
        if constexpr (!Epi::AFTER_DRAIN) { E(acc, cur, wr, wc, fr, fq); S.done(cur); }
        if (!has_next) break;
#pragma unroll
        for (int a = 0; a < 2; ++a)
#pragma unroll
            for (int b = 0; b < 2; ++b)
#pragma unroll
                for (int m = 0; m < 4; ++m)
#pragma unroll
                    for (int n = 0; n < 2; ++n) acc[a][b][m][n] = (f32x4){0.f, 0.f, 0.f, 0.f};
        cur = nxt; cA = nA; cB = nB; ++ui;
        if constexpr (ALIGN_EPI) { if (wr == 1) PG8_BAR; }
    }
    PG8_WAIT_V(0);
    if constexpr (!ALIGN_EPI) { if (wr == 0) PG8_BAR; }
    PG8_BAR;
    if constexpr (Epi::AFTER_DRAIN) { E.fused(acc, cur, wr, wc, fr, fq, lds, wid, lane); S.done(cur); }
#undef PG8_SA
#undef PG8_SB
#undef PG8_STAGE
#undef PG8_LDA
#undef PG8_LDB
#undef PG8_MMA
#undef PG8_WAIT_V
#undef PG8_WAIT_L
#undef PG8_BAR
#undef PG8_SCHED
}
}

#define LAS __attribute__((address_space(3)))
typedef unsigned short bf16;
typedef short bf16x8 __attribute__((ext_vector_type(8)));
typedef float f32x4 __attribute__((ext_vector_type(4)));
typedef float f32x16 __attribute__((ext_vector_type(16)));
typedef unsigned v4u __attribute__((ext_vector_type(4)));
typedef unsigned v2u __attribute__((ext_vector_type(2)));
using pg8::cvt_pk_bf16;

constexpr int NB = 8, SEQ = 8192, DM = 1024, CTXL = 256, DFF = 4096, NIN = 1536;
constexpr int ML = NB * SEQ;
constexpr int MT = ML + NB * CTXL;
constexpr float EPSN = 1e-6f;
constexpr float LOG2E = 1.4426950408889634f;
constexpr float QSCALE = 0.125f * 1.4426950408889634f;
constexpr size_t MiB = 1u << 20;
constexpr size_t WS_WIN = 0;
constexpr size_t WS_WOUT = 7 * MiB;
constexpr size_t WS_WFF1 = 11 * MiB;
constexpr size_t WS_WFF2 = 27 * MiB;
constexpr size_t WS_DFT512 = 43 * MiB;
constexpr size_t WS_DFT256 = 45 * MiB;
constexpr size_t WS_TW = 45 * MiB + 256 * 1024;
constexpr size_t WS_ROPEC = WS_TW + 64 * 1024;
constexpr size_t WS_ROPES = WS_ROPEC + 8 * 1024;
constexpr size_t WS_MOD = 46 * MiB;
constexpr size_t WS_HX = 48 * MiB;
constexpr size_t WS_XR = WS_HX + 132 * MiB;
constexpr size_t WS_C = WS_XR + 264 * MiB;
constexpr size_t WS_H1 = WS_C;
constexpr size_t WS_QB = WS_C;
constexpr size_t WS_KB = WS_QB + 66 * MiB;
constexpr size_t WS_VT = WS_KB + 17 * MiB;
constexpr size_t WS_VTC = WS_VT + 16 * MiB;
constexpr size_t WS_UB = WS_VTC + 1 * MiB;
constexpr size_t WS_GVT = WS_UB + 33 * MiB;
constexpr size_t WS_GVTC = WS_GVT + 32 * MiB;
constexpr size_t WS_GT = WS_GVTC + 1 * MiB;
constexpr size_t WS_GTC = WS_GT + 64 * MiB;
constexpr size_t WS_TP = WS_GTC + 2 * MiB;
constexpr size_t WS_MIX = WS_TP + 64 * MiB;
constexpr size_t WS_END = WS_C + 528 * MiB;
static_assert(WS_MIX + 132 * MiB <= WS_END, "overlay region");
constexpr size_t WS_PART = WS_END;
constexpr size_t WS_TOTAL = WS_PART + 32 * MiB;
static_assert(WS_TOTAL <= 1024 * MiB, "workspace");
constexpr int LDS_BYTES = 147456;
constexpr size_t WS_BAR = 46 * MiB + 512 * 1024;
constexpr int LDS_BARST = LDS_BYTES - 64;

__device__ __forceinline__ float bf2f(unsigned short h) { return __builtin_bit_cast(float, (unsigned)h << 16); }
__device__ __forceinline__ float bflo(unsigned w) { return __builtin_bit_cast(float, w << 16); }
__device__ __forceinline__ float bfhi(unsigned w) { return __builtin_bit_cast(float, w & 0xffff0000u); }
__device__ __forceinline__ float wave_sum(float v) {
#pragma unroll
    for (int o = 1; o < 64; o <<= 1) v += __shfl_xor(v, o);
    return v;
}
#define LDS_WAIT() asm volatile("s_waitcnt lgkmcnt(0)" ::: "memory")
__host__ __device__ __forceinline__ int fsig(int p) { return (p & 1) ? ((p == 1) ? 32 : 64 - (p >> 1)) : (p >> 1); }

struct Args { const float* in[19]; float* out; unsigned char* ws; };

struct EpiIn {
    static constexpr bool PERM = true, AFTER_DRAIN = false;
    unsigned char* wsb; int last;
    __device__ __forceinline__ void operator()(const pg8::f32x4 (&acc)[2][2][4][2], const pg8::Unit& u, int wr, int wc, int fr, int fq) const {
        using namespace pg8;
        asm volatile("" : "+v"(fr), "+v"(fq));
        unsigned char* ws = wsb; asm volatile("" : "+s"(ws));
        bf16_t* const QB = (bf16_t*)(ws + WS_QB); bf16_t* const KB = (bf16_t*)(ws + WS_KB); bf16_t* const VT = (bf16_t*)(ws + WS_VT); bf16_t* const VTc = (bf16_t*)(ws + WS_VTC);
        bf16_t* const UB = (bf16_t*)(ws + WS_UB); bf16_t* const GVT = (bf16_t*)(ws + WS_GVT); bf16_t* const GVTc = (bf16_t*)(ws + WS_GVTC); bf16_t* const GT = (bf16_t*)(ws + WS_GT); bf16_t* const GTc = (bf16_t*)(ws + WS_GTC);
        const float* const ropeC = (const float*)(ws + WS_ROPEC); const float* const ropeS = (const float*)(ws + WS_ROPES);
        const int pm = u.pm, pn = u.pn; const bool isctx = pm >= 256;
        if (isctx && last && pn != 2) return;
        const int b = isctx ? pm - 256 : pm >> 5;
        const int sbase = (isctx ? 0 : (pm & 31) * 256) + wr * 64 + fr;
        const size_t grow0 = (size_t)pm * 256 + wr * 64 + fr;
        const int c8 = wc * 32 + 8 * fq;
        if (pn <= 2) {
#pragma unroll
            for (int bj = 0; bj < 2; ++bj) {
                if (pn == 2 && bj == 1) {
                    bf16_t* base = isctx ? VTc + (size_t)b * 128 * 256 : VT + (size_t)b * 128 * 8192; const int ld = isctx ? 256 : 8192;
#pragma unroll
                    for (int ai = 0; ai < 2; ++ai)
#pragma unroll
                        for (int m = 0; m < 4; ++m) { const int s = sbase + ai * HALF + m * 16;
#pragma unroll
                            for (int n = 0; n < 2; ++n)
#pragma unroll
                                for (int j = 0; j < 4; ++j) base[(size_t)(c8 + 4 * n + j) * ld + s] = f2bf1(acc[ai][1][m][n][j]); asm volatile("" ::: "memory"); }
                } else {
                    const int i0 = 8 * (fq & 1); const bool odd = (wc & 1) != 0; const float sgn = (fq < 2) ? -1.f : 1.f;
#pragma unroll
                    for (int ai = 0; ai < 2; ++ai)
#pragma unroll
                        for (int m = 0; m < 4; ++m) { const int s = sbase + ai * HALF + m * 16;
                            f32x4 v0 = acc[ai][bj][m][0], v1 = acc[ai][bj][m][1];
                            if (!isctx) {
                                const int pos = odd ? (s & 63) : (s >> 6);
                                const f32x4 c0 = *(const f32x4*)(ropeC + pos * 16 + i0), c1 = *(const f32x4*)(ropeC + pos * 16 + i0 + 4);
                                const f32x4 s0 = *(const f32x4*)(ropeS + pos * 16 + i0), s1 = *(const f32x4*)(ropeS + pos * 16 + i0 + 4);
#pragma unroll
                                for (int j = 0; j < 4; ++j) { const float p0 = __shfl_xor(v0[j], 32), p1 = __shfl_xor(v1[j], 32);
                                    v0[j] = v0[j] * c0[j] + sgn * p0 * s0[j]; v1[j] = v1[j] * c1[j] + sgn * p1 * s1[j]; }
                            }
                            if (pn < 2) { v0 = v0 * QSCALE; v1 = v1 * QSCALE; }
                            u32x4 w; w.x = cvt_pk_bf16(v0[0], v0[1]); w.y = cvt_pk_bf16(v0[2], v0[3]); w.z = cvt_pk_bf16(v1[0], v1[1]); w.w = cvt_pk_bf16(v1[2], v1[3]);
                            const size_t grow = grow0 + ai * HALF + m * 16;
                            if (pn < 2) *(u32x4*)(QB + grow * 512 + pn * 256 + bj * HALF + c8) = w; else *(u32x4*)(KB + grow * 128 + c8) = w; asm volatile("" ::: "memory"); }
                }
            }
        } else if (pn == 3) {
#pragma unroll
            for (int ai = 0; ai < 2; ++ai)
#pragma unroll
                for (int m = 0; m < 4; ++m) { const size_t grow = grow0 + ai * HALF + m * 16;
#pragma unroll
                    for (int bj = 0; bj < 2; ++bj) { f32x4 v0 = acc[ai][bj][m][0], v1 = acc[ai][bj][m][1];
#pragma unroll
                        for (int j = 0; j < 4; ++j) { v0[j] = gelu_tanh(v0[j]); v1[j] = gelu_tanh(v1[j]); }
                        u32x4 w; w.x = cvt_pk_bf16(v0[0], v0[1]); w.y = cvt_pk_bf16(v0[2], v0[3]); w.z = cvt_pk_bf16(v1[0], v1[1]); w.w = cvt_pk_bf16(v1[2], v1[3]);
                        *(u32x4*)(UB + grow * 256 + bj * HALF + c8) = w; } asm volatile("" ::: "memory"); }
        } else if (pn == 4) {
            bf16_t* base = isctx ? GVTc + (size_t)b * 256 * 256 : GVT + (size_t)b * 256 * 8192; const int ld = isctx ? 256 : 8192;
#pragma unroll
            for (int ai = 0; ai < 2; ++ai)
#pragma unroll
                for (int m = 0; m < 4; ++m) { const int s = sbase + ai * HALF + m * 16;
#pragma unroll
                    for (int bj = 0; bj < 2; ++bj)
#pragma unroll
                        for (int n = 0; n < 2; ++n)
#pragma unroll
                            for (int j = 0; j < 4; ++j) base[(size_t)(bj * HALF + c8 + 4 * n + j) * ld + s] = f2bf1(gelu_tanh(acc[ai][bj][m][n][j])); asm volatile("" ::: "memory"); }
        } else {
            if (!isctx) {
                bf16_t* base = GT + ((size_t)b * 256 * 16 + fr) * 512 + 16 * (pm & 31) + 4 * wr;
#pragma unroll
                for (int bj = 0; bj < 2; ++bj)
#pragma unroll
                    for (int n = 0; n < 2; ++n)
#pragma unroll
                        for (int j = 0; j < 4; ++j) { const int ch = bj * HALF + c8 + 4 * n + j;
#pragma unroll
                            for (int ai = 0; ai < 2; ++ai) { u32x2 w; w.x = cvt_pk_bf16(acc[ai][bj][0][n][j], acc[ai][bj][1][n][j]); w.y = cvt_pk_bf16(acc[ai][bj][2][n][j], acc[ai][bj][3][n][j]);
                                *(u32x2*)(base + (size_t)ch * 8192 + 8 * ai) = w; } asm volatile("" ::: "memory"); }
            } else {
                bf16_t* base = GTc + (size_t)b * 256 * 512;
#pragma unroll
                for (int ai = 0; ai < 2; ++ai)
#pragma unroll
                    for (int m = 0; m < 4; ++m) { const int s = sbase + ai * HALF + m * 16;
#pragma unroll
                        for (int bj = 0; bj < 2; ++bj)
#pragma unroll
                            for (int n = 0; n < 2; ++n)
#pragma unroll
                                for (int j = 0; j < 4; ++j) { const int ch = bj * HALF + c8 + 4 * n + j; const bool ity = (ch & 1) && ((ch & 63) != 1);
                                    base[(size_t)ch * 512 + (ity ? 256 : 0) + s] = f2bf1(acc[ai][bj][m][n][j]); base[(size_t)ch * 512 + (ity ? 0 : 256) + s] = 0; } asm volatile("" ::: "memory"); }
            }
        }
    }
};


template <bool PERMK = false>
__device__ __forceinline__ void p0_transpose_item(const float* W, int K, int N, bf16* WT, int nblk, LAS float* scr, int item, int lane) {
    const int kb = item / nblk, nb = item % nblk, k0 = 64 * kb, n0 = 32 * nb;
    float tv[32];
#pragma unroll
    for (int i = 0; i < 32; ++i) { int kr = k0 + 2 * i + (lane >> 5); if (PERMK && kr >= 768) kr = (kr & ~63) + fsig(kr & 63); tv[i] = W[(size_t)kr * N + n0 + (lane & 31)]; }
#pragma unroll
    for (int i = 0; i < 32; ++i) scr[(2 * i + (lane >> 5)) * 33 + (lane & 31)] = tv[i];
    LDS_WAIT();
    const int c = lane & 7;
#pragma unroll
    for (int j = 0; j < 4; ++j) { const int n = (lane >> 3) + 8 * j; const LAS float* s = scr + (8 * c) * 33 + n;
        v4u o; o.x = cvt_pk_bf16(s[0 * 33], s[1 * 33]); o.y = cvt_pk_bf16(s[2 * 33], s[3 * 33]); o.z = cvt_pk_bf16(s[4 * 33], s[5 * 33]); o.w = cvt_pk_bf16(s[6 * 33], s[7 * 33]);
        *(v4u*)(WT + (size_t)(n0 + n) * K + k0 + 8 * c) = o; }
    LDS_WAIT();
}
__device__ __forceinline__ void p0_fold_item(const float* Win  , bf16* WT  , LAS float* scr, int item, int lane) {
    const int g = item >> 6, k0 = ((item >> 2) & 15) * 64, q0 = (item & 3) * 16;
    LAS float* cs = scr + 64 * 65; LAS float* sn = cs + 64;
    cs[lane] = cospif((float)lane / 32.f); sn[lane] = -sinpif((float)lane / 32.f);
#pragma unroll 1
    for (int i0 = 0; i0 < 64; i0 += 32) { float tv[32];
#pragma unroll
        for (int i = 0; i < 32; ++i) tv[i] = Win[(size_t)(k0 + i0 + i) * 1536 + 1280 + g * 64 + lane];
#pragma unroll
        for (int i = 0; i < 32; ++i) scr[(i0 + i) * 65 + lane] = tv[i]; }
    LDS_WAIT();
    for (int q = q0; q < q0 + 16; ++q) {
        const bool rtype = !(q & 1) || q == 1; const int jm = q == 1 ? 32 : (q >> 1);
        const LAS float* tab = rtype ? cs : sn;
        float ar = 0.f;
#pragma unroll 8
        for (int c = 0; c < 64; ++c) ar += scr[lane * 65 + c] * tab[(jm * c) & 63];
        WT[(size_t)(1280 + g * 64 + q) * 1024 + k0 + lane] = pg8::f2bf1(ar);
    }
    LDS_WAIT();
}
__device__ __forceinline__ void p0_mod_item(LAS unsigned char* lds, int item, const float* w_ada, const float* b_ada, float* MOD, int tid) {
    LAS float* sl = (LAS float*)lds; LAS float* red = sl + 9 * 1024;
    const int wave = tid >> 6, lane = tid & 63;
    const int l = item / 96, n0 = (item % 96) * 64;
    f32x4 acc[9];
#pragma unroll
    for (int r = 0; r < 9; ++r) acc[r] = (f32x4){0.f, 0.f, 0.f, 0.f};
    const int kr = lane >> 4, c4 = lane & 15;
    const float* W = w_ada + (size_t)l * 1024 * 6144 + n0 + c4 * 4;
#pragma unroll 1
    for (int k0 = 0; k0 < 128; k0 += 32) {
        f32x4 wv[8];
#pragma unroll
        for (int i = 0; i < 8; ++i) wv[i] = *(const f32x4*)(W + (size_t)(wave * 128 + k0 + i * 4 + kr) * 6144);
#pragma unroll
        for (int i = 0; i < 8; ++i) { const int k = wave * 128 + k0 + i * 4 + kr;
#pragma unroll
            for (int r = 0; r < 9; ++r) acc[r] = acc[r] + wv[i] * sl[r * 1024 + k]; }
    }
#pragma unroll
    for (int r = 0; r < 9; ++r)
#pragma unroll
        for (int e = 0; e < 4; ++e) { float v = acc[r][e]; v += __shfl_xor(v, 16); v += __shfl_xor(v, 32); acc[r][e] = v; }
    if (kr == 0) {
#pragma unroll
        for (int r = 0; r < 9; ++r)
#pragma unroll
            for (int e = 0; e < 4; ++e) red[(wave * 9 + r) * 64 + c4 * 4 + e] = acc[r][e];
    }
    __syncthreads();
    for (int i = tid; i < 576; i += 512) { const int r = i >> 6, n = i & 63; float s = b_ada[l * 6144 + n0 + n];
#pragma unroll
        for (int w = 0; w < 8; ++w) s += red[(w * 9 + r) * 64 + n];
        MOD[(size_t)(l * 9 + r) * 6144 + n0 + n] = s; }
    __syncthreads();
}
__device__ __forceinline__ void p0_prologue(const Args& a, LAS unsigned char* lds, int bid, int G, int tid) {
    asm volatile("" : "+v"(tid));
    unsigned char* ws = a.ws;
    const int wave = tid >> 6, lane = tid & 63;
    if (bid < 192) {
        LAS float* sl = (LAS float*)lds;
        for (int i = tid; i < 9 * 1024; i += 512) { const int r = i >> 10, k = i & 1023; const float v = r < 8 ? a.in[1][r * 1024 + k] : a.in[3][k]; sl[i] = v / (1.f + __expf(-v)); }
        __syncthreads();
        for (int it = bid; it < 192; it += G) p0_mod_item(lds, it, a.in[4], a.in[5], (float*)(ws + WS_MOD), tid);
    }
    __syncthreads();
    {
        const int gt = bid * 512 + tid, NT = G * 512;
        float* rc = (float*)(ws + WS_ROPEC); float* rs = (float*)(ws + WS_ROPES);
        for (int i = gt; i < 2048; i += NT) { const int pos = i >> 4, f = i & 15; const float invf = exp2f(-(float)f * (13.287712379549449f / 16.f));
            const float ang = (float)pos * invf; float rev = ang * 0.15915494309189535f; rev -= floorf(rev); rc[i] = cospif(2.f * rev); rs[i] = sinpif(2.f * rev); }
        float* tw = (float*)(ws + WS_TW);
        for (int i = gt; i < 8192; i += NT) { tw[2 * i] = cospif((float)i / 4096.f); tw[2 * i + 1] = sinpif((float)i / 4096.f); }
        bf16* d5 = (bf16*)(ws + WS_DFT512);
        for (int i = gt; i < 512 * 512; i += NT) { const int R = i >> 9, s1 = i & 511;
            float v; if (R < 256) v = cospif((float)((R * s1) & 511) / 256.f); else if (R == 256) v = (s1 & 1) ? -1.f : 1.f; else v = -sinpif((float)(((R - 256) * s1) & 511) / 256.f);
            d5[i] = pg8::f2bf1(v); }
        bf16* d2 = (bf16*)(ws + WS_DFT256);
        for (int i = gt; i < 256 * 512; i += NT) { const int k = i >> 9, C = i & 511, pc = C >> 8, s = C & 255; const int m = (k * s) & 255;
            d2[i] = pg8::f2bf1(pc == 0 ? cospif((float)m / 128.f) : sinpif((float)m / 128.f)); }
    }
    LAS float* scr = (LAS float*)(lds + wave * 17408);
    const int gw = bid * 8 + wave, NGW = G * 8;
    constexpr int PER = 640 + 256 + 512 + 2048 + 2048;
    for (int it = gw; it < 2 * PER; it += NGW) {
        const int l = it / PER; int r = it % PER;
        const float* win = a.in[7] + (size_t)l * 1024 * 1536; bf16* wtin = (bf16*)(ws + WS_WIN) + (size_t)l * NIN * 1024;
        if (r < 640) { p0_transpose_item(win, 1024, 1536, wtin, 40, scr, r, lane); continue; } r -= 640;
        if (r < 256) { p0_fold_item(win, wtin, scr, r, lane); continue; } r -= 256;
        if (r < 512) { p0_transpose_item<true>(a.in[13] + (size_t)l * 1024 * 1024, 1024, 1024, (bf16*)(ws + WS_WOUT) + (size_t)l * 1024 * 1024, 32, scr, r, lane); continue; } r -= 512;
        if (r < 2048) { p0_transpose_item(a.in[16] + (size_t)l * 1024 * 4096, 1024, 4096, (bf16*)(ws + WS_WFF1) + (size_t)l * 4096 * 1024, 128, scr, r, lane); continue; } r -= 2048;
        p0_transpose_item(a.in[17] + (size_t)l * 4096 * 1024, 4096, 1024, (bf16*)(ws + WS_WFF2) + (size_t)l * 1024 * 4096, 32, scr, r, lane);
    }
}

template <int NR, int NP = 0>
__device__ __forceinline__ void row_op(const float* xin, const bf16* upd, const float* gate, const float* gupd, float* xout, bf16* hxout,
                                       const float* gn, const float* sc, const float* sh, int lane,
                                       const bf16* upd2 = nullptr, const float* gate2 = nullptr, const float* gupd2 = nullptr) {
    asm volatile("" : "+v"(lane));
    f32x4 x[NR][4];
#pragma unroll
    for (int r = 0; r < NR; ++r)
#pragma unroll
        for (int j = 0; j < 4; ++j) x[r][j] = *(const f32x4*)(xin + (size_t)r * DM + j * 256 + lane * 4);
    if (upd) {
        f32x4 y[NR][4];
#pragma unroll
        for (int r = 0; r < NR; ++r)
#pragma unroll
            for (int j = 0; j < 4; ++j) {
                if (NP == 0) { const v2u w = *(const v2u*)(upd + (size_t)r * DM + j * 256 + lane * 4); y[r][j][0] = bflo(w.x); y[r][j][1] = bfhi(w.x); y[r][j][2] = bflo(w.y); y[r][j][3] = bfhi(w.y); }
                else { const float* pp = (const float*)upd + (size_t)r * DM + j * 256 + lane * 4; f32x4 t = *(const f32x4*)pp;
#pragma unroll
                    for (int p = 1; p < NP; ++p) t = t + *(const f32x4*)(pp + (size_t)p * 2048 * 1024);
                    y[r][j] = t; } }
        float rr[NR];
#pragma unroll
        for (int r = 0; r < NR; ++r) { float ss = 0.f;
#pragma unroll
            for (int j = 0; j < 4; ++j) ss += (y[r][j][0] * y[r][j][0] + y[r][j][1] * y[r][j][1]) + (y[r][j][2] * y[r][j][2] + y[r][j][3] * y[r][j][3]);
            rr[r] = ss; }
#pragma unroll
        for (int r = 0; r < NR; ++r) rr[r] = rsqrtf(wave_sum(rr[r]) * (1.f / 1024.f) + EPSN);
#pragma unroll
        for (int j = 0; j < 4; ++j) { const f32x4 g = *(const f32x4*)(gate + j * 256 + lane * 4) * *(const f32x4*)(gupd + j * 256 + lane * 4);
#pragma unroll
            for (int r = 0; r < NR; ++r) x[r][j] = x[r][j] + g * (y[r][j] * rr[r]); }
    }
    if (upd2) {
        f32x4 y[NR][4];
#pragma unroll
        for (int r = 0; r < NR; ++r)
#pragma unroll
            for (int j = 0; j < 4; ++j) { const v2u w = *(const v2u*)(upd2 + (size_t)r * DM + j * 256 + lane * 4); y[r][j][0] = bflo(w.x); y[r][j][1] = bfhi(w.x); y[r][j][2] = bflo(w.y); y[r][j][3] = bfhi(w.y); }
        float rr[NR];
#pragma unroll
        for (int r = 0; r < NR; ++r) { float ss = 0.f;
#pragma unroll
            for (int j = 0; j < 4; ++j) ss += (y[r][j][0] * y[r][j][0] + y[r][j][1] * y[r][j][1]) + (y[r][j][2] * y[r][j][2] + y[r][j][3] * y[r][j][3]);
            rr[r] = ss; }
#pragma unroll
        for (int r = 0; r < NR; ++r) rr[r] = rsqrtf(wave_sum(rr[r]) * (1.f / 1024.f) + EPSN);
#pragma unroll
        for (int j = 0; j < 4; ++j) { const f32x4 g = *(const f32x4*)(gate2 + j * 256 + lane * 4) * *(const f32x4*)(gupd2 + j * 256 + lane * 4);
#pragma unroll
            for (int r = 0; r < NR; ++r) x[r][j] = x[r][j] + g * (y[r][j] * rr[r]); }
    }
    if (xout) {
#pragma unroll
        for (int r = 0; r < NR; ++r)
#pragma unroll
            for (int j = 0; j < 4; ++j) *(f32x4*)(xout + (size_t)r * DM + j * 256 + lane * 4) = x[r][j];
    }
    if (hxout) {
        float rr[NR];
#pragma unroll
        for (int r = 0; r < NR; ++r) { float ss = 0.f;
#pragma unroll
            for (int j = 0; j < 4; ++j) ss += (x[r][j][0] * x[r][j][0] + x[r][j][1] * x[r][j][1]) + (x[r][j][2] * x[r][j][2] + x[r][j][3] * x[r][j][3]);
            rr[r] = ss; }
#pragma unroll
        for (int r = 0; r < NR; ++r) rr[r] = rsqrtf(wave_sum(rr[r]) * (1.f / 1024.f) + EPSN);
#pragma unroll
        for (int j = 0; j < 4; ++j) { const f32x4 g = *(const f32x4*)(gn + j * 256 + lane * 4) * (*(const f32x4*)(sc + j * 256 + lane * 4) + 1.f), s0 = *(const f32x4*)(sh + j * 256 + lane * 4);
#pragma unroll
            for (int r = 0; r < NR; ++r) { const f32x4 h = (x[r][j] * rr[r]) * g + s0; v2u w; w.x = cvt_pk_bf16(h[0], h[1]); w.y = cvt_pk_bf16(h[2], h[3]); *(v2u*)(hxout + (size_t)r * DM + j * 256 + lane * 4) = w; } }
    }
}
template <int NR>
__device__ __forceinline__ void mixnorm_rows(bf16* mix, const float* gmix, int lane, bf16* outp) {
    asm volatile("" : "+v"(lane));
    v4u w[NR][2];
#pragma unroll
    for (int r = 0; r < NR; ++r) { w[r][0] = *(const v4u*)(mix + (size_t)r * 1024 + lane * 16); w[r][1] = *(const v4u*)(mix + (size_t)r * 1024 + lane * 16 + 8); }
    f32x4 g[4];
#pragma unroll
    for (int q = 0; q < 4; ++q) g[q] = *(const f32x4*)(gmix + lane * 16 + q * 4);
    float rr[NR];
#pragma unroll
    for (int r = 0; r < NR; ++r) { float ss = 0.f;
#pragma unroll
        for (int h = 0; h < 2; ++h)
#pragma unroll
            for (int e = 0; e < 4; ++e) { const float a = bflo(w[r][h][e]), b = bfhi(w[r][h][e]); ss += a * a + b * b; }
        rr[r] = ss; }
#pragma unroll
    for (int r = 0; r < NR; ++r) { float ss = rr[r]; ss += __shfl_xor(ss, 1); ss += __shfl_xor(ss, 2); ss += __shfl_xor(ss, 4); ss += __shfl_xor(ss, 8);
        const float s16 = __shfl_xor(ss, 16); const float tot = lane < 32 ? ss + s16 : ss; const float cnt = lane < 32 ? 512.f : 256.f;
        rr[r] = rsqrtf(tot / cnt + EPSN); }
#pragma unroll
    for (int r = 0; r < NR; ++r) {
#pragma unroll
        for (int h = 0; h < 2; ++h)
#pragma unroll
            for (int e = 0; e < 4; ++e) { const int q = h * 2 + (e >> 1); const float a = bflo(w[r][h][e]) * rr[r] * g[q][(e & 1) * 2], b = bfhi(w[r][h][e]) * rr[r] * g[q][(e & 1) * 2 + 1]; w[r][h][e] = cvt_pk_bf16(a, b); }
        *(v4u*)(outp + (size_t)r * 1024 + lane * 16) = w[r][0]; *(v4u*)(outp + (size_t)r * 1024 + lane * 16 + 8) = w[r][1]; }
}

#define MFMA32(a, b, c) __builtin_amdgcn_mfma_f32_32x32x16_bf16(a, b, c, 0, 0, 0)
constexpr int AT_ST = 136;
constexpr int AT_HALF = 128 * AT_ST * 2;
constexpr int AT_BUF = 2 * AT_HALF;
constexpr int AT_RED = 2 * AT_BUF;
__device__ __forceinline__ void attn_units(LAS unsigned char* lds, const bf16* QB, const bf16* KB, const bf16* VT, const bf16* VTc, bf16* MIX, const float* sink, const float* gmix,
                                           int nunits, int G, int vb, int tid) {
    asm volatile("" : "+v"(tid));
    const int wave = __builtin_amdgcn_readfirstlane(tid >> 6), lane = tid & 63, h = wave >> 2, c = lane & 31, hh = lane >> 5;
    LAS float* red = (LAS float*)(lds + AT_RED);
    for (int L = vb; L < nunits; L += G) {
        const int uidx = (L < 1024 && (G & 7) == 0) ? (L & 7) * 128 + (L >> 3) : L;
        const bool isctx = uidx >= 1024; int b, nb, q0;
        if (!isctx) { b = uidx >> 7; nb = (uidx >> 1) & 63; q0 = nb * 128 + (uidx & 1) * 64; } else { const int v = uidx - 1024; b = v >> 2; nb = 0; q0 = (v & 3) * 64; }
        const size_t qrow0 = (size_t)(isctx ? ML + b * CTXL : b * SEQ) + q0;
        bf16x8 qf[2][4];
#pragma unroll
        for (int qs = 0; qs < 2; ++qs)
#pragma unroll
            for (int ks = 0; ks < 4; ++ks) qf[qs][ks] = *(const bf16x8*)(QB + (qrow0 + qs * 32 + c) * 512 + wave * 64 + ks * 16 + hh * 8);
        float mrun[2], lrun[2]; f32x16 o[2][2];
        const float sk = sink[wave] * LOG2E;
#pragma unroll
        for (int qs = 0; qs < 2; ++qs) { mrun[qs] = sk; lrun[qs] = 1.f;
#pragma unroll
            for (int dt = 0; dt < 2; ++dt)
#pragma unroll
                for (int r = 0; r < 16; ++r) o[qs][dt][r] = 0.f; }
        int s = isctx ? 3 : (nb == 0 ? 1 : 0);
        v4u pk[4], pv[4];
#define AT_ISSUE(ss) do { const bf16* kg; const bf16* vg; int ldv; \
            if ((ss) < 3) { const int kb0 = (nb - 1 + (ss)) * 128; kg = KB + (size_t)(b * SEQ + kb0) * 128; vg = VT + (size_t)(b * 128) * SEQ + kb0; ldv = SEQ; } \
            else { const int kb0 = ((ss) - 3) * 128; kg = KB + (size_t)(ML + b * CTXL + kb0) * 128; vg = VTc + (size_t)(b * 128) * CTXL + kb0; ldv = CTXL; } \
            _Pragma("unroll") for (int e = 0; e < 4; ++e) { const int i = tid + 512 * e, r = i >> 4, ch = i & 15; pk[e] = *(const v4u*)(kg + (size_t)r * 128 + ch * 8); pv[e] = *(const v4u*)(vg + (size_t)r * ldv + ch * 8); } } while (0)
#define AT_WRITE(bufo) do { _Pragma("unroll") for (int e = 0; e < 4; ++e) { const int i = tid + 512 * e, r = i >> 4, ch = i & 15; \
            *(LAS v4u*)(lds + (bufo) + (r * AT_ST + ch * 8) * 2) = pk[e]; *(LAS v4u*)(lds + (bufo) + AT_HALF + (r * AT_ST + ch * 8) * 2) = pv[e]; } } while (0)
        AT_ISSUE(s);
        __syncthreads();
        AT_WRITE(0);
        __syncthreads();
        int cur = 0;
        for (;;) {
            int sn = s + 1; if (sn == 2 && !isctx && nb == 63) sn = 3;
            if (sn <= 4) AT_ISSUE(sn);
            const LAS bf16* Ks = (const LAS bf16*)(lds + cur * AT_BUF); const LAS bf16* Vs = (const LAS bf16*)(lds + cur * AT_BUF + AT_HALF);
            int t_lo = 0, t_hi = 3; const int kb0 = (nb - 1 + s) * 128;
            if (s < 3) { const int a0 = q0 - 128 - kb0, a1 = q0 + 191 - kb0; t_lo = a0 > 0 ? a0 >> 5 : 0; t_hi = (a1 >> 5) < 3 ? (a1 >> 5) : 3; }
#pragma unroll 2
            for (int kt = t_lo; kt <= t_hi; ++kt) {
                bf16x8 kf[4];
#pragma unroll
                for (int ks = 0; ks < 4; ++ks) kf[ks] = *(const LAS bf16x8*)(Ks + (kt * 32 + c) * AT_ST + h * 64 + ks * 16 + hh * 8);
                bf16x8 vf[2][2];
#pragma unroll
                for (int dt = 0; dt < 2; ++dt)
#pragma unroll
                    for (int s2 = 0; s2 < 2; ++s2) { const LAS bf16* p = Vs + (h * 64 + dt * 32 + c) * AT_ST + kt * 32 + s2 * 16 + hh * 4;
                        const v2u lo = *(const LAS v2u*)p, hi = *(const LAS v2u*)(p + 8); v4u t; t.x = lo.x; t.y = lo.y; t.z = hi.x; t.w = hi.y; vf[dt][s2] = __builtin_bit_cast(bf16x8, t); }
                f32x16 st[2];
#pragma unroll
                for (int qs = 0; qs < 2; ++qs) {
                    const float nm = -mrun[qs];
#pragma unroll
                    for (int r = 0; r < 16; ++r) st[qs][r] = nm;
#pragma unroll
                    for (int ks = 0; ks < 4; ++ks) st[qs] = MFMA32(kf[ks], qf[qs][ks], st[qs]);
                }
                bf16x8 pb[2][2];
#pragma unroll
                for (int qs = 0; qs < 2; ++qs) {
                    float t[16];
#pragma unroll
                    for (int r = 0; r < 16; ++r) t[r] = st[qs][r];
                    const int kmin = kb0 + kt * 32, qmin = q0 + qs * 32;
                    if (s < 3 && (kmin - (qmin + 31) < -128 || kmin + 31 - qmin > 128)) {
                        const int base = kmin + 4 * hh - (qmin + c) + 128;
#pragma unroll
                        for (int r = 0; r < 16; ++r) { if ((unsigned)(base + (r & 3) + 8 * (r >> 2)) > 256u) t[r] = -1e30f; } }
                    float tmax = fmaxf(fmaxf(t[0], t[1]), t[2]);
#pragma unroll
                    for (int r = 3; r < 15; r += 2) tmax = fmaxf(fmaxf(tmax, t[r]), t[r + 1]);
                    tmax = fmaxf(tmax, t[15]);
                    { auto rr = __builtin_amdgcn_permlane32_swap(__float_as_uint(tmax), __float_as_uint(tmax), false, false); tmax = fmaxf(__uint_as_float(rr[0]), __uint_as_float(rr[1])); }
                    if (!__all(tmax <= 8.f)) {
                        const float delta = fmaxf(tmax, 0.f), alpha = __builtin_amdgcn_exp2f(-delta);
                        lrun[qs] *= alpha; mrun[qs] += delta;
#pragma unroll
                        for (int dt = 0; dt < 2; ++dt) o[qs][dt] = o[qs][dt] * alpha;
#pragma unroll
                        for (int r = 0; r < 16; ++r) t[r] -= delta;
                    }
                    float psum = 0.f;
#pragma unroll
                    for (int r = 0; r < 16; ++r) { t[r] = __builtin_amdgcn_exp2f(t[r]); psum += t[r]; }
                    { auto rr = __builtin_amdgcn_permlane32_swap(__float_as_uint(psum), __float_as_uint(psum), false, false); psum = __uint_as_float(rr[0]) + __uint_as_float(rr[1]); }
                    lrun[qs] += psum;
#pragma unroll
                    for (int s2 = 0; s2 < 2; ++s2) { v4u w; w.x = cvt_pk_bf16(t[8 * s2 + 0], t[8 * s2 + 1]); w.y = cvt_pk_bf16(t[8 * s2 + 2], t[8 * s2 + 3]); w.z = cvt_pk_bf16(t[8 * s2 + 4], t[8 * s2 + 5]); w.w = cvt_pk_bf16(t[8 * s2 + 6], t[8 * s2 + 7]);
                        pb[qs][s2] = __builtin_bit_cast(bf16x8, w); }
#pragma unroll
                    for (int s2 = 0; s2 < 2; ++s2)
#pragma unroll
                        for (int dt = 0; dt < 2; ++dt) o[qs][dt] = MFMA32(vf[dt][s2], pb[qs][s2], o[qs][dt]);
                    __builtin_amdgcn_sched_barrier(0);
                }
            }
            if (sn > 4) break;
            AT_WRITE((cur ^ 1) * AT_BUF);
            __syncthreads();
            cur ^= 1; s = sn;
        }
#undef AT_ISSUE
#undef AT_WRITE
        float ssq[2];
#pragma unroll
        for (int qs = 0; qs < 2; ++qs) { const float inv = 1.f / lrun[qs]; float ss = 0.f;
#pragma unroll
            for (int dt = 0; dt < 2; ++dt) { o[qs][dt] = o[qs][dt] * inv;
#pragma unroll
                for (int r = 0; r < 16; ++r) ss += o[qs][dt][r] * o[qs][dt][r]; }
            { auto rr = __builtin_amdgcn_permlane32_swap(__float_as_uint(ss), __float_as_uint(ss), false, false); ss = __uint_as_float(rr[0]) + __uint_as_float(rr[1]); }
            ssq[qs] = ss; if (hh == 0) red[wave * 64 + qs * 32 + c] = ss; }
        __syncthreads();
        LAS bf16* otile = (LAS bf16*)(lds + wave * 9216);
#pragma unroll
        for (int qs = 0; qs < 2; ++qs) { float tot = 0.f;
#pragma unroll
            for (int w = 0; w < 8; ++w) tot += red[w * 64 + qs * 32 + c];
            const float rn = rsqrtf(tot * (1.f / 512.f) + EPSN);
#pragma unroll
            for (int dt = 0; dt < 2; ++dt)
#pragma unroll
                for (int rg = 0; rg < 4; ++rg) { const f32x4 gm = *(const f32x4*)(gmix + wave * 64 + dt * 32 + rg * 8 + hh * 4);
                    v2u w; w.x = cvt_pk_bf16(o[qs][dt][4 * rg] * rn * gm[0], o[qs][dt][4 * rg + 1] * rn * gm[1]); w.y = cvt_pk_bf16(o[qs][dt][4 * rg + 2] * rn * gm[2], o[qs][dt][4 * rg + 3] * rn * gm[3]);
                    *(LAS v2u*)(otile + (qs * 32 + c) * 72 + dt * 32 + rg * 8 + hh * 4) = w; } }
        LDS_WAIT();
#pragma unroll
        for (int it = 0; it < 8; ++it) { const int r = it * 8 + (lane >> 3), ch = lane & 7; const v4u v = *(const LAS v4u*)(otile + r * 72 + ch * 8);
            *(v4u*)(MIX + (qrow0 + r) * 1024 + wave * 64 + ch * 8) = v; }
    }
    __syncthreads();
}

__device__ __forceinline__ void sgu_units(LAS unsigned char* lds, const bf16* UB, const bf16* GVT, const bf16* GVTc, bf16* MIX, const float* wsgu, const float* bsgu, const float* gsgu, const float* gmix,
                                          int nchunks, int G, int bid, int tid) {
    asm volatile("" : "+v"(tid));
    const int wave = __builtin_amdgcn_readfirstlane(tid >> 6), lane = tid & 63, hd = wave >> 1, ph = wave & 1, c = lane & 31, h2 = lane >> 5;
    LAS float* rq = (LAS float*)lds + wave * 128;
    bf16x8 bfr[2][8];
#pragma unroll
    for (int ps = 0; ps < 2; ++ps)
#pragma unroll
        for (int ks = 0; ks < 8; ++ks) { const float* wp = wsgu + ((size_t)(hd * 128 + ph * 64 + ps * 32 + c)) * 128 + ks * 16 + h2 * 8; const f32x4 w0 = *(const f32x4*)wp, w1 = *(const f32x4*)(wp + 4);
            v4u w; w.x = cvt_pk_bf16(w0[0], w0[1]); w.y = cvt_pk_bf16(w0[2], w0[3]); w.z = cvt_pk_bf16(w1[0], w1[1]); w.w = cvt_pk_bf16(w1[2], w1[3]); bfr[ps][ks] = __builtin_bit_cast(bf16x8, w); }
    for (int L = bid; L < nchunks; L += G) {
        const int chunk = (L < 512 && (G & 7) == 0) ? (L & 7) * 64 + (L >> 3) : L;
        const bool isctx = chunk >= 512; const int b = isctx ? (chunk - 512) >> 1 : chunk >> 6, s0 = isctx ? ((chunk - 512) & 1) * 128 : (chunk & 63) * 128;
        const int ld = isctx ? CTXL : SEQ;
        const bf16* Gt = (isctx ? GVTc + ((size_t)(b * 256 + hd * 64)) * CTXL : GVT + ((size_t)(b * 256 + hd * 64)) * SEQ) + s0;
        float sa = 0.f, sb = 0.f;
#pragma unroll 1
        for (int d0 = 0; d0 < 64; d0 += 32) { unsigned gv[32];
#pragma unroll
            for (int d = 0; d < 32; ++d) gv[d] = *(const unsigned*)(Gt + (size_t)(d0 + d) * ld + 2 * lane);
#pragma unroll
            for (int d = 0; d < 32; ++d) { const float x0 = bflo(gv[d]), x1 = bfhi(gv[d]); sa += x0 * x0; sb += x1 * x1; } }
        LDS_WAIT();
        rq[2 * lane] = rsqrtf(sa * (1.f / 64.f) + EPSN); rq[2 * lane + 1] = rsqrtf(sb * (1.f / 64.f) + EPSN);
        LDS_WAIT();
        f32x16 o[2][2];
#pragma unroll
        for (int dt = 0; dt < 2; ++dt)
#pragma unroll
            for (int ps = 0; ps < 2; ++ps)
#pragma unroll
                for (int r = 0; r < 16; ++r) o[dt][ps][r] = 0.f;
        v4u afr[2][8];
#pragma unroll
        for (int ks = 0; ks < 8; ++ks)
#pragma unroll
            for (int dt = 0; dt < 2; ++dt) afr[dt][ks] = *(const v4u*)(Gt + (size_t)(dt * 32 + c) * ld + ks * 16 + h2 * 8);
        LAS bf16* utile = (LAS bf16*)(lds + 8192 + wave * 9216);
        { v4u ut[8];
#pragma unroll
          for (int it = 0; it < 8; ++it) ut[it] = *(const v4u*)(UB + ((size_t)chunk * 128 + ph * 64 + it * 8 + (lane >> 3)) * 256 + hd * 64 + (lane & 7) * 8);
#pragma unroll
          for (int it = 0; it < 8; ++it) *(LAS v4u*)(utile + (it * 8 + (lane >> 3)) * 72 + (lane & 7) * 8) = ut[it]; }
#pragma unroll
        for (int ks = 0; ks < 8; ++ks) {
            const f32x4 r0 = *(const LAS f32x4*)(rq + ks * 16 + h2 * 8), r1 = *(const LAS f32x4*)(rq + ks * 16 + h2 * 8 + 4);
#pragma unroll
            for (int dt = 0; dt < 2; ++dt) { const v4u g = afr[dt][ks]; v4u w;
                w.x = cvt_pk_bf16(bflo(g.x) * r0[0], bfhi(g.x) * r0[1]); w.y = cvt_pk_bf16(bflo(g.y) * r0[2], bfhi(g.y) * r0[3]); w.z = cvt_pk_bf16(bflo(g.z) * r1[0], bfhi(g.z) * r1[1]); w.w = cvt_pk_bf16(bflo(g.w) * r1[2], bfhi(g.w) * r1[3]);
                const bf16x8 af = __builtin_bit_cast(bf16x8, w);
#pragma unroll
                for (int ps = 0; ps < 2; ++ps) o[dt][ps] = MFMA32(af, bfr[ps][ks], o[dt][ps]); }
        }
        LAS float* red2 = (LAS float*)(lds + 4096);
#pragma unroll
        for (int ps = 0; ps < 2; ++ps) { const int p = ph * 64 + ps * 32 + c; const size_t row = (size_t)chunk * 128 + p; const float bs = bsgu[hd * 128 + p]; float ss = 0.f;
#pragma unroll
            for (int dt = 0; dt < 2; ++dt)
#pragma unroll
                for (int rg = 0; rg < 4; ++rg) { const int d0 = dt * 32 + rg * 8 + h2 * 4; const f32x4 gs = *(const f32x4*)(gsgu + hd * 64 + d0);
                    const v2u uw = *(const LAS v2u*)(utile + (ps * 32 + c) * 72 + d0);
                    const float o0 = bflo(uw.x) * (gs[0] * o[dt][ps][4 * rg] + bs), o1 = bfhi(uw.x) * (gs[1] * o[dt][ps][4 * rg + 1] + bs), o2 = bflo(uw.y) * (gs[2] * o[dt][ps][4 * rg + 2] + bs), o3 = bfhi(uw.y) * (gs[3] * o[dt][ps][4 * rg + 3] + bs);
                    o[dt][ps][4 * rg] = o0; o[dt][ps][4 * rg + 1] = o1; o[dt][ps][4 * rg + 2] = o2; o[dt][ps][4 * rg + 3] = o3; ss += (o0 * o0 + o1 * o1) + (o2 * o2 + o3 * o3); }
            { auto rr = __builtin_amdgcn_permlane32_swap(__float_as_uint(ss), __float_as_uint(ss), false, false); ss = __uint_as_float(rr[0]) + __uint_as_float(rr[1]); }
            if (h2 == 0) red2[hd * 128 + p] = ss; }
        __syncthreads();
        LAS bf16* otile = (LAS bf16*)(lds + 8192 + wave * 9216);
#pragma unroll
        for (int ps = 0; ps < 2; ++ps) { const int p = ph * 64 + ps * 32 + c;
            const float rn = rsqrtf((red2[p] + red2[128 + p] + red2[256 + p] + red2[384 + p]) * (1.f / 256.f) + EPSN);
#pragma unroll
            for (int dt = 0; dt < 2; ++dt)
#pragma unroll
                for (int rg = 0; rg < 4; ++rg) { const int d0 = dt * 32 + rg * 8 + h2 * 4; const f32x4 gm = *(const f32x4*)(gmix + 512 + hd * 64 + d0);
                    v2u w; w.x = cvt_pk_bf16(o[dt][ps][4 * rg] * rn * gm[0], o[dt][ps][4 * rg + 1] * rn * gm[1]); w.y = cvt_pk_bf16(o[dt][ps][4 * rg + 2] * rn * gm[2], o[dt][ps][4 * rg + 3] * rn * gm[3]);
                    *(LAS v2u*)(otile + (ps * 32 + c) * 72 + d0) = w; } }
        LDS_WAIT();
#pragma unroll
        for (int it = 0; it < 8; ++it) { const int r = it * 8 + (lane >> 3), ch = lane & 7; const v4u v = *(const LAS v4u*)(otile + r * 72 + ch * 8);
            *(v4u*)(MIX + ((size_t)chunk * 128 + ph * 64 + r) * 1024 + 512 + hd * 64 + ch * 8) = v; }
        LDS_WAIT();
        __syncthreads();
    }
}

__device__ __forceinline__ void fourier_stage2(LAS unsigned char* lds, int wave, const bf16* Tp, bf16* MIX, const float* gmix, int gw, int NGW, int lane) {
    asm volatile("" : "+v"(lane));
    LAS bf16* slab = (LAS bf16*)(lds + wave * 8448);
    const int k2 = lane & 15, kq = lane >> 4, prt = kq >> 1, s2b = (kq & 1) * 8;
    constexpr float NRM = 0.0013810679320049757f;
    for (int item = gw; item < 4096; item += NGW) {
        const int k1 = item >> 3, b = item & 7, k = k1 + 512 * k2;
        const int k1p = k1 <= 256 ? k1 : 512 - k1;
        const float imf = (k1p == 0 || k1p == 256) ? 0.f : (k1 > 256 ? -1.f : 1.f);
        const int trow = prt == 0 ? k1p : ((k1p == 0 || k1p == 256) ? 0 : 256 + k1p);
        unsigned wr_[4], wi_[4];
#pragma unroll
        for (int jj = 0; jj < 4; ++jj) { float c[2], sn[2];
#pragma unroll
            for (int u = 0; u < 2; ++u) { const int n = (k * (s2b + 2 * jj + u)) & 8191; const float rev = (float)n * (1.f / 8192.f); c[u] = __builtin_amdgcn_cosf(rev); sn[u] = __builtin_amdgcn_sinf(rev); }
            wr_[jj] = prt == 0 ? cvt_pk_bf16(c[0], c[1]) : cvt_pk_bf16(imf * sn[0], imf * sn[1]);
            wi_[jj] = prt == 0 ? cvt_pk_bf16(sn[0], sn[1]) : cvt_pk_bf16(-imf * c[0], -imf * c[1]); }
        v4u t0; t0.x = wr_[0]; t0.y = wr_[1]; t0.z = wr_[2]; t0.w = wr_[3]; const bf16x8 bR = __builtin_bit_cast(bf16x8, t0);
        v4u t1; t1.x = wi_[0]; t1.y = wi_[1]; t1.z = wi_[2]; t1.w = wi_[3]; const bf16x8 bI = __builtin_bit_cast(bf16x8, t1);
        const bf16* ap = Tp + (size_t)trow * 32768 + ((size_t)(b * 256 + k2) * 16 + s2b);
        bf16x8 af[16];
#pragma unroll
        for (int t = 0; t < 16; ++t) af[t] = *(const bf16x8*)(ap + t * 256);
        f32x4 y[16]; float ss = 0.f;
#pragma unroll
        for (int t = 0; t < 16; ++t) {
            const f32x4 z4 = {0.f, 0.f, 0.f, 0.f};
            const f32x4 aR = __builtin_amdgcn_mfma_f32_16x16x32_bf16(af[t], bR, z4, 0, 0, 0), aI = __builtin_amdgcn_mfma_f32_16x16x32_bf16(af[t], bI, z4, 0, 0, 0);
            const bool special = ((t & 3) == 0) && kq == 0;
            const float p0 = aR[0] * NRM, p1 = (special ? aR[1] : aI[1]) * NRM, p2 = aR[2] * NRM, p3 = aI[3] * NRM;
            f32x4 o; o[0] = special ? p0 : p0 + p1; o[1] = special ? p1 : p0 - p1; o[2] = p2 + p3; o[3] = p2 - p3;
            y[t] = o; ss += (o[0] * o[0] + o[1] * o[1]) + (o[2] * o[2] + o[3] * o[3]); }
        ss += __shfl_xor(ss, 16); ss += __shfl_xor(ss, 32);
        const float rn = rsqrtf(ss * (1.f / 256.f) + EPSN);
#pragma unroll
        for (int t = 0; t < 16; ++t) { const float* gb = gmix + 768 + (t >> 2) * 64; const int p = 16 * (t & 3) + 4 * kq;
            v2u w; w.x = cvt_pk_bf16(y[t][0] * rn * gb[fsig(p)], y[t][1] * rn * gb[fsig(p + 1)]); w.y = cvt_pk_bf16(y[t][2] * rn * gb[fsig(p + 2)], y[t][3] * rn * gb[fsig(p + 3)]);
            *(LAS v2u*)(slab + k2 * 264 + 16 * t + 4 * kq) = w; }
        LDS_WAIT();
#pragma unroll
        for (int it = 0; it < 8; ++it) { const int r = it * 2 + (lane >> 5), ch = lane & 31; const v4u v = *(const LAS v4u*)(slab + r * 264 + ch * 8);
            *(v4u*)(MIX + ((size_t)b * SEQ + k1 + 512 * r) * 1024 + 768 + ch * 8) = v; }
        LDS_WAIT();
    }
}
__device__ __forceinline__ void ctx_fourier_norm(bf16* MIX, const float* gmix, int gw, int NGW, int lane) {
    asm volatile("" : "+v"(lane));
    const int pg = (lane * 4) & 63, grp = lane >> 4;
    for (int row = ML + gw; row < MT; row += NGW) { bf16* p = MIX + (size_t)row * 1024 + 768 + lane * 4;
        const v2u w = *(const v2u*)p; const float a0 = bflo(w.x), b0 = bfhi(w.x), a1 = bflo(w.y), b1 = bfhi(w.y);
        const bool pass = pg == 0;
        const float v0 = pass ? a0 : a0 + b0, v1 = pass ? b0 : a0 - b0, v2 = a1 + b1, v3 = a1 - b1;
        const float rn = rsqrtf(wave_sum((v0 * v0 + v1 * v1) + (v2 * v2 + v3 * v3)) * (1.f / 256.f) + EPSN);
        const float* gb = gmix + 768 + grp * 64;
        v2u o; o.x = cvt_pk_bf16(v0 * rn * gb[fsig(pg)], v1 * rn * gb[fsig(pg + 1)]); o.y = cvt_pk_bf16(v2 * rn * gb[fsig(pg + 2)], v3 * rn * gb[fsig(pg + 3)]); *(v2u*)p = o; }
}

#define XB_TMO      128
#define XB_XCNT(j)  (256  + 64 * (j))
#define XB_XSUB(j)  (1280 + 64 * (j))
#define XB_XGEN(j)  (2304 + 64 * (j))
#define XB_TOP      3328
#define XB_TOPGEN   3392
#define XCD_BAR_WORDS 3456
#define XB_SPIN_CAP (1u << 18)

__device__ __forceinline__ unsigned xb_ld(unsigned* p)              { return __hip_atomic_load(p, __ATOMIC_RELAXED, __HIP_MEMORY_SCOPE_AGENT); }
__device__ __forceinline__ unsigned xb_add(unsigned* p, unsigned v) { return __hip_atomic_fetch_add(p, v, __ATOMIC_RELAXED, __HIP_MEMORY_SCOPE_AGENT); }
__device__ __forceinline__ unsigned xb_xcc_id() { return (unsigned)__builtin_amdgcn_s_getreg((3 << 11) | 20) & 0xFu; }
#define XB_SPIN(cond, bar) do { unsigned _sp = 0; while (cond) { __builtin_amdgcn_s_sleep(1); \
    if ((++_sp & 255u) == 0u) { if (xb_ld(&(bar)[XB_TMO])) break; if (_sp > XB_SPIN_CAP) { atomicAdd(&(bar)[XB_TMO], 1u); break; } } } } while (0)

struct XcdBarrier {
    unsigned* bar; unsigned x;
    volatile LAS unsigned* st;
};

__device__ __forceinline__ XcdBarrier xcd_barrier_post(unsigned* bar, volatile LAS unsigned* st) {
    XcdBarrier b; b.bar = bar; b.x = xb_xcc_id(); b.st = st;
    if (threadIdx.x == 0) (void)xb_add(&bar[XB_XCNT(b.x)], 1u);
    return b;
}
__device__ __forceinline__ void xcd_barrier_complete(unsigned* bar, unsigned x, unsigned& nloc, unsigned& nx) {
    const unsigned G = gridDim.x * gridDim.y * gridDim.z;
    unsigned sum, cnt, mine, sp = 0u;
    for (;;) {
        sum = 0u; cnt = 0u; mine = 0u;
#pragma unroll
        for (unsigned j = 0; j < 16; ++j) { const unsigned c = xb_ld(&bar[XB_XCNT(j)]); sum += c; cnt += (c > 0u) ? 1u : 0u; mine = (j == x) ? c : mine; }
        if (sum == G) break;
        __builtin_amdgcn_s_sleep(1);
        if ((++sp & 255u) == 0u) { if (xb_ld(&bar[XB_TMO])) break; if (sp > XB_SPIN_CAP) { atomicAdd(&bar[XB_TMO], 1u); break; } }
    }
    nloc = mine > 0u ? mine : 1u; nx = cnt > 0u ? cnt : 1u;
}

__device__ __forceinline__ void xcd_barrier(const XcdBarrier& b) {
    asm volatile("s_waitcnt vmcnt(0)" ::: "memory");
    __syncthreads();
    if (threadIdx.x == 0) {
        unsigned* bar = b.bar;
        __builtin_amdgcn_s_waitcnt(0);
        unsigned nloc = b.st[0], nx = b.st[1];
        if (nloc == 0u) { xcd_barrier_complete(bar, b.x, nloc, nx); b.st[0] = nloc; b.st[1] = nx; }
        const unsigned old = xb_add(&bar[XB_XSUB(b.x)], 1u);
        const unsigned gen = old / nloc;
        if (old + 1u == (gen + 1u) * nloc) {
            __builtin_amdgcn_fence(__ATOMIC_RELEASE, "agent");
            asm volatile("s_waitcnt vmcnt(0)" ::: "memory");
            const unsigned og = xb_add(&bar[XB_TOP], 1u);
            const unsigned tg = og / nx;
            if (og + 1u == (tg + 1u) * nx) xb_add(&bar[XB_TOPGEN], 1u);
            else XB_SPIN(xb_ld(&bar[XB_TOPGEN]) == tg, bar);
            __builtin_amdgcn_fence(__ATOMIC_ACQUIRE, "agent");
            xb_add(&bar[XB_XGEN(b.x)], 1u);
            asm volatile("s_waitcnt vmcnt(0)" ::: "memory");
        } else {
            XB_SPIN(xb_ld(&bar[XB_XGEN(b.x)]) == gen, bar);
            __builtin_amdgcn_fence(__ATOMIC_ACQUIRE, "agent");
            asm volatile("s_waitcnt vmcnt(0)" ::: "memory");
        }
    }
    __syncthreads();
}

__global__ void __launch_bounds__(512, 2) fwd_megakernel(Args a) {
    extern __shared__ __attribute__((aligned(16))) unsigned char lds_raw[];
    LAS unsigned char* lds = (LAS unsigned char*)lds_raw;
    cg::grid_group grid = cg::this_grid();
#define GSYNC() do { XcdBarrier xb_; xb_.bar = (unsigned*)(ws + WS_BAR); xb_.x = xb_xcc_id(); xb_.st = (volatile LAS unsigned*)(lds + LDS_BARST); xcd_barrier(xb_); } while (0)
    const int tid = threadIdx.x, lane = tid & 63, wave = __builtin_amdgcn_readfirstlane(tid >> 6);
    const int bid = blockIdx.x, G = gridDim.x;
    const int gw = bid * 8 + wave, NGW = G * 8;
    unsigned char* ws = a.ws;
    const float* MOD = (const float*)(ws + WS_MOD);
    bf16* HX = (bf16*)(ws + WS_HX); bf16* YB = (bf16*)(ws + WS_XR);
    float* X1C = (float*)(ws + WS_XR + 132 * MiB) - (size_t)ML * DM;
    bf16* MIX = (bf16*)(ws + WS_MIX);
    if (bid == 0) { for (int i = tid; i < XCD_BAR_WORDS; i += 512) __hip_atomic_store((unsigned*)(ws + WS_BAR) + i, 0u, __ATOMIC_RELAXED, __HIP_MEMORY_SCOPE_AGENT); }

#ifndef SKIP_P0
    p0_prologue(a, lds, bid, G, tid);
#endif
    __syncthreads();
    if (tid < 2) ((volatile LAS unsigned*)(lds + LDS_BARST))[tid] = 0u;
    grid.sync();
    (void)xcd_barrier_post((unsigned*)(ws + WS_BAR), (volatile LAS unsigned*)(lds + LDS_BARST));
    __syncthreads();
    for (int row = gw * 4; row < MT; row += NGW * 4) {
        const int mr = row < ML ? row >> 13 : 8; const float* md = MOD + (size_t)mr * 6144;
        const float* xin = row < ML ? a.in[0] + (size_t)row * DM : a.in[2] + (size_t)(row - ML) * DM;
#ifdef PROBE_ROWS
        row_op<4>(xin, nullptr, nullptr, nullptr, nullptr, (bf16*)(ws + WS_C) + (size_t)row * DM, a.in[6], md + 1024, md, lane);
#endif
        row_op<4>(xin, nullptr, nullptr, nullptr, nullptr, HX + (size_t)row * DM, a.in[6], md + 1024, md, lane);
    }
    GSYNC();
#pragma unroll 1
    for (int l = 0; l < 2; ++l) {
        const bool last = l == 1;
        const int MR = last ? ML : MT;
        const float* modl = MOD + (size_t)l * 9 * 6144;
#ifndef SKIP_G1
        {
            int fM = MT, fN = NIN, fK = DM; asm volatile("" : "+s"(fM), "+s"(fN), "+s"(fK));
            pg8::Gemm g{HX, (const bf16*)(ws + WS_WIN) + (size_t)l * NIN * 1024, fM, fN, fK}; pg8::StaticOrder S; S.init(fM, fN, G, bid);
            EpiIn E{ws, last ? 1 : 0};
            pg8::gemm_phase<EpiIn, pg8::StaticOrder, true, true>(lds, g, S, E);
        }
#endif
        GSYNC();
        const float* gmixl = a.in[12] + l * 1024;
        attn_units(lds, (const bf16*)(ws + WS_QB), (const bf16*)(ws + WS_KB), (const bf16*)(ws + WS_VT), (const bf16*)(ws + WS_VTC), MIX, a.in[8] + l * 8, gmixl, last ? 1024 : 1056, G, bid, tid);
        sgu_units(lds, (const bf16*)(ws + WS_UB), (const bf16*)(ws + WS_GVT), (const bf16*)(ws + WS_GVTC), MIX, a.in[9] + (size_t)l * 4 * 128 * 128, a.in[10] + l * 512, a.in[11] + l * 256, gmixl,
                  last ? 512 : 528, G, (bid + 224) % G, tid);
        __syncthreads();
#ifndef SKIP_F1
        {
            int fM = 512, fN = 32768, fK = 512; asm volatile("" : "+s"(fM), "+s"(fN), "+s"(fK));
            pg8::Gemm g{(const bf16*)(ws + WS_DFT512), (const bf16*)(ws + WS_GT), fM, fN, fK}; pg8::StaticOrder S; S.init(fM, fN, G, bid);
            pg8::EpiPlain<0, false> E{(bf16*)(ws + WS_TP), fN, 1.f};
            pg8::gemm_phase<pg8::EpiPlain<0, false>, pg8::StaticOrder, true, true>(lds, g, S, E);
        }
#endif
#ifndef SKIP_CF
        if (!last) {
            int fM = 256, fN = 2048, fK = 512, fL = 1024; asm volatile("" : "+s"(fM), "+s"(fN), "+s"(fK), "+s"(fL));
            pg8::Gemm g{(const bf16*)(ws + WS_DFT256), (const bf16*)(ws + WS_GTC), fM, fN, fK}; pg8::StaticOrder S; S.init(fM, fN, G, (bid + 208) % G);
            pg8::EpiPlain<0, true> E{MIX + (size_t)ML * 1024 + 768, fL, 0.0078125f};
            pg8::gemm_phase<pg8::EpiPlain<0, true>, pg8::StaticOrder, true, true>(lds, g, S, E);
        }
#endif
        GSYNC();
        fourier_stage2(lds, wave, (const bf16*)(ws + WS_TP), MIX, gmixl, gw, NGW, lane);
        if (!last) ctx_fourier_norm(MIX, gmixl, gw, NGW, lane);
        GSYNC();
#ifndef SKIP_G2
        {
            pg8::Gemm g{MIX, (const bf16*)(ws + WS_WOUT) + (size_t)l * 1024 * 1024, ML, DM, DM, 0}; pg8::StaticOrder S; S.init(ML, DM, G, bid);
            pg8::EpiPlain<0, false> E{YB, DM, 1.f};
            pg8::gemm_phase<pg8::EpiPlain<0, false>, pg8::StaticOrder, true, true>(lds, g, S, E);
        }
        if (!last) {
            int fK = 256, fL = DM; asm volatile("" : "+s"(fK), "+s"(fL));
            pg8::Gemm g{MIX, (const bf16*)(ws + WS_WOUT) + (size_t)l * 1024 * 1024, MT, DM, fK, fL}; pg8::SplitKOrder S{G, bid, 256, 8, 4, 4, fK * 2};
            pg8::EpiPart E{(float*)(ws + WS_PART), fL, fK * 2, 256, (size_t)2048 * 1024};
            pg8::gemm_phase<pg8::EpiPart, pg8::SplitKOrder, true, true>(lds, g, S, E);
        }
#endif
        GSYNC();
        for (int row = gw * 4; row < ML; row += NGW * 4) {
            const float* md = modl + (size_t)(row >> 13) * 6144;
            const float* xin = l == 0 ? a.in[0] + (size_t)row * DM : a.out + (size_t)row * DM;
            row_op<4>(xin, YB + (size_t)row * DM, md + 2048, a.in[14] + l * 1024, nullptr, HX + (size_t)row * DM, a.in[15] + l * 1024, md + 4096, md + 3072, lane);
        }
        if (!last) for (int row = ML + gw * 2; row < MT; row += NGW * 2) {
            const float* md = modl + (size_t)8 * 6144;
            row_op<2, 4>(a.in[2] + (size_t)(row - ML) * DM, (const bf16*)((const float*)(ws + WS_PART) + (size_t)(row - ML) * DM), md + 2048, a.in[14] + l * 1024, X1C + (size_t)row * DM, HX + (size_t)row * DM, a.in[15] + l * 1024, md + 4096, md + 3072, lane);
        }
        GSYNC();
#ifndef SKIP_G3
        {
            pg8::Gemm g{HX, (const bf16*)(ws + WS_WFF1) + (size_t)l * 4096 * 1024, MR, DFF, DM}; pg8::StaticOrder S; S.init(MR, DFF, G, bid);
            pg8::EpiPlain<1, false> E{(bf16*)(ws + WS_H1), DFF, 1.f};
            pg8::gemm_phase<pg8::EpiPlain<1, false>, pg8::StaticOrder, true, true>(lds, g, S, E);
        }
#endif
        GSYNC();
#ifndef SKIP_G4
        {
            pg8::Gemm g{(const bf16*)(ws + WS_H1), (const bf16*)(ws + WS_WFF2) + (size_t)l * 1024 * 4096, ML, DM, DFF, 0}; pg8::StaticOrder S; S.init(ML, DM, G, bid);
            pg8::EpiPlain<0, false> E{HX, DM, 1.f};
            pg8::gemm_phase<pg8::EpiPlain<0, false>, pg8::StaticOrder, true, true>(lds, g, S, E);
        }
        if (!last) {
            int fK = 1024, fL = DFF, fC = DM; asm volatile("" : "+s"(fK), "+s"(fL), "+s"(fC));
            pg8::Gemm g{(const bf16*)(ws + WS_H1), (const bf16*)(ws + WS_WFF2) + (size_t)l * 1024 * 4096, MT, DM, fK, fL}; pg8::SplitKOrder S{G, bid, 256, 8, 4, 4, fK * 2};
            pg8::EpiPart E{(float*)(ws + WS_PART), fC, fK * 2, 256, (size_t)2048 * 1024};
            pg8::gemm_phase<pg8::EpiPart, pg8::SplitKOrder, true, true>(lds, g, S, E);
        }
#endif
        GSYNC();
        for (int row = gw * 4; row < ML; row += NGW * 4) {
            const int mr = row >> 13; const float* md = modl + (size_t)mr * 6144;
            const float* xin = l == 0 ? a.in[0] + (size_t)row * DM : a.out + (size_t)row * DM;
            if (!last) { const float* mdn = MOD + (size_t)(9 + mr) * 6144;
                row_op<4>(xin, YB + (size_t)row * DM, md + 2048, a.in[14] + l * 1024, a.out + (size_t)row * DM, HX + (size_t)row * DM, a.in[6] + 1024, mdn + 1024, mdn, lane,
                          HX + (size_t)row * DM, md + 5120, a.in[18] + l * 1024);
            } else row_op<4>(xin, YB + (size_t)row * DM, md + 2048, a.in[14] + l * 1024, a.out + (size_t)row * DM, nullptr, nullptr, nullptr, nullptr, lane,
                             HX + (size_t)row * DM, md + 5120, a.in[18] + l * 1024);
        }
        if (!last) for (int row = ML + gw * 2; row < MT; row += NGW * 2) {
            const float* md = modl + (size_t)8 * 6144; const float* mdn = MOD + (size_t)(9 + 8) * 6144;
            row_op<2, 4>(X1C + (size_t)row * DM, (const bf16*)((const float*)(ws + WS_PART) + (size_t)(row - ML) * DM), md + 5120, a.in[18] + l * 1024, nullptr, HX + (size_t)row * DM, a.in[6] + 1024, mdn + 1024, mdn, lane);
        }
        if (!last) GSYNC();
    }
}

extern "C" void kernel_launch(void* const* d_in, const int* in_sizes, int n_in, void* d_out, int out_size, void* d_ws, size_t ws_size, hipStream_t stream) {
    static int grid = 0;
    if (grid == 0) {
        if (n_in != 19 || ws_size < WS_TOTAL) { fprintf(stderr, "kernel_launch: unexpected n_in %d / ws %zu\n", n_in, ws_size); grid = -1; return; }
        int dev = 0, cus = 0, per_cu = 0;
        hipGetDevice(&dev);
        hipDeviceGetAttribute(&cus, hipDeviceAttributeMultiprocessorCount, dev);
        hipFuncSetAttribute((const void*)fwd_megakernel, hipFuncAttributeMaxDynamicSharedMemorySize, LDS_BYTES);
        hipOccupancyMaxActiveBlocksPerMultiprocessor(&per_cu, (const void*)fwd_megakernel, 512, LDS_BYTES);
        if (per_cu < 1) per_cu = 1;
        grid = cus * per_cu;
        (void)hipGetLastError();
    }
    if (grid < 0) return;
    Args a{};
    for (int i = 0; i < 19; ++i) a.in[i] = (const float*)d_in[i];
    a.out = (float*)d_out; a.ws = (unsigned char*)d_ws;
    void* args[] = {&a};
    hipError_t e = hipLaunchCooperativeKernel((const void*)fwd_megakernel, dim3(grid), dim3(512), args, LDS_BYTES, stream);
    if (e != hipSuccess) fprintf(stderr, "cooperative launch failed: %s (grid %d)\n", hipGetErrorString(e), grid);
}
```

```cpp
#include <hip/hip_runtime.h>
#include <hip/hip_cooperative_groups.h>
#include <cstdio>
#include <cstdint>
namespace cg = cooperative_groups;
namespace pg8 {
#define PG8_LAS __attribute__((address_space(3)))
typedef unsigned short bf16_t;
typedef short bf16x8 __attribute__((ext_vector_type(8)));
typedef float f32x4 __attribute__((ext_vector_type(4)));
typedef unsigned u32x4 __attribute__((ext_vector_type(4)));
constexpr int BM = 256, BK = 64, HALF = 128, HTB = HALF * BK * 2  , STAGE_BYTES = 8 * HTB, NXCD = 8, WGM = 8;

__host__ __device__ __forceinline__ int lds_byte(int r, int c) { const int st = (r >> 4) * 2 + (c >> 5), rr = r & 15, cc = c & 31, ob = rr * 64 + cc * 2; return st * 1024 + (ob ^ (((ob >> 9) & 1) << 5)); }
__host__ __device__ __forceinline__ void stage_rc(int b, int& R, int& C) { const int st = b / 1024, sb = b % 1024, swz = sb ^ (((sb >> 9) & 1) << 5); R = (st >> 1) * 16 + swz / 64; C = (st & 1) * 32 + (swz % 64) / 2; }
__host__ __device__ __forceinline__ int perm32(int rho) { const int n = rho >> 4, i = rho & 15; return 8 * (i >> 2) + 4 * n + (i & 3); }

struct Unit { int pm, pn, ko; };
struct Gemm { const bf16_t* A; const bf16_t* Bt; int M, N, K, ld; };

struct StaticOrder {
    int nM, nN, nwg, G, c;
    __host__ __device__ void init(int M, int N, int G_, int c_) { nM = M / BM; nN = N / BM; nwg = nM * nN; G = G_; c = c_; }
    __host__ __device__ bool next(int i, Unit& u) const {
        const long L = (long)i * G + c; if (L >= nwg) return false;
        int wgid = (int)L; { const int q = nwg / NXCD, r = nwg % NXCD, xcd = wgid % NXCD, off = wgid / NXCD; wgid = (xcd < r ? xcd * (q + 1) : r * (q + 1) + (xcd - r) * q) + off; }
        const int nig = WGM * nN, gid = wgid / nig, fm = gid * WGM, gsz = (nM - fm) < WGM ? (nM - fm) : WGM;
        u.pm = fm + ((wgid % nig) % gsz); u.pn = (wgid % nig) / gsz; u.ko = 0; return true;
    }
    __device__ __forceinline__ void a_ready(const Unit&) const {}
    __device__ __forceinline__ void done(const Unit&) const {}
};

__device__ __forceinline__ unsigned cvt_pk_bf16(float lo, float hi) { unsigned r; asm volatile("v_cvt_pk_bf16_f32 %0, %1, %2" : "=v"(r) : "v"(lo), "v"(hi)); return r; }
typedef float f32x2 __attribute__((ext_vector_type(2)));
typedef unsigned u32x2 __attribute__((ext_vector_type(2)));
__device__ __forceinline__ unsigned short f2bf1(float f) { return (unsigned short)(cvt_pk_bf16(f, 0.f) & 0xffffu); }
__device__ __forceinline__ float gelu_tanh(float x) {
    const float u = 0.7978845608f * (x + 0.044715f * x * x * x);
    return x * __builtin_amdgcn_rcpf(1.0f + __builtin_amdgcn_exp2f(-2.885390082f * u));
}
template <int ACT, bool REMAP> struct EpiPlain {
    static constexpr bool PERM = true, AFTER_DRAIN = false;
    bf16_t* O; int ldc; float scale;
    __device__ __forceinline__ void operator()(const f32x4 (&acc)[2][2][4][2], const Unit& u, int wr, int wc, int fr, int fq) const {
        asm volatile("" : "+v"(fr), "+v"(fq));
        const int row0 = (REMAP ? u.pn * BM : u.pm * BM) + wr * 64 + fr; const int col0 = (REMAP ? 0 : u.pn * BM) + wc * 32 + 8 * fq;
#pragma unroll
        for (int ai = 0; ai < 2; ++ai)
#pragma unroll
            for (int m = 0; m < 4; ++m) { bf16_t* rowp = O + (size_t)(row0 + ai * HALF + m * 16) * ldc + col0;
#pragma unroll
                for (int bj = 0; bj < 2; ++bj) { f32x4 v0 = acc[ai][bj][m][0], v1 = acc[ai][bj][m][1];
                    if (ACT == 1) {
#pragma unroll
                        for (int j = 0; j < 4; ++j) { float a = fmaxf(v0[j], 0.f), b = fmaxf(v1[j], 0.f); v0[j] = a * a; v1[j] = b * b; } }
                    v0 = v0 * scale; v1 = v1 * scale;
                    u32x4 w; w.x = cvt_pk_bf16(v0[0], v0[1]); w.y = cvt_pk_bf16(v0[2], v0[3]); w.z = cvt_pk_bf16(v1[0], v1[1]); w.w = cvt_pk_bf16(v1[2], v1[3]);
                    *(u32x4*)(rowp + bj * HALF) = w; } }
    }
};

struct SplitKOrder {
    int G, c, pm0, npm, npn, nks, ksub_bytes;
    __device__ bool next(int i, Unit& u) const {
        const int L = i * G + c; if (L >= npm * npn * nks) return false;
        u.ko = (L % nks) * ksub_bytes; const int t = L / nks; u.pn = t % npn; u.pm = pm0 + t / npn; return true;
    }
    __device__ __forceinline__ void a_ready(const Unit&) const {}
    __device__ __forceinline__ void done(const Unit&) const {}
};
struct EpiPart {
    static constexpr bool PERM = true, AFTER_DRAIN = false;
    float* P; int ldc, ksub_bytes, pm0; size_t slice;
    __device__ __forceinline__ void operator()(const f32x4 (&acc)[2][2][4][2], const Unit& u, int wr, int wc, int fr, int fq) const {
        asm volatile("" : "+v"(fr), "+v"(fq));
        float* base = P + (size_t)(u.ko / ksub_bytes) * slice;
        const int row0 = (u.pm - pm0) * BM + wr * 64 + fr, col0 = u.pn * BM + wc * 32 + 8 * fq;
#pragma unroll
        for (int ai = 0; ai < 2; ++ai)
#pragma unroll
            for (int m = 0; m < 4; ++m) { float* rowp = base + (size_t)(row0 + ai * HALF + m * 16) * ldc + col0;
#pragma unroll
                for (int bj = 0; bj < 2; ++bj) { *(f32x4*)(rowp + bj * HALF) = acc[ai][bj][m][0]; *(f32x4*)(rowp + bj * HALF + 4) = acc[ai][bj][m][1]; } }
    }
};
template <class Epi, class Sched, bool ALIGN_EPI = false, bool SP2 = false>
__device__ __forceinline__ void gemm_phase(PG8_LAS unsigned char* lds, const Gemm g, const Sched& S, const Epi& E) {
    int tid_l = threadIdx.x; asm volatile("" : "+v"(tid_l));
    const int tid = tid_l, wid = __builtin_amdgcn_readfirstlane(tid >> 6), lane = tid & 63, wr = wid >> 2, wc = wid & 3, fr = lane & 15, fq = lane >> 4;
    const int K = g.K, LD = g.ld ? g.ld : g.K, nt = K / BK;
    unsigned voffA[2], voffB[2];
#pragma unroll
    for (int i = 0; i < 2; ++i) { int R, C; stage_rc(tid * 16 + i * 8192, R, C); const int Rb = Epi::PERM ? ((R & ~31) + perm32(R & 31)) : R;
        voffA[i] = (unsigned)(R * LD + C) * 2u; voffB[i] = (unsigned)(Rb * LD + C) * 2u; }
    const size_t kstep = (size_t)(BK * 2);
    const size_t hstep = (size_t)HALF * LD * 2;
    const size_t tstep = 2 * hstep;
    const unsigned ldsw = (unsigned)wid * 1024u;
    const int aoff = lds_byte(wr * 64 + fr, fq * 8), boff = lds_byte(wc * 32 + fr, fq * 8);
#define PG8_SA(b, h) (((b) * 2 + (h)) * HTB)
#define PG8_SB(b, h) ((4 + (b) * 2 + (h)) * HTB)
#define PG8_STAGE(bufoff, gbase, voff) do { _Pragma("unroll") for (int _i = 0; _i < 2; ++_i) \
        __builtin_amdgcn_global_load_lds((const unsigned*)((const char*)(gbase) + (voff)[_i]), (PG8_LAS unsigned*)(lds + (bufoff) + ldsw + _i * 8192), 16, 0, 0); } while (0)
#define PG8_LDA(dst, b, h) do { _Pragma("unroll") for (int m = 0; m < 4; ++m) _Pragma("unroll") for (int k = 0; k < 2; ++k) dst[m][k] = *(const PG8_LAS bf16x8*)(lds + PG8_SA(b, h) + aoff + m * 2048 + k * 1024); } while (0)
#define PG8_LDB(dst, b, h) do { _Pragma("unroll") for (int n = 0; n < 2; ++n) _Pragma("unroll") for (int k = 0; k < 2; ++k) dst[n][k] = *(const PG8_LAS bf16x8*)(lds + PG8_SB(b, h) + boff + n * 2048 + k * 1024); } while (0)
#define PG8_MMA(ai, bj, At, Bt) do { __builtin_amdgcn_s_setprio(1); _Pragma("unroll") for (int m = 0; m < 4; ++m) _Pragma("unroll") for (int n = 0; n < 2; ++n) _Pragma("unroll") for (int k = 0; k < 2; ++k) \
        acc[ai][bj][m][n] = __builtin_amdgcn_mfma_f32_16x16x32_bf16(Bt[n][k], At[m][k], acc[ai][bj][m][n], 0, 0, 0); __builtin_amdgcn_s_setprio(0); } while (0)
#define PG8_WAIT_V(n) asm volatile("s_waitcnt vmcnt(" #n ")" ::: "memory")
#define PG8_WAIT_L(n) asm volatile("s_waitcnt lgkmcnt(" #n ")" ::: "memory")
#define PG8_BAR __builtin_amdgcn_s_barrier()
#define PG8_SCHED __builtin_amdgcn_sched_barrier(0)
    Unit cur, nxt; int ui = 0;
    if (!S.next(0, cur)) return;
    f32x4 acc[2][2][4][2];
#pragma unroll
    for (int a = 0; a < 2; ++a)
#pragma unroll
        for (int b = 0; b < 2; ++b)
#pragma unroll
            for (int m = 0; m < 4; ++m)
#pragma unroll
                for (int n = 0; n < 2; ++n) acc[a][b][m][n] = (f32x4){0.f, 0.f, 0.f, 0.f};
    bf16x8 At[4][2], B0[2][2], B1[2][2];
    const char* cA = (const char*)g.A + (size_t)cur.pm * tstep + cur.ko; const char* cB = (const char*)g.Bt + (size_t)cur.pn * tstep + cur.ko;
    S.a_ready(cur);
    if constexpr (SP2) {
        PG8_STAGE(PG8_SB(0, 0), cB, voffB); PG8_STAGE(PG8_SB(0, 1), cB + hstep, voffB); PG8_STAGE(PG8_SA(0, 0), cA, voffA); PG8_STAGE(PG8_SA(0, 1), cA + hstep, voffA);
        if (wr == 1) PG8_BAR;
        PG8_WAIT_V(2); PG8_BAR;
        PG8_STAGE(PG8_SB(1, 0), cB + kstep, voffB); PG8_STAGE(PG8_SA(1, 0), cA + kstep, voffA); PG8_STAGE(PG8_SB(1, 1), cB + hstep + kstep, voffB);
        PG8_WAIT_V(6); PG8_BAR;
    } else {
        PG8_STAGE(PG8_SB(0, 0), cB, voffB); PG8_STAGE(PG8_SA(0, 0), cA, voffA); PG8_STAGE(PG8_SB(0, 1), cB + hstep, voffB); PG8_STAGE(PG8_SA(0, 1), cA + hstep, voffA);
        if (wr == 1) PG8_BAR;
        PG8_WAIT_V(4); PG8_BAR;
        PG8_STAGE(PG8_SB(1, 0), cB + kstep, voffB); PG8_STAGE(PG8_SA(1, 0), cA + kstep, voffA); PG8_STAGE(PG8_SB(1, 1), cB + hstep + kstep, voffB);
        PG8_WAIT_V(6); PG8_BAR;
    }
    for (;;) {
        const bool has_next = S.next(ui + 1, nxt);
        const char* nA = has_next ? (const char*)g.A + (size_t)nxt.pm * tstep + nxt.ko : cA; const char* nB = has_next ? (const char*)g.Bt + (size_t)nxt.pn * tstep + nxt.ko : cB;
        for (int t = 0; t < nt; t += 2) {
            const bool last = (t == nt - 2);
            const char* a1 = cA + (size_t)(t + 1) * kstep;
            const char* a2 = last ? nA : cA + (size_t)(t + 2) * kstep; const char* b2 = last ? nB : cB + (size_t)(t + 2) * kstep;
            const char* a3 = a2 + kstep; const char* b3 = b2 + kstep;
            if (last && has_next) S.a_ready(nxt);
            if constexpr (SP2) {
            PG8_LDB(B0, 0, 0); PG8_LDB(B1, 0, 1); PG8_SCHED; PG8_LDA(At, 0, 0); PG8_STAGE(PG8_SA(1, 1), a1 + hstep, voffA);
            PG8_WAIT_V(8); PG8_WAIT_L(0); PG8_BAR; PG8_MMA(0, 0, At, B0); PG8_MMA(0, 1, At, B1); PG8_BAR; PG8_SCHED;
            PG8_LDA(At, 0, 1); PG8_STAGE(PG8_SB(0, 0), b2, voffB); PG8_STAGE(PG8_SB(0, 1), b2 + hstep, voffB); PG8_STAGE(PG8_SA(0, 0), a2, voffA);
            PG8_WAIT_V(8); PG8_WAIT_L(0); PG8_BAR; PG8_MMA(1, 0, At, B0); PG8_MMA(1, 1, At, B1); PG8_BAR; PG8_SCHED;
            PG8_LDB(B0, 1, 0); PG8_LDB(B1, 1, 1); PG8_SCHED; PG8_LDA(At, 1, 0); PG8_STAGE(PG8_SA(0, 1), a2 + hstep, voffA);
            PG8_WAIT_V(8); PG8_WAIT_L(0); PG8_BAR; PG8_MMA(0, 0, At, B0); PG8_MMA(0, 1, At, B1); PG8_BAR; PG8_SCHED;
            PG8_LDA(At, 1, 1); PG8_STAGE(PG8_SB(1, 0), b3, voffB); PG8_STAGE(PG8_SB(1, 1), b3 + hstep, voffB); PG8_STAGE(PG8_SA(1, 0), a3, voffA);
            PG8_WAIT_V(8); PG8_WAIT_L(0); PG8_BAR; PG8_MMA(1, 0, At, B0); PG8_MMA(1, 1, At, B1); PG8_BAR; PG8_SCHED;
            } else {
            PG8_LDB(B0, 0, 0); PG8_SCHED; PG8_LDA(At, 0, 0); PG8_STAGE(PG8_SA(1, 1), a1 + hstep, voffA);
            PG8_WAIT_L(8); PG8_BAR; PG8_WAIT_L(0); PG8_MMA(0, 0, At, B0); PG8_BAR; PG8_SCHED;
            PG8_LDB(B1, 0, 1); PG8_STAGE(PG8_SB(0, 0), b2, voffB);
            PG8_BAR; PG8_WAIT_L(0); PG8_MMA(0, 1, At, B1); PG8_BAR;
            PG8_LDA(At, 0, 1); PG8_STAGE(PG8_SA(0, 0), a2, voffA);
            PG8_BAR; PG8_WAIT_L(0); PG8_MMA(1, 0, At, B0); PG8_BAR; PG8_SCHED;
            PG8_STAGE(PG8_SB(0, 1), b2 + hstep, voffB);
            PG8_WAIT_V(6); PG8_BAR; PG8_MMA(1, 1, At, B1); PG8_BAR;
            PG8_LDB(B0, 1, 0); PG8_SCHED; PG8_LDA(At, 1, 0); PG8_STAGE(PG8_SA(0, 1), a2 + hstep, voffA);
            PG8_WAIT_L(8); PG8_BAR; PG8_WAIT_L(0); PG8_MMA(0, 0, At, B0); PG8_BAR; PG8_SCHED;
            PG8_LDB(B1, 1, 1); PG8_STAGE(PG8_SB(1, 0), b3, voffB);
            PG8_BAR; PG8_WAIT_L(0); PG8_MMA(0, 1, At, B1); PG8_BAR;
            PG8_LDA(At, 1, 1); PG8_STAGE(PG8_SA(1, 0), a3, voffA);
            PG8_BAR; PG8_WAIT_L(0); PG8_MMA(1, 0, At, B0); PG8_BAR; PG8_SCHED;
            PG8_STAGE(PG8_SB(1, 1), b3 + hstep, voffB);
            PG8_WAIT_V(6); PG8_BAR; PG8_MMA(1, 1, At, B1); PG8_BAR;
            }
        }
        if constexpr (ALIGN_EPI) { if (wr == 0) PG8_BAR; }
        if constexpr (!Epi::AFTER_DRAIN) { E(acc, cur, wr, wc, fr, fq); S.done(cur); }
        if (!has_next) break;
#pragma unroll
        for (int a = 0; a < 2; ++a)
#pragma unroll
            for (int b = 0; b < 2; ++b)
#pragma unroll
                for (int m = 0; m < 4; ++m)
#pragma unroll
                    for (int n = 0; n < 2; ++n) acc[a][b][m][n] = (f32x4){0.f, 0.f, 0.f, 0.f};
        cur = nxt; cA = nA; cB = nB; ++ui;
        if constexpr (ALIGN_EPI) { if (wr == 1) PG8_BAR; }
    }
    PG8_WAIT_V(0);
    if constexpr (!ALIGN_EPI) { if (wr == 0) PG8_BAR; }
    PG8_BAR;
    if constexpr (Epi::AFTER_DRAIN) { E.fused(acc, cur, wr, wc, fr, fq, lds, wid, lane); S.done(cur); }
#undef PG8_SA
#undef PG8_SB
#undef PG8_STAGE
#undef PG8_LDA
#undef PG8_LDB
#undef PG8_MMA
#undef PG8_WAIT_V
#undef PG8_WAIT_L
#undef PG8_BAR
#undef PG8_SCHED
}
}

#define LAS __attribute__((address_space(3)))
typedef unsigned short bf16;
typedef short bf16x8 __attribute__((ext_vector_type(8)));
typedef float f32x4 __attribute__((ext_vector_type(4)));
typedef float f32x16 __attribute__((ext_vector_type(16)));
typedef unsigned v4u __attribute__((ext_vector_type(4)));
typedef unsigned v2u __attribute__((ext_vector_type(2)));
using pg8::cvt_pk_bf16;

constexpr int NB = 8, SEQ = 8192, DM = 1024, CTXL = 256, DFF = 4096, NIN = 1536;
constexpr int ML = NB * SEQ;
constexpr int MT = ML + NB * CTXL;
constexpr float EPSN = 1e-6f;
constexpr float LOG2E = 1.4426950408889634f;
constexpr float QSCALE = 0.125f * 1.4426950408889634f;
constexpr size_t MiB = 1u << 20;
constexpr size_t WS_WIN = 0;
constexpr size_t WS_WOUT = 7 * MiB;
constexpr size_t WS_WFF1 = 11 * MiB;
constexpr size_t WS_WFF2 = 27 * MiB;
constexpr size_t WS_DFT512 = 43 * MiB;
constexpr size_t WS_DFT256 = 45 * MiB;
constexpr size_t WS_TW = 45 * MiB + 256 * 1024;
constexpr size_t WS_ROPEC = WS_TW + 64 * 1024;
constexpr size_t WS_ROPES = WS_ROPEC + 8 * 1024;
constexpr size_t WS_MOD = 46 * MiB;
constexpr size_t WS_HX = 48 * MiB;
constexpr size_t WS_XR = WS_HX + 132 * MiB;
constexpr size_t WS_C = WS_XR + 264 * MiB;
constexpr size_t WS_H1 = WS_C;
constexpr size_t WS_QB = WS_C;
constexpr size_t WS_KB = WS_QB + 66 * MiB;
constexpr size_t WS_VT = WS_KB + 17 * MiB;
constexpr size_t WS_VTC = WS_VT + 16 * MiB;
constexpr size_t WS_UB = WS_VTC + 1 * MiB;
constexpr size_t WS_GVT = WS_UB + 33 * MiB;
constexpr size_t WS_GVTC = WS_GVT + 32 * MiB;
constexpr size_t WS_GT = WS_GVTC + 1 * MiB;
constexpr size_t WS_GTC = WS_GT + 64 * MiB;
constexpr size_t WS_TP = WS_GTC + 2 * MiB;
constexpr size_t WS_MIX = WS_TP + 64 * MiB;
constexpr size_t WS_END = WS_C + 528 * MiB;
static_assert(WS_MIX + 132 * MiB <= WS_END, "overlay region");
constexpr size_t WS_PART = WS_END;
constexpr size_t WS_TOTAL = WS_PART + 32 * MiB;
static_assert(WS_TOTAL <= 1024 * MiB, "workspace");
constexpr int LDS_BYTES = 147456;
constexpr size_t WS_BAR = 46 * MiB + 512 * 1024;
constexpr int LDS_BARST = LDS_BYTES - 64;

__device__ __forceinline__ float bf2f(unsigned short h) { return __builtin_bit_cast(float, (unsigned)h << 16); }
__device__ __forceinline__ float bflo(unsigned w) { return __builtin_bit_cast(float, w << 16); }
__device__ __forceinline__ float bfhi(unsigned w) { return __builtin_bit_cast(float, w & 0xffff0000u); }
__device__ __forceinline__ float wave_sum(float v) {
#pragma unroll
    for (int o = 1; o < 64; o <<= 1) v += __shfl_xor(v, o);
    return v;
}
#define LDS_WAIT() asm volatile("s_waitcnt lgkmcnt(0)" ::: "memory")
__host__ __device__ __forceinline__ int fsig(int p) { return (p & 1) ? ((p == 1) ? 32 : 64 - (p >> 1)) : (p >> 1); }

struct Args { const float* in[19]; float* out; unsigned char* ws; };

struct EpiIn {
    static constexpr bool PERM = true, AFTER_DRAIN = false;
    unsigned char* wsb; int last;
    __device__ __forceinline__ void operator()(const pg8::f32x4 (&acc)[2][2][4][2], const pg8::Unit& u, int wr, int wc, int fr, int fq) const {
        using namespace pg8;
        asm volatile("" : "+v"(fr), "+v"(fq));
        unsigned char* ws = wsb; asm volatile("" : "+s"(ws));
        bf16_t* const QB = (bf16_t*)(ws + WS_QB); bf16_t* const KB = (bf16_t*)(ws + WS_KB); bf16_t* const VT = (bf16_t*)(ws + WS_VT); bf16_t* const VTc = (bf16_t*)(ws + WS_VTC);
        bf16_t* const UB = (bf16_t*)(ws + WS_UB); bf16_t* const GVT = (bf16_t*)(ws + WS_GVT); bf16_t* const GVTc = (bf16_t*)(ws + WS_GVTC); bf16_t* const GT = (bf16_t*)(ws + WS_GT); bf16_t* const GTc = (bf16_t*)(ws + WS_GTC);
        const float* const ropeC = (const float*)(ws + WS_ROPEC); const float* const ropeS = (const float*)(ws + WS_ROPES);
        const int pm = u.pm, pn = u.pn; const bool isctx = pm >= 256;
        if (isctx && last && pn != 2) return;
        const int b = isctx ? pm - 256 : pm >> 5;
        const int sbase = (isctx ? 0 : (pm & 31) * 256) + wr * 64 + fr;
        const size_t grow0 = (size_t)pm * 256 + wr * 64 + fr;
        const int c8 = wc * 32 + 8 * fq;
        if (pn <= 2) {
#pragma unroll
            for (int bj = 0; bj < 2; ++bj) {
                if (pn == 2 && bj == 1) {
                    bf16_t* base = isctx ? VTc + (size_t)b * 128 * 256 : VT + (size_t)b * 128 * 8192; const int ld = isctx ? 256 : 8192;
#pragma unroll
                    for (int ai = 0; ai < 2; ++ai)
#pragma unroll
                        for (int m = 0; m < 4; ++m) { const int s = sbase + ai * HALF + m * 16;
#pragma unroll
                            for (int n = 0; n < 2; ++n)
#pragma unroll
                                for (int j = 0; j < 4; ++j) base[(size_t)(c8 + 4 * n + j) * ld + s] = f2bf1(acc[ai][1][m][n][j]); asm volatile("" ::: "memory"); }
                } else {
                    const int i0 = 8 * (fq & 1); const bool odd = (wc & 1) != 0; const float sgn = (fq < 2) ? -1.f : 1.f;
#pragma unroll
                    for (int ai = 0; ai < 2; ++ai)
#pragma unroll
                        for (int m = 0; m < 4; ++m) { const int s = sbase + ai * HALF + m * 16;
                            f32x4 v0 = acc[ai][bj][m][0], v1 = acc[ai][bj][m][1];
                            if (!isctx) {
                                const int pos = odd ? (s & 63) : (s >> 6);
                                const f32x4 c0 = *(const f32x4*)(ropeC + pos * 16 + i0), c1 = *(const f32x4*)(ropeC + pos * 16 + i0 + 4);
                                const f32x4 s0 = *(const f32x4*)(ropeS + pos * 16 + i0), s1 = *(const f32x4*)(ropeS + pos * 16 + i0 + 4);
#pragma unroll
                                for (int j = 0; j < 4; ++j) { const float p0 = __shfl_xor(v0[j], 32), p1 = __shfl_xor(v1[j], 32);
                                    v0[j] = v0[j] * c0[j] + sgn * p0 * s0[j]; v1[j] = v1[j] * c1[j] + sgn * p1 * s1[j]; }
                            }
                            if (pn < 2) { v0 = v0 * QSCALE; v1 = v1 * QSCALE; }
                            u32x4 w; w.x = cvt_pk_bf16(v0[0], v0[1]); w.y = cvt_pk_bf16(v0[2], v0[3]); w.z = cvt_pk_bf16(v1[0], v1[1]); w.w = cvt_pk_bf16(v1[2], v1[3]);
                            const size_t grow = grow0 + ai * HALF + m * 16;
                            if (pn < 2) *(u32x4*)(QB + grow * 512 + pn * 256 + bj * HALF + c8) = w; else *(u32x4*)(KB + grow * 128 + c8) = w; asm volatile("" ::: "memory"); }
                }
            }
        } else if (pn == 3) {
#pragma unroll
            for (int ai = 0; ai < 2; ++ai)
#pragma unroll
                for (int m = 0; m < 4; ++m) { const size_t grow = grow0 + ai * HALF + m * 16;
#pragma unroll
                    for (int bj = 0; bj < 2; ++bj) { f32x4 v0 = acc[ai][bj][m][0], v1 = acc[ai][bj][m][1];
#pragma unroll
                        for (int j = 0; j < 4; ++j) { v0[j] = gelu_tanh(v0[j]); v1[j] = gelu_tanh(v1[j]); }
                        u32x4 w; w.x = cvt_pk_bf16(v0[0], v0[1]); w.y = cvt_pk_bf16(v0[2], v0[3]); w.z = cvt_pk_bf16(v1[0], v1[1]); w.w = cvt_pk_bf16(v1[2], v1[3]);
                        *(u32x4*)(UB + grow * 256 + bj * HALF + c8) = w; } asm volatile("" ::: "memory"); }
        } else if (pn == 4) {
            bf16_t* base = isctx ? GVTc + (size_t)b * 256 * 256 : GVT + (size_t)b * 256 * 8192; const int ld = isctx ? 256 : 8192;
#pragma unroll
            for (int ai = 0; ai < 2; ++ai)
#pragma unroll
                for (int m = 0; m < 4; ++m) { const int s = sbase + ai * HALF + m * 16;
#pragma unroll
                    for (int bj = 0; bj < 2; ++bj)
#pragma unroll
                        for (int n = 0; n < 2; ++n)
#pragma unroll
                            for (int j = 0; j < 4; ++j) base[(size_t)(bj * HALF + c8 + 4 * n + j) * ld + s] = f2bf1(gelu_tanh(acc[ai][bj][m][n][j])); asm volatile("" ::: "memory"); }
        } else {
            if (!isctx) {
                bf16_t* base = GT + ((size_t)b * 256 * 16 + fr) * 512 + 16 * (pm & 31) + 4 * wr;
#pragma unroll
                for (int bj = 0; bj < 2; ++bj)
#pragma unroll
                    for (int n = 0; n < 2; ++n)
#pragma unroll
                        for (int j = 0; j < 4; ++j) { const int ch = bj * HALF + c8 + 4 * n + j;
#pragma unroll
                            for (int ai = 0; ai < 2; ++ai) { u32x2 w; w.x = cvt_pk_bf16(acc[ai][bj][0][n][j], acc[ai][bj][1][n][j]); w.y = cvt_pk_bf16(acc[ai][bj][2][n][j], acc[ai][bj][3][n][j]);
                                *(u32x2*)(base + (size_t)ch * 8192 + 8 * ai) = w; } asm volatile("" ::: "memory"); }
            } else {
                bf16_t* base = GTc + (size_t)b * 256 * 512;
#pragma unroll
                for (int ai = 0; ai < 2; ++ai)
#pragma unroll
                    for (int m = 0; m < 4; ++m) { const int s = sbase + ai * HALF + m * 16;
#pragma unroll
                        for (int bj = 0; bj < 2; ++bj)
#pragma unroll
                            for (int n = 0; n < 2; ++n)
#pragma unroll
                                for (int j = 0; j < 4; ++j) { const int ch = bj * HALF + c8 + 4 * n + j; const bool ity = (ch & 1) && ((ch & 63) != 1);
                                    base[(size_t)ch * 512 + (ity ? 256 : 0) + s] = f2bf1(acc[ai][bj][m][n][j]); base[(size_t)ch * 512 + (ity ? 0 : 256) + s] = 0; } asm volatile("" ::: "memory"); }
            }
        }
    }
};


template <bool PERMK = false>
__device__ __forceinline__ void p0_transpose_item(const float* W, int K, int N, bf16* WT, int nblk, LAS float* scr, int item, int lane) {
    const int kb = item / nblk, nb = item % nblk, k0 = 64 * kb, n0 = 32 * nb;
    float tv[32];
#pragma unroll
    for (int i = 0; i < 32; ++i) { int kr = k0 + 2 * i + (lane >> 5); if (PERMK && kr >= 768) kr = (kr & ~63) + fsig(kr & 63); tv[i] = W[(size_t)kr * N + n0 + (lane & 31)]; }
#pragma unroll
    for (int i = 0; i < 32; ++i) scr[(2 * i + (lane >> 5)) * 33 + (lane & 31)] = tv[i];
    LDS_WAIT();
    const int c = lane & 7;
#pragma unroll
    for (int j = 0; j < 4; ++j) { const int n = (lane >> 3) + 8 * j; const LAS float* s = scr + (8 * c) * 33 + n;
        v4u o; o.x = cvt_pk_bf16(s[0 * 33], s[1 * 33]); o.y = cvt_pk_bf16(s[2 * 33], s[3 * 33]); o.z = cvt_pk_bf16(s[4 * 33], s[5 * 33]); o.w = cvt_pk_bf16(s[6 * 33], s[7 * 33]);
        *(v4u*)(WT + (size_t)(n0 + n) * K + k0 + 8 * c) = o; }
    LDS_WAIT();
}
__device__ __forceinline__ void p0_fold_item(const float* Win  , bf16* WT  , LAS float* scr, int item, int lane) {
    const int g = item >> 6, k0 = ((item >> 2) & 15) * 64, q0 = (item & 3) * 16;
    LAS float* cs = scr + 64 * 65; LAS float* sn = cs + 64;
    cs[lane] = cospif((float)lane / 32.f); sn[lane] = -sinpif((float)lane / 32.f);
#pragma unroll 1
    for (int i0 = 0; i0 < 64; i0 += 32) { float tv[32];
#pragma unroll
        for (int i = 0; i < 32; ++i) tv[i] = Win[(size_t)(k0 + i0 + i) * 1536 + 1280 + g * 64 + lane];
#pragma unroll
        for (int i = 0; i < 32; ++i) scr[(i0 + i) * 65 + lane] = tv[i]; }
    LDS_WAIT();
    for (int q = q0; q < q0 + 16; ++q) {
        const bool rtype = !(q & 1) || q == 1; const int jm = q == 1 ? 32 : (q >> 1);
        const LAS float* tab = rtype ? cs : sn;
        float ar = 0.f;
#pragma unroll 8
        for (int c = 0; c < 64; ++c) ar += scr[lane * 65 + c] * tab[(jm * c) & 63];
        WT[(size_t)(1280 + g * 64 + q) * 1024 + k0 + lane] = pg8::f2bf1(ar);
    }
    LDS_WAIT();
}
__device__ __forceinline__ void p0_mod_item(LAS unsigned char* lds, int item, const float* w_ada, const float* b_ada, float* MOD, int tid) {
    LAS float* sl = (LAS float*)lds; LAS float* red = sl + 9 * 1024;
    const int wave = tid >> 6, lane = tid & 63;
    const int l = item / 96, n0 = (item % 96) * 64;
    f32x4 acc[9];
#pragma unroll
    for (int r = 0; r < 9; ++r) acc[r] = (f32x4){0.f, 0.f, 0.f, 0.f};
    const int kr = lane >> 4, c4 = lane & 15;
    const float* W = w_ada + (size_t)l * 1024 * 6144 + n0 + c4 * 4;
#pragma unroll 1
    for (int k0 = 0; k0 < 128; k0 += 32) {
        f32x4 wv[8];
#pragma unroll
        for (int i = 0; i < 8; ++i) wv[i] = *(const f32x4*)(W + (size_t)(wave * 128 + k0 + i * 4 + kr) * 6144);
#pragma unroll
        for (int i = 0; i < 8; ++i) { const int k = wave * 128 + k0 + i * 4 + kr;
#pragma unroll
            for (int r = 0; r < 9; ++r) acc[r] = acc[r] + wv[i] * sl[r * 1024 + k]; }
    }
#pragma unroll
    for (int r = 0; r < 9; ++r)
#pragma unroll
        for (int e = 0; e < 4; ++e) { float v = acc[r][e]; v += __shfl_xor(v, 16); v += __shfl_xor(v, 32); acc[r][e] = v; }
    if (kr == 0) {
#pragma unroll
        for (int r = 0; r < 9; ++r)
#pragma unroll
            for (int e = 0; e < 4; ++e) red[(wave * 9 + r) * 64 + c4 * 4 + e] = acc[r][e];
    }
    __syncthreads();
    for (int i = tid; i < 576; i += 512) { const int r = i >> 6, n = i & 63; float s = b_ada[l * 6144 + n0 + n];
#pragma unroll
        for (int w = 0; w < 8; ++w) s += red[(w * 9 + r) * 64 + n];
        MOD[(size_t)(l * 9 + r) * 6144 + n0 + n] = s; }
    __syncthreads();
}
__device__ __forceinline__ void p0_prologue(const Args& a, LAS unsigned char* lds, int bid, int G, int tid) {
    asm volatile("" : "+v"(tid));
    unsigned char* ws = a.ws;
    const int wave = tid >> 6, lane = tid & 63;
    if (bid < 192) {
        LAS float* sl = (LAS float*)lds;
        for (int i = tid; i < 9 * 1024; i += 512) { const int r = i >> 10, k = i & 1023; const float v = r < 8 ? a.in[1][r * 1024 + k] : a.in[3][k]; sl[i] = v / (1.f + __expf(-v)); }
        __syncthreads();
        for (int it = bid; it < 192; it += G) p0_mod_item(lds, it, a.in[4], a.in[5], (float*)(ws + WS_MOD), tid);
    }
    __syncthreads();
    {
        const int gt = bid * 512 + tid, NT = G * 512;
        float* rc = (float*)(ws + WS_ROPEC); float* rs = (float*)(ws + WS_ROPES);
        for (int i = gt; i < 2048; i += NT) { const int pos = i >> 4, f = i & 15; const float invf = exp2f(-(float)f * (13.287712379549449f / 16.f));
            const float ang = (float)pos * invf; float rev = ang * 0.15915494309189535f; rev -= floorf(rev); rc[i] = cospif(2.f * rev); rs[i] = sinpif(2.f * rev); }
        float* tw = (float*)(ws + WS_TW);
        for (int i = gt; i < 8192; i += NT) { tw[2 * i] = cospif((float)i / 4096.f); tw[2 * i + 1] = sinpif((float)i / 4096.f); }
        bf16* d5 = (bf16*)(ws + WS_DFT512);
        for (int i = gt; i < 512 * 512; i += NT) { const int R = i >> 9, s1 = i & 511;
            float v; if (R < 256) v = cospif((float)((R * s1) & 511) / 256.f); else if (R == 256) v = (s1 & 1) ? -1.f : 1.f; else v = -sinpif((float)(((R - 256) * s1) & 511) / 256.f);
            d5[i] = pg8::f2bf1(v); }
        bf16* d2 = (bf16*)(ws + WS_DFT256);
        for (int i = gt; i < 256 * 512; i += NT) { const int k = i >> 9, C = i & 511, pc = C >> 8, s = C & 255; const int m = (k * s) & 255;
            d2[i] = pg8::f2bf1(pc == 0 ? cospif((float)m / 128.f) : sinpif((float)m / 128.f)); }
    }
    LAS float* scr = (LAS float*)(lds + wave * 17408);
    const int gw = bid * 8 + wave, NGW = G * 8;
    constexpr int PER = 640 + 256 + 512 + 2048 + 2048;
    for (int it = gw; it < 2 * PER; it += NGW) {
        const int l = it / PER; int r = it % PER;
        const float* win = a.in[7] + (size_t)l * 1024 * 1536; bf16* wtin = (bf16*)(ws + WS_WIN) + (size_t)l * NIN * 1024;
        if (r < 640) { p0_transpose_item(win, 1024, 1536, wtin, 40, scr, r, lane); continue; } r -= 640;
        if (r < 256) { p0_fold_item(win, wtin, scr, r, lane); continue; } r -= 256;
        if (r < 512) { p0_transpose_item<true>(a.in[13] + (size_t)l * 1024 * 1024, 1024, 1024, (bf16*)(ws + WS_WOUT) + (size_t)l * 1024 * 1024, 32, scr, r, lane); continue; } r -= 512;
        if (r < 2048) { p0_transpose_item(a.in[16] + (size_t)l * 1024 * 4096, 1024, 4096, (bf16*)(ws + WS_WFF1) + (size_t)l * 4096 * 1024, 128, scr, r, lane); continue; } r -= 2048;
        p0_transpose_item(a.in[17] + (size_t)l * 4096 * 1024, 4096, 1024, (bf16*)(ws + WS_WFF2) + (size_t)l * 1024 * 4096, 32, scr, r, lane);
    }
}

template <int NR, int NP = 0>
__device__ __forceinline__ void row_op(const float* xin, const bf16* upd, const float* gate, const float* gupd, float* xout, bf16* hxout,
                                       const float* gn, const float* sc, const float* sh, int lane,
                                       const bf16* upd2 = nullptr, const float* gate2 = nullptr, const float* gupd2 = nullptr) {
    asm volatile("" : "+v"(lane));
    f32x4 x[NR][4];
#pragma unroll
    for (int r = 0; r < NR; ++r)
#pragma unroll
        for (int j = 0; j < 4; ++j) x[r][j] = *(const f32x4*)(xin + (size_t)r * DM + j * 256 + lane * 4);
    if (upd) {
        f32x4 y[NR][4];
#pragma unroll
        for (int r = 0; r < NR; ++r)
#pragma unroll
            for (int j = 0; j < 4; ++j) {
                if (NP == 0) { const v2u w = *(const v2u*)(upd + (size_t)r * DM + j * 256 + lane * 4); y[r][j][0] = bflo(w.x); y[r][j][1] = bfhi(w.x); y[r][j][2] = bflo(w.y); y[r][j][3] = bfhi(w.y); }
                else { const float* pp = (const float*)upd + (size_t)r * DM + j * 256 + lane * 4; f32x4 t = *(const f32x4*)pp;
#pragma unroll
                    for (int p = 1; p < NP; ++p) t = t + *(const f32x4*)(pp + (size_t)p * 2048 * 1024);
                    y[r][j] = t; } }
        float rr[NR];
#pragma unroll
        for (int r = 0; r < NR; ++r) { float ss = 0.f;
#pragma unroll
            for (int j = 0; j < 4; ++j) ss += (y[r][j][0] * y[r][j][0] + y[r][j][1] * y[r][j][1]) + (y[r][j][2] * y[r][j][2] + y[r][j][3] * y[r][j][3]);
            rr[r] = ss; }
#pragma unroll
        for (int r = 0; r < NR; ++r) rr[r] = rsqrtf(wave_sum(rr[r]) * (1.f / 1024.f) + EPSN);
#pragma unroll
        for (int j = 0; j < 4; ++j) { const f32x4 g = *(const f32x4*)(gate + j * 256 + lane * 4) * *(const f32x4*)(gupd + j * 256 + lane * 4);
#pragma unroll
            for (int r = 0; r < NR; ++r) x[r][j] = x[r][j] + g * (y[r][j] * rr[r]); }
    }
    if (upd2) {
        f32x4 y[NR][4];
#pragma unroll
        for (int r = 0; r < NR; ++r)
#pragma unroll
            for (int j = 0; j < 4; ++j) { const v2u w = *(const v2u*)(upd2 + (size_t)r * DM + j * 256 + lane * 4); y[r][j][0] = bflo(w.x); y[r][j][1] = bfhi(w.x); y[r][j][2] = bflo(w.y); y[r][j][3] = bfhi(w.y); }
        float rr[NR];
#pragma unroll
        for (int r = 0; r < NR; ++r) { float ss = 0.f;
#pragma unroll
            for (int j = 0; j < 4; ++j) ss += (y[r][j][0] * y[r][j][0] + y[r][j][1] * y[r][j][1]) + (y[r][j][2] * y[r][j][2] + y[r][j][3] * y[r][j][3]);
            rr[r] = ss; }
#pragma unroll
        for (int r = 0; r < NR; ++r) rr[r] = rsqrtf(wave_sum(rr[r]) * (1.f / 1024.f) + EPSN);
#pragma unroll
        for (int j = 0; j < 4; ++j) { const f32x4 g = *(const f32x4*)(gate2 + j * 256 + lane * 4) * *(const f32x4*)(gupd2 + j * 256 + lane * 4);
#pragma unroll
            for (int r = 0; r < NR; ++r) x[r][j] = x[r][j] + g * (y[r][j] * rr[r]); }
    }
    if (xout) {
#pragma unroll
        for (int r = 0; r < NR; ++r)
#pragma unroll
            for (int j = 0; j < 4; ++j) *(f32x4*)(xout + (size_t)r * DM + j * 256 + lane * 4) = x[r][j];
    }
    if (hxout) {
        float rr[NR];
#pragma unroll
        for (int r = 0; r < NR; ++r) { float ss = 0.f;
#pragma unroll
            for (int j = 0; j < 4; ++j) ss += (x[r][j][0] * x[r][j][0] + x[r][j][1] * x[r][j][1]) + (x[r][j][2] * x[r][j][2] + x[r][j][3] * x[r][j][3]);
            rr[r] = ss; }
#pragma unroll
        for (int r = 0; r < NR; ++r) rr[r] = rsqrtf(wave_sum(rr[r]) * (1.f / 1024.f) + EPSN);
#pragma unroll
        for (int j = 0; j < 4; ++j) { const f32x4 g = *(const f32x4*)(gn + j * 256 + lane * 4) * (*(const f32x4*)(sc + j * 256 + lane * 4) + 1.f), s0 = *(const f32x4*)(sh + j * 256 + lane * 4);
#pragma unroll
            for (int r = 0; r < NR; ++r) { const f32x4 h = (x[r][j] * rr[r]) * g + s0; v2u w; w.x = cvt_pk_bf16(h[0], h[1]); w.y = cvt_pk_bf16(h[2], h[3]); *(v2u*)(hxout + (size_t)r * DM + j * 256 + lane * 4) = w; } }
    }
}
template <int NR>
__device__ __forceinline__ void mixnorm_rows(bf16* mix, const float* gmix, int lane, bf16* outp) {
    asm volatile("" : "+v"(lane));
    v4u w[NR][2];
#pragma unroll
    for (int r = 0; r < NR; ++r) { w[r][0] = *(const v4u*)(mix + (size_t)r * 1024 + lane * 16); w[r][1] = *(const v4u*)(mix + (size_t)r * 1024 + lane * 16 + 8); }
    f32x4 g[4];
#pragma unroll
    for (int q = 0; q < 4; ++q) g[q] = *(const f32x4*)(gmix + lane * 16 + q * 4);
    float rr[NR];
#pragma unroll
    for (int r = 0; r < NR; ++r) { float ss = 0.f;
#pragma unroll
        for (int h = 0; h < 2; ++h)
#pragma unroll
            for (int e = 0; e < 4; ++e) { const float a = bflo(w[r][h][e]), b = bfhi(w[r][h][e]); ss += a * a + b * b; }
        rr[r] = ss; }
#pragma unroll
    for (int r = 0; r < NR; ++r) { float ss = rr[r]; ss += __shfl_xor(ss, 1); ss += __shfl_xor(ss, 2); ss += __shfl_xor(ss, 4); ss += __shfl_xor(ss, 8);
        const float s16 = __shfl_xor(ss, 16); const float tot = lane < 32 ? ss + s16 : ss; const float cnt = lane < 32 ? 512.f : 256.f;
        rr[r] = rsqrtf(tot / cnt + EPSN); }
#pragma unroll
    for (int r = 0; r < NR; ++r) {
#pragma unroll
        for (int h = 0; h < 2; ++h)
#pragma unroll
            for (int e = 0; e < 4; ++e) { const int q = h * 2 + (e >> 1); const float a = bflo(w[r][h][e]) * rr[r] * g[q][(e & 1) * 2], b = bfhi(w[r][h][e]) * rr[r] * g[q][(e & 1) * 2 + 1]; w[r][h][e] = cvt_pk_bf16(a, b); }
        *(v4u*)(outp + (size_t)r * 1024 + lane * 16) = w[r][0]; *(v4u*)(outp + (size_t)r * 1024 + lane * 16 + 8) = w[r][1]; }
}

#define MFMA32(a, b, c) __builtin_amdgcn_mfma_f32_32x32x16_bf16(a, b, c, 0, 0, 0)
constexpr int AT_ST = 136;
constexpr int AT_HALF = 128 * AT_ST * 2;
constexpr int AT_BUF = 2 * AT_HALF;
constexpr int AT_RED = 2 * AT_BUF;
__device__ __forceinline__ void attn_units(LAS unsigned char* lds, const bf16* QB, const bf16* KB, const bf16* VT, const bf16* VTc, bf16* MIX, const float* sink, const float* gmix,
                                           int nunits, int G, int vb, int tid) {
    asm volatile("" : "+v"(tid));
    const int wave = __builtin_amdgcn_readfirstlane(tid >> 6), lane = tid & 63, h = wave >> 2, c = lane & 31, hh = lane >> 5;
    LAS float* red = (LAS float*)(lds + AT_RED);
    for (int L = vb; L < nunits; L += G) {
        const int uidx = (L < 1024 && (G & 7) == 0) ? (L & 7) * 128 + (L >> 3) : L;
        const bool isctx = uidx >= 1024; int b, nb, q0;
        if (!isctx) { b = uidx >> 7; nb = (uidx >> 1) & 63; q0 = nb * 128 + (uidx & 1) * 64; } else { const int v = uidx - 1024; b = v >> 2; nb = 0; q0 = (v & 3) * 64; }
        const size_t qrow0 = (size_t)(isctx ? ML + b * CTXL : b * SEQ) + q0;
        bf16x8 qf[2][4];
#pragma unroll
        for (int qs = 0; qs < 2; ++qs)
#pragma unroll
            for (int ks = 0; ks < 4; ++ks) qf[qs][ks] = *(const bf16x8*)(QB + (qrow0 + qs * 32 + c) * 512 + wave * 64 + ks * 16 + hh * 8);
        float mrun[2], lrun[2]; f32x16 o[2][2];
        const float sk = sink[wave] * LOG2E;
#pragma unroll
        for (int qs = 0; qs < 2; ++qs) { mrun[qs] = sk; lrun[qs] = 1.f;
#pragma unroll
            for (int dt = 0; dt < 2; ++dt)
#pragma unroll
                for (int r = 0; r < 16; ++r) o[qs][dt][r] = 0.f; }
        int s = isctx ? 3 : (nb == 0 ? 1 : 0);
        v4u pk[4], pv[4];
#define AT_ISSUE(ss) do { const bf16* kg; const bf16* vg; int ldv; \
            if ((ss) < 3) { const int kb0 = (nb - 1 + (ss)) * 128; kg = KB + (size_t)(b * SEQ + kb0) * 128; vg = VT + (size_t)(b * 128) * SEQ + kb0; ldv = SEQ; } \
            else { const int kb0 = ((ss) - 3) * 128; kg = KB + (size_t)(ML + b * CTXL + kb0) * 128; vg = VTc + (size_t)(b * 128) * CTXL + kb0; ldv = CTXL; } \
            _Pragma("unroll") for (int e = 0; e < 4; ++e) { const int i = tid + 512 * e, r = i >> 4, ch = i & 15; pk[e] = *(const v4u*)(kg + (size_t)r * 128 + ch * 8); pv[e] = *(const v4u*)(vg + (size_t)r * ldv + ch * 8); } } while (0)
#define AT_WRITE(bufo) do { _Pragma("unroll") for (int e = 0; e < 4; ++e) { const int i = tid + 512 * e, r = i >> 4, ch = i & 15; \
            *(LAS v4u*)(lds + (bufo) + (r * AT_ST + ch * 8) * 2) = pk[e]; *(LAS v4u*)(lds + (bufo) + AT_HALF + (r * AT_ST + ch * 8) * 2) = pv[e]; } } while (0)
        AT_ISSUE(s);
        __syncthreads();
        AT_WRITE(0);
        __syncthreads();
        int cur = 0;
        for (;;) {
            int sn = s + 1; if (sn == 2 && !isctx && nb == 63) sn = 3;
            if (sn <= 4) AT_ISSUE(sn);
            const LAS bf16* Ks = (const LAS bf16*)(lds + cur * AT_BUF); const LAS bf16* Vs = (const LAS bf16*)(lds + cur * AT_BUF + AT_HALF);
            int t_lo = 0, t_hi = 3; const int kb0 = (nb - 1 + s) * 128;
            if (s < 3) { const int a0 = q0 - 128 - kb0, a1 = q0 + 191 - kb0; t_lo = a0 > 0 ? a0 >> 5 : 0; t_hi = (a1 >> 5) < 3 ? (a1 >> 5) : 3; }
#pragma unroll 2
            for (int kt = t_lo; kt <= t_hi; ++kt) {
                bf16x8 kf[4];
#pragma unroll
                for (int ks = 0; ks < 4; ++ks) kf[ks] = *(const LAS bf16x8*)(Ks + (kt * 32 + c) * AT_ST + h * 64 + ks * 16 + hh * 8);
                bf16x8 vf[2][2];
#pragma unroll
                for (int dt = 0; dt < 2; ++dt)
#pragma unroll
                    for (int s2 = 0; s2 < 2; ++s2) { const LAS bf16* p = Vs + (h * 64 + dt * 32 + c) * AT_ST + kt * 32 + s2 * 16 + hh * 4;
                        const v2u lo = *(const LAS v2u*)p, hi = *(const LAS v2u*)(p + 8); v4u t; t.x = lo.x; t.y = lo.y; t.z = hi.x; t.w = hi.y; vf[dt][s2] = __builtin_bit_cast(bf16x8, t); }
                f32x16 st[2];
#pragma unroll
                for (int qs = 0; qs < 2; ++qs) {
                    const float nm = -mrun[qs];
#pragma unroll
                    for (int r = 0; r < 16; ++r) st[qs][r] = nm;
#pragma unroll
                    for (int ks = 0; ks < 4; ++ks) st[qs] = MFMA32(kf[ks], qf[qs][ks], st[qs]);
                }
                bf16x8 pb[2][2];
#pragma unroll
                for (int qs = 0; qs < 2; ++qs) {
                    const int kmin = kb0 + kt * 32, qmin = q0 + qs * 32;
                    if (s < 3 && (kmin - (qmin + 31) > 128 || qmin - (kmin + 31) > 128)) continue;
                    float t[16];
#pragma unroll
                    for (int r = 0; r < 16; ++r) t[r] = st[qs][r];
                    if (s < 3 && (kmin - (qmin + 31) < -128 || kmin + 31 - qmin > 128)) {
                        const int base = kmin + 4 * hh - (qmin + c) + 128;
#pragma unroll
                        for (int r = 0; r < 16; ++r) { if ((unsigned)(base + (r & 3) + 8 * (r >> 2)) > 256u) t[r] = -1e30f; } }
                    float tmax = fmaxf(fmaxf(t[0], t[1]), t[2]);
#pragma unroll
                    for (int r = 3; r < 15; r += 2) tmax = fmaxf(fmaxf(tmax, t[r]), t[r + 1]);
                    tmax = fmaxf(tmax, t[15]);
                    { auto rr = __builtin_amdgcn_permlane32_swap(__float_as_uint(tmax), __float_as_uint(tmax), false, false); tmax = fmaxf(__uint_as_float(rr[0]), __uint_as_float(rr[1])); }
                    if (!__all(tmax <= 8.f)) {
                        const float delta = fmaxf(tmax, 0.f), alpha = __builtin_amdgcn_exp2f(-delta);
                        lrun[qs] *= alpha; mrun[qs] += delta;
#pragma unroll
                        for (int dt = 0; dt < 2; ++dt) o[qs][dt] = o[qs][dt] * alpha;
#pragma unroll
                        for (int r = 0; r < 16; ++r) t[r] -= delta;
                    }
                    float psum = 0.f;
#pragma unroll
                    for (int r = 0; r < 16; ++r) { t[r] = __builtin_amdgcn_exp2f(t[r]); psum += t[r]; }
                    { auto rr = __builtin_amdgcn_permlane32_swap(__float_as_uint(psum), __float_as_uint(psum), false, false); psum = __uint_as_float(rr[0]) + __uint_as_float(rr[1]); }
                    lrun[qs] += psum;
#pragma unroll
                    for (int s2 = 0; s2 < 2; ++s2) { v4u w; w.x = cvt_pk_bf16(t[8 * s2 + 0], t[8 * s2 + 1]); w.y = cvt_pk_bf16(t[8 * s2 + 2], t[8 * s2 + 3]); w.z = cvt_pk_bf16(t[8 * s2 + 4], t[8 * s2 + 5]); w.w = cvt_pk_bf16(t[8 * s2 + 6], t[8 * s2 + 7]);
                        pb[qs][s2] = __builtin_bit_cast(bf16x8, w); }
#pragma unroll
                    for (int s2 = 0; s2 < 2; ++s2)
#pragma unroll
                        for (int dt = 0; dt < 2; ++dt) o[qs][dt] = MFMA32(vf[dt][s2], pb[qs][s2], o[qs][dt]);
                    __builtin_amdgcn_sched_barrier(0);
                }
            }
            if (sn > 4) break;
            AT_WRITE((cur ^ 1) * AT_BUF);
            __syncthreads();
            cur ^= 1; s = sn;
        }
#undef AT_ISSUE
#undef AT_WRITE
        float ssq[2];
#pragma unroll
        for (int qs = 0; qs < 2; ++qs) { const float inv = 1.f / lrun[qs]; float ss = 0.f;
#pragma unroll
            for (int dt = 0; dt < 2; ++dt) { o[qs][dt] = o[qs][dt] * inv;
#pragma unroll
                for (int r = 0; r < 16; ++r) ss += o[qs][dt][r] * o[qs][dt][r]; }
            { auto rr = __builtin_amdgcn_permlane32_swap(__float_as_uint(ss), __float_as_uint(ss), false, false); ss = __uint_as_float(rr[0]) + __uint_as_float(rr[1]); }
            ssq[qs] = ss; if (hh == 0) red[wave * 64 + qs * 32 + c] = ss; }
        __syncthreads();
        LAS bf16* otile = (LAS bf16*)(lds + wave * 9216);
#pragma unroll
        for (int qs = 0; qs < 2; ++qs) { float tot = 0.f;
#pragma unroll
            for (int w = 0; w < 8; ++w) tot += red[w * 64 + qs * 32 + c];
            const float rn = rsqrtf(tot * (1.f / 512.f) + EPSN);
#pragma unroll
            for (int dt = 0; dt < 2; ++dt)
#pragma unroll
                for (int rg = 0; rg < 4; ++rg) { const f32x4 gm = *(const f32x4*)(gmix + wave * 64 + dt * 32 + rg * 8 + hh * 4);
                    v2u w; w.x = cvt_pk_bf16(o[qs][dt][4 * rg] * rn * gm[0], o[qs][dt][4 * rg + 1] * rn * gm[1]); w.y = cvt_pk_bf16(o[qs][dt][4 * rg + 2] * rn * gm[2], o[qs][dt][4 * rg + 3] * rn * gm[3]);
                    *(LAS v2u*)(otile + (qs * 32 + c) * 72 + dt * 32 + rg * 8 + hh * 4) = w; } }
        LDS_WAIT();
#pragma unroll
        for (int it = 0; it < 8; ++it) { const int r = it * 8 + (lane >> 3), ch = lane & 7; const v4u v = *(const LAS v4u*)(otile + r * 72 + ch * 8);
            *(v4u*)(MIX + (qrow0 + r) * 1024 + wave * 64 + ch * 8) = v; }
    }
    __syncthreads();
}

__device__ __forceinline__ void sgu_units(LAS unsigned char* lds, const bf16* UB, const bf16* GVT, const bf16* GVTc, bf16* MIX, const float* wsgu, const float* bsgu, const float* gsgu, const float* gmix,
                                          int nchunks, int G, int bid, int tid) {
    asm volatile("" : "+v"(tid));
    const int wave = __builtin_amdgcn_readfirstlane(tid >> 6), lane = tid & 63, hd = wave >> 1, ph = wave & 1, c = lane & 31, h2 = lane >> 5;
    LAS float* rq = (LAS float*)lds + wave * 128;
    bf16x8 bfr[2][8];
#pragma unroll
    for (int ps = 0; ps < 2; ++ps)
#pragma unroll
        for (int ks = 0; ks < 8; ++ks) { const float* wp = wsgu + ((size_t)(hd * 128 + ph * 64 + ps * 32 + c)) * 128 + ks * 16 + h2 * 8; const f32x4 w0 = *(const f32x4*)wp, w1 = *(const f32x4*)(wp + 4);
            v4u w; w.x = cvt_pk_bf16(w0[0], w0[1]); w.y = cvt_pk_bf16(w0[2], w0[3]); w.z = cvt_pk_bf16(w1[0], w1[1]); w.w = cvt_pk_bf16(w1[2], w1[3]); bfr[ps][ks] = __builtin_bit_cast(bf16x8, w); }
    for (int L = bid; L < nchunks; L += G) {
        const int chunk = (L < 512 && (G & 7) == 0) ? (L & 7) * 64 + (L >> 3) : L;
        const bool isctx = chunk >= 512; const int b = isctx ? (chunk - 512) >> 1 : chunk >> 6, s0 = isctx ? ((chunk - 512) & 1) * 128 : (chunk & 63) * 128;
        const int ld = isctx ? CTXL : SEQ;
        const bf16* Gt = (isctx ? GVTc + ((size_t)(b * 256 + hd * 64)) * CTXL : GVT + ((size_t)(b * 256 + hd * 64)) * SEQ) + s0;
        float sa = 0.f, sb = 0.f;
#pragma unroll 1
        for (int d0 = 0; d0 < 64; d0 += 32) { unsigned gv[32];
#pragma unroll
            for (int d = 0; d < 32; ++d) gv[d] = *(const unsigned*)(Gt + (size_t)(d0 + d) * ld + 2 * lane);
#pragma unroll
            for (int d = 0; d < 32; ++d) { const float x0 = bflo(gv[d]), x1 = bfhi(gv[d]); sa += x0 * x0; sb += x1 * x1; } }
        LDS_WAIT();
        rq[2 * lane] = rsqrtf(sa * (1.f / 64.f) + EPSN); rq[2 * lane + 1] = rsqrtf(sb * (1.f / 64.f) + EPSN);
        LDS_WAIT();
        f32x16 o[2][2];
#pragma unroll
        for (int dt = 0; dt < 2; ++dt)
#pragma unroll
            for (int ps = 0; ps < 2; ++ps)
#pragma unroll
                for (int r = 0; r < 16; ++r) o[dt][ps][r] = 0.f;
        v4u afr[2][8];
#pragma unroll
        for (int ks = 0; ks < 8; ++ks)
#pragma unroll
            for (int dt = 0; dt < 2; ++dt) afr[dt][ks] = *(const v4u*)(Gt + (size_t)(dt * 32 + c) * ld + ks * 16 + h2 * 8);
        LAS bf16* utile = (LAS bf16*)(lds + 8192 + wave * 9216);
        { v4u ut[8];
#pragma unroll
          for (int it = 0; it < 8; ++it) ut[it] = *(const v4u*)(UB + ((size_t)chunk * 128 + ph * 64 + it * 8 + (lane >> 3)) * 256 + hd * 64 + (lane & 7) * 8);
#pragma unroll
          for (int it = 0; it < 8; ++it) *(LAS v4u*)(utile + (it * 8 + (lane >> 3)) * 72 + (lane & 7) * 8) = ut[it]; }
#pragma unroll
        for (int ks = 0; ks < 8; ++ks) {
            const f32x4 r0 = *(const LAS f32x4*)(rq + ks * 16 + h2 * 8), r1 = *(const LAS f32x4*)(rq + ks * 16 + h2 * 8 + 4);
#pragma unroll
            for (int dt = 0; dt < 2; ++dt) { const v4u g = afr[dt][ks]; v4u w;
                w.x = cvt_pk_bf16(bflo(g.x) * r0[0], bfhi(g.x) * r0[1]); w.y = cvt_pk_bf16(bflo(g.y) * r0[2], bfhi(g.y) * r0[3]); w.z = cvt_pk_bf16(bflo(g.z) * r1[0], bfhi(g.z) * r1[1]); w.w = cvt_pk_bf16(bflo(g.w) * r1[2], bfhi(g.w) * r1[3]);
                const bf16x8 af = __builtin_bit_cast(bf16x8, w);
#pragma unroll
                for (int ps = 0; ps < 2; ++ps) o[dt][ps] = MFMA32(af, bfr[ps][ks], o[dt][ps]); }
        }
        LAS float* red2 = (LAS float*)(lds + 4096);
#pragma unroll
        for (int ps = 0; ps < 2; ++ps) { const int p = ph * 64 + ps * 32 + c; const size_t row = (size_t)chunk * 128 + p; const float bs = bsgu[hd * 128 + p]; float ss = 0.f;
#pragma unroll
            for (int dt = 0; dt < 2; ++dt)
#pragma unroll
                for (int rg = 0; rg < 4; ++rg) { const int d0 = dt * 32 + rg * 8 + h2 * 4; const f32x4 gs = *(const f32x4*)(gsgu + hd * 64 + d0);
                    const v2u uw = *(const LAS v2u*)(utile + (ps * 32 + c) * 72 + d0);
                    const float o0 = bflo(uw.x) * (gs[0] * o[dt][ps][4 * rg] + bs), o1 = bfhi(uw.x) * (gs[1] * o[dt][ps][4 * rg + 1] + bs), o2 = bflo(uw.y) * (gs[2] * o[dt][ps][4 * rg + 2] + bs), o3 = bfhi(uw.y) * (gs[3] * o[dt][ps][4 * rg + 3] + bs);
                    o[dt][ps][4 * rg] = o0; o[dt][ps][4 * rg + 1] = o1; o[dt][ps][4 * rg + 2] = o2; o[dt][ps][4 * rg + 3] = o3; ss += (o0 * o0 + o1 * o1) + (o2 * o2 + o3 * o3); }
            { auto rr = __builtin_amdgcn_permlane32_swap(__float_as_uint(ss), __float_as_uint(ss), false, false); ss = __uint_as_float(rr[0]) + __uint_as_float(rr[1]); }
            if (h2 == 0) red2[hd * 128 + p] = ss; }
        __syncthreads();
        LAS bf16* otile = (LAS bf16*)(lds + 8192 + wave * 9216);
#pragma unroll
        for (int ps = 0; ps < 2; ++ps) { const int p = ph * 64 + ps * 32 + c;
            const float rn = rsqrtf((red2[p] + red2[128 + p] + red2[256 + p] + red2[384 + p]) * (1.f / 256.f) + EPSN);
#pragma unroll
            for (int dt = 0; dt < 2; ++dt)
#pragma unroll
                for (int rg = 0; rg < 4; ++rg) { const int d0 = dt * 32 + rg * 8 + h2 * 4; const f32x4 gm = *(const f32x4*)(gmix + 512 + hd * 64 + d0);
                    v2u w; w.x = cvt_pk_bf16(o[dt][ps][4 * rg] * rn * gm[0], o[dt][ps][4 * rg + 1] * rn * gm[1]); w.y = cvt_pk_bf16(o[dt][ps][4 * rg + 2] * rn * gm[2], o[dt][ps][4 * rg + 3] * rn * gm[3]);
                    *(LAS v2u*)(otile + (ps * 32 + c) * 72 + d0) = w; } }
        LDS_WAIT();
#pragma unroll
        for (int it = 0; it < 8; ++it) { const int r = it * 8 + (lane >> 3), ch = lane & 7; const v4u v = *(const LAS v4u*)(otile + r * 72 + ch * 8);
            *(v4u*)(MIX + ((size_t)chunk * 128 + ph * 64 + r) * 1024 + 512 + hd * 64 + ch * 8) = v; }
        LDS_WAIT();
        __syncthreads();
    }
}

__device__ __forceinline__ void fourier_stage2(LAS unsigned char* lds, int wave, const bf16* Tp, bf16* MIX, const float* gmix, int gw, int NGW, int lane) {
    asm volatile("" : "+v"(lane));
    LAS bf16* slab = (LAS bf16*)(lds + wave * 8448);
    const int k2 = lane & 15, kq = lane >> 4, prt = kq >> 1, s2b = (kq & 1) * 8;
    constexpr float NRM = 0.0013810679320049757f;
    for (int item = gw; item < 4096; item += NGW) {
        const int k1 = item >> 3, b = item & 7, k = k1 + 512 * k2;
        const int k1p = k1 <= 256 ? k1 : 512 - k1;
        const float imf = (k1p == 0 || k1p == 256) ? 0.f : (k1 > 256 ? -1.f : 1.f);
        const int trow = prt == 0 ? k1p : ((k1p == 0 || k1p == 256) ? 0 : 256 + k1p);
        unsigned wr_[4], wi_[4];
#pragma unroll
        for (int jj = 0; jj < 4; ++jj) { float c[2], sn[2];
#pragma unroll
            for (int u = 0; u < 2; ++u) { const int n = (k * (s2b + 2 * jj + u)) & 8191; const float rev = (float)n * (1.f / 8192.f); c[u] = __builtin_amdgcn_cosf(rev); sn[u] = __builtin_amdgcn_sinf(rev); }
            wr_[jj] = prt == 0 ? cvt_pk_bf16(c[0], c[1]) : cvt_pk_bf16(imf * sn[0], imf * sn[1]);
            wi_[jj] = prt == 0 ? cvt_pk_bf16(sn[0], sn[1]) : cvt_pk_bf16(-imf * c[0], -imf * c[1]); }
        v4u t0; t0.x = wr_[0]; t0.y = wr_[1]; t0.z = wr_[2]; t0.w = wr_[3]; const bf16x8 bR = __builtin_bit_cast(bf16x8, t0);
        v4u t1; t1.x = wi_[0]; t1.y = wi_[1]; t1.z = wi_[2]; t1.w = wi_[3]; const bf16x8 bI = __builtin_bit_cast(bf16x8, t1);
        const bf16* ap = Tp + (size_t)trow * 32768 + ((size_t)(b * 256 + k2) * 16 + s2b);
        bf16x8 af[16];
#pragma unroll
        for (int t = 0; t < 16; ++t) af[t] = *(const bf16x8*)(ap + t * 256);
        f32x4 y[16]; float ss = 0.f;
#pragma unroll
        for (int t = 0; t < 16; ++t) {
            const f32x4 z4 = {0.f, 0.f, 0.f, 0.f};
            const f32x4 aR = __builtin_amdgcn_mfma_f32_16x16x32_bf16(af[t], bR, z4, 0, 0, 0), aI = __builtin_amdgcn_mfma_f32_16x16x32_bf16(af[t], bI, z4, 0, 0, 0);
            const bool special = ((t & 3) == 0) && kq == 0;
            const float p0 = aR[0] * NRM, p1 = (special ? aR[1] : aI[1]) * NRM, p2 = aR[2] * NRM, p3 = aI[3] * NRM;
            f32x4 o; o[0] = special ? p0 : p0 + p1; o[1] = special ? p1 : p0 - p1; o[2] = p2 + p3; o[3] = p2 - p3;
            y[t] = o; ss += (o[0] * o[0] + o[1] * o[1]) + (o[2] * o[2] + o[3] * o[3]); }
        ss += __shfl_xor(ss, 16); ss += __shfl_xor(ss, 32);
        const float rn = rsqrtf(ss * (1.f / 256.f) + EPSN);
#pragma unroll
        for (int t = 0; t < 16; ++t) { const float* gb = gmix + 768 + (t >> 2) * 64; const int p = 16 * (t & 3) + 4 * kq;
            v2u w; w.x = cvt_pk_bf16(y[t][0] * rn * gb[fsig(p)], y[t][1] * rn * gb[fsig(p + 1)]); w.y = cvt_pk_bf16(y[t][2] * rn * gb[fsig(p + 2)], y[t][3] * rn * gb[fsig(p + 3)]);
            *(LAS v2u*)(slab + k2 * 264 + 16 * t + 4 * kq) = w; }
        LDS_WAIT();
#pragma unroll
        for (int it = 0; it < 8; ++it) { const int r = it * 2 + (lane >> 5), ch = lane & 31; const v4u v = *(const LAS v4u*)(slab + r * 264 + ch * 8);
            *(v4u*)(MIX + ((size_t)b * SEQ + k1 + 512 * r) * 1024 + 768 + ch * 8) = v; }
        LDS_WAIT();
    }
}
__device__ __forceinline__ void ctx_fourier_norm(bf16* MIX, const float* gmix, int gw, int NGW, int lane) {
    asm volatile("" : "+v"(lane));
    const int pg = (lane * 4) & 63, grp = lane >> 4;
    for (int row = ML + gw; row < MT; row += NGW) { bf16* p = MIX + (size_t)row * 1024 + 768 + lane * 4;
        const v2u w = *(const v2u*)p; const float a0 = bflo(w.x), b0 = bfhi(w.x), a1 = bflo(w.y), b1 = bfhi(w.y);
        const bool pass = pg == 0;
        const float v0 = pass ? a0 : a0 + b0, v1 = pass ? b0 : a0 - b0, v2 = a1 + b1, v3 = a1 - b1;
        const float rn = rsqrtf(wave_sum((v0 * v0 + v1 * v1) + (v2 * v2 + v3 * v3)) * (1.f / 256.f) + EPSN);
        const float* gb = gmix + 768 + grp * 64;
        v2u o; o.x = cvt_pk_bf16(v0 * rn * gb[fsig(pg)], v1 * rn * gb[fsig(pg + 1)]); o.y = cvt_pk_bf16(v2 * rn * gb[fsig(pg + 2)], v3 * rn * gb[fsig(pg + 3)]); *(v2u*)p = o; }
}

#define XB_TMO      128
#define XB_XCNT(j)  (256  + 64 * (j))
#define XB_XSUB(j)  (1280 + 64 * (j))
#define XB_XGEN(j)  (2304 + 64 * (j))
#define XB_TOP      3328
#define XB_TOPGEN   3392
#define XCD_BAR_WORDS 3456
#define XB_SPIN_CAP (1u << 18)

__device__ __forceinline__ unsigned xb_ld(unsigned* p)              { return __hip_atomic_load(p, __ATOMIC_RELAXED, __HIP_MEMORY_SCOPE_AGENT); }
__device__ __forceinline__ unsigned xb_add(unsigned* p, unsigned v) { return __hip_atomic_fetch_add(p, v, __ATOMIC_RELAXED, __HIP_MEMORY_SCOPE_AGENT); }
__device__ __forceinline__ unsigned xb_xcc_id() { return (unsigned)__builtin_amdgcn_s_getreg((3 << 11) | 20) & 0xFu; }
#define XB_SPIN(cond, bar) do { unsigned _sp = 0; while (cond) { __builtin_amdgcn_s_sleep(1); \
    if ((++_sp & 255u) == 0u) { if (xb_ld(&(bar)[XB_TMO])) break; if (_sp > XB_SPIN_CAP) { atomicAdd(&(bar)[XB_TMO], 1u); break; } } } } while (0)

struct XcdBarrier {
    unsigned* bar; unsigned x;
    volatile LAS unsigned* st;
};

__device__ __forceinline__ XcdBarrier xcd_barrier_post(unsigned* bar, volatile LAS unsigned* st) {
    XcdBarrier b; b.bar = bar; b.x = xb_xcc_id(); b.st = st;
    if (threadIdx.x == 0) (void)xb_add(&bar[XB_XCNT(b.x)], 1u);
    return b;
}
__device__ __forceinline__ void xcd_barrier_complete(unsigned* bar, unsigned x, unsigned& nloc, unsigned& nx) {
    const unsigned G = gridDim.x * gridDim.y * gridDim.z;
    unsigned sum, cnt, mine, sp = 0u;
    for (;;) {
        sum = 0u; cnt = 0u; mine = 0u;
#pragma unroll
        for (unsigned j = 0; j < 16; ++j) { const unsigned c = xb_ld(&bar[XB_XCNT(j)]); sum += c; cnt += (c > 0u) ? 1u : 0u; mine = (j == x) ? c : mine; }
        if (sum == G) break;
        __builtin_amdgcn_s_sleep(1);
        if ((++sp & 255u) == 0u) { if (xb_ld(&bar[XB_TMO])) break; if (sp > XB_SPIN_CAP) { atomicAdd(&bar[XB_TMO], 1u); break; } }
    }
    nloc = mine > 0u ? mine : 1u; nx = cnt > 0u ? cnt : 1u;
}

__device__ __forceinline__ void xcd_barrier(const XcdBarrier& b) {
    asm volatile("s_waitcnt vmcnt(0)" ::: "memory");
    __syncthreads();
    if (threadIdx.x == 0) {
        unsigned* bar = b.bar;
        __builtin_amdgcn_s_waitcnt(0);
        unsigned nloc = b.st[0], nx = b.st[1];
        if (nloc == 0u) { xcd_barrier_complete(bar, b.x, nloc, nx); b.st[0] = nloc; b.st[1] = nx; }
        const unsigned old = xb_add(&bar[XB_XSUB(b.x)], 1u);
        const unsigned gen = old / nloc;
        if (old + 1u == (gen + 1u) * nloc) {
            __builtin_amdgcn_fence(__ATOMIC_RELEASE, "agent");
            asm volatile("s_waitcnt vmcnt(0)" ::: "memory");
            const unsigned og = xb_add(&bar[XB_TOP], 1u);
            const unsigned tg = og / nx;
            if (og + 1u == (tg + 1u) * nx) xb_add(&bar[XB_TOPGEN], 1u);
            else XB_SPIN(xb_ld(&bar[XB_TOPGEN]) == tg, bar);
            __builtin_amdgcn_fence(__ATOMIC_ACQUIRE, "agent");
            xb_add(&bar[XB_XGEN(b.x)], 1u);
            asm volatile("s_waitcnt vmcnt(0)" ::: "memory");
        } else {
            XB_SPIN(xb_ld(&bar[XB_XGEN(b.x)]) == gen, bar);
            __builtin_amdgcn_fence(__ATOMIC_ACQUIRE, "agent");
            asm volatile("s_waitcnt vmcnt(0)" ::: "memory");
        }
    }
    __syncthreads();
}

__global__ void __launch_bounds__(512, 2) fwd_megakernel(Args a) {
    extern __shared__ __attribute__((aligned(16))) unsigned char lds_raw[];
    LAS unsigned char* lds = (LAS unsigned char*)lds_raw;
    cg::grid_group grid = cg::this_grid();
#define GSYNC() do { XcdBarrier xb_; xb_.bar = (unsigned*)(ws + WS_BAR); xb_.x = xb_xcc_id(); xb_.st = (volatile LAS unsigned*)(lds + LDS_BARST); xcd_barrier(xb_); } while (0)
    const int tid = threadIdx.x, lane = tid & 63, wave = __builtin_amdgcn_readfirstlane(tid >> 6);
    const int bid = blockIdx.x, G = gridDim.x;
    const int gw = bid * 8 + wave, NGW = G * 8;
    unsigned char* ws = a.ws;
    const float* MOD = (const float*)(ws + WS_MOD);
    bf16* HX = (bf16*)(ws + WS_HX); bf16* YB = (bf16*)(ws + WS_XR);
    float* X1C = (float*)(ws + WS_XR + 132 * MiB) - (size_t)ML * DM;
    bf16* MIX = (bf16*)(ws + WS_MIX);
    if (bid == 0) { for (int i = tid; i < XCD_BAR_WORDS; i += 512) __hip_atomic_store((unsigned*)(ws + WS_BAR) + i, 0u, __ATOMIC_RELAXED, __HIP_MEMORY_SCOPE_AGENT); }

#ifndef SKIP_P0
    p0_prologue(a, lds, bid, G, tid);
#endif
    __syncthreads();
    if (tid < 2) ((volatile LAS unsigned*)(lds + LDS_BARST))[tid] = 0u;
    grid.sync();
    (void)xcd_barrier_post((unsigned*)(ws + WS_BAR), (volatile LAS unsigned*)(lds + LDS_BARST));
    __syncthreads();
    for (int row = gw * 4; row < MT; row += NGW * 4) {
        const int mr = row < ML ? row >> 13 : 8; const float* md = MOD + (size_t)mr * 6144;
        const float* xin = row < ML ? a.in[0] + (size_t)row * DM : a.in[2] + (size_t)(row - ML) * DM;
#ifdef PROBE_ROWS
        row_op<4>(xin, nullptr, nullptr, nullptr, nullptr, (bf16*)(ws + WS_C) + (size_t)row * DM, a.in[6], md + 1024, md, lane);
#endif
        row_op<4>(xin, nullptr, nullptr, nullptr, nullptr, HX + (size_t)row * DM, a.in[6], md + 1024, md, lane);
    }
    GSYNC();
#pragma unroll 1
    for (int l = 0; l < 2; ++l) {
        const bool last = l == 1;
        const int MR = last ? ML : MT;
        const float* modl = MOD + (size_t)l * 9 * 6144;
#ifndef SKIP_G1
        {
            int fM = MT, fN = NIN, fK = DM; asm volatile("" : "+s"(fM), "+s"(fN), "+s"(fK));
            pg8::Gemm g{HX, (const bf16*)(ws + WS_WIN) + (size_t)l * NIN * 1024, fM, fN, fK}; pg8::StaticOrder S; S.init(fM, fN, G, bid);
            EpiIn E{ws, last ? 1 : 0};
            pg8::gemm_phase<EpiIn, pg8::StaticOrder, true, true>(lds, g, S, E);
        }
#endif
        GSYNC();
        const float* gmixl = a.in[12] + l * 1024;
        attn_units(lds, (const bf16*)(ws + WS_QB), (const bf16*)(ws + WS_KB), (const bf16*)(ws + WS_VT), (const bf16*)(ws + WS_VTC), MIX, a.in[8] + l * 8, gmixl, last ? 1024 : 1056, G, bid, tid);
        sgu_units(lds, (const bf16*)(ws + WS_UB), (const bf16*)(ws + WS_GVT), (const bf16*)(ws + WS_GVTC), MIX, a.in[9] + (size_t)l * 4 * 128 * 128, a.in[10] + l * 512, a.in[11] + l * 256, gmixl,
                  last ? 512 : 528, G, (bid + 224) % G, tid);
        __syncthreads();
#ifndef SKIP_F1
        {
            int fM = 512, fN = 32768, fK = 512; asm volatile("" : "+s"(fM), "+s"(fN), "+s"(fK));
            pg8::Gemm g{(const bf16*)(ws + WS_DFT512), (const bf16*)(ws + WS_GT), fM, fN, fK}; pg8::StaticOrder S; S.init(fM, fN, G, bid);
            pg8::EpiPlain<0, false> E{(bf16*)(ws + WS_TP), fN, 1.f};
            pg8::gemm_phase<pg8::EpiPlain<0, false>, pg8::StaticOrder, true, true>(lds, g, S, E);
        }
#endif
#ifndef SKIP_CF
        if (!last) {
            int fM = 256, fN = 2048, fK = 512, fL = 1024; asm volatile("" : "+s"(fM), "+s"(fN), "+s"(fK), "+s"(fL));
            pg8::Gemm g{(const bf16*)(ws + WS_DFT256), (const bf16*)(ws + WS_GTC), fM, fN, fK}; pg8::StaticOrder S; S.init(fM, fN, G, (bid + 208) % G);
            pg8::EpiPlain<0, true> E{MIX + (size_t)ML * 1024 + 768, fL, 0.0078125f};
            pg8::gemm_phase<pg8::EpiPlain<0, true>, pg8::StaticOrder, true, true>(lds, g, S, E);
        }
#endif
        GSYNC();
        fourier_stage2(lds, wave, (const bf16*)(ws + WS_TP), MIX, gmixl, gw, NGW, lane);
        if (!last) ctx_fourier_norm(MIX, gmixl, gw, NGW, lane);
        GSYNC();
#ifndef SKIP_G2
        {
            pg8::Gemm g{MIX, (const bf16*)(ws + WS_WOUT) + (size_t)l * 1024 * 1024, ML, DM, DM, 0}; pg8::StaticOrder S; S.init(ML, DM, G, bid);
            pg8::EpiPlain<0, false> E{YB, DM, 1.f};
            pg8::gemm_phase<pg8::EpiPlain<0, false>, pg8::StaticOrder, true, true>(lds, g, S, E);
        }
        if (!last) {
            int fK = 256, fL = DM; asm volatile("" : "+s"(fK), "+s"(fL));
            pg8::Gemm g{MIX, (const bf16*)(ws + WS_WOUT) + (size_t)l * 1024 * 1024, MT, DM, fK, fL}; pg8::SplitKOrder S{G, bid, 256, 8, 4, 4, fK * 2};
            pg8::EpiPart E{(float*)(ws + WS_PART), fL, fK * 2, 256, (size_t)2048 * 1024};
            pg8::gemm_phase<pg8::EpiPart, pg8::SplitKOrder, true, true>(lds, g, S, E);
        }
#endif
        GSYNC();
        for (int row = gw * 4; row < ML; row += NGW * 4) {
            const float* md = modl + (size_t)(row >> 13) * 6144;
            const float* xin = l == 0 ? a.in[0] + (size_t)row * DM : a.out + (size_t)row * DM;
            row_op<4>(xin, YB + (size_t)row * DM, md + 2048, a.in[14] + l * 1024, nullptr, HX + (size_t)row * DM, a.in[15] + l * 1024, md + 4096, md + 3072, lane);
        }
        if (!last) for (int row = ML + gw * 2; row < MT; row += NGW * 2) {
            const float* md = modl + (size_t)8 * 6144;
            row_op<2, 4>(a.in[2] + (size_t)(row - ML) * DM, (const bf16*)((const float*)(ws + WS_PART) + (size_t)(row - ML) * DM), md + 2048, a.in[14] + l * 1024, X1C + (size_t)row * DM, HX + (size_t)row * DM, a.in[15] + l * 1024, md + 4096, md + 3072, lane);
        }
        GSYNC();
#ifndef SKIP_G3
        {
            pg8::Gemm g{HX, (const bf16*)(ws + WS_WFF1) + (size_t)l * 4096 * 1024, MR, DFF, DM}; pg8::StaticOrder S; S.init(MR, DFF, G, bid);
            pg8::EpiPlain<1, false> E{(bf16*)(ws + WS_H1), DFF, 1.f};
            pg8::gemm_phase<pg8::EpiPlain<1, false>, pg8::StaticOrder, true, true>(lds, g, S, E);
        }
#endif
        GSYNC();
#ifndef SKIP_G4
        {
            pg8::Gemm g{(const bf16*)(ws + WS_H1), (const bf16*)(ws + WS_WFF2) + (size_t)l * 1024 * 4096, ML, DM, DFF, 0}; pg8::StaticOrder S; S.init(ML, DM, G, bid);
            pg8::EpiPlain<0, false> E{HX, DM, 1.f};
            pg8::gemm_phase<pg8::EpiPlain<0, false>, pg8::StaticOrder, true, true>(lds, g, S, E);
        }
        if (!last) {
            int fK = 1024, fL = DFF, fC = DM; asm volatile("" : "+s"(fK), "+s"(fL), "+s"(fC));
            pg8::Gemm g{(const bf16*)(ws + WS_H1), (const bf16*)(ws + WS_WFF2) + (size_t)l * 1024 * 4096, MT, DM, fK, fL}; pg8::SplitKOrder S{G, bid, 256, 8, 4, 4, fK * 2};
            pg8::EpiPart E{(float*)(ws + WS_PART), fC, fK * 2, 256, (size_t)2048 * 1024};
            pg8::gemm_phase<pg8::EpiPart, pg8::SplitKOrder, true, true>(lds, g, S, E);
        }
#endif
        GSYNC();
        for (int row = gw * 4; row < ML; row += NGW * 4) {
            const int mr = row >> 13; const float* md = modl + (size_t)mr * 6144;
            const float* xin = l == 0 ? a.in[0] + (size_t)row * DM : a.out + (size_t)row * DM;
            if (!last) { const float* mdn = MOD + (size_t)(9 + mr) * 6144;
                row_op<4>(xin, YB + (size_t)row * DM, md + 2048, a.in[14] + l * 1024, a.out + (size_t)row * DM, HX + (size_t)row * DM, a.in[6] + 1024, mdn + 1024, mdn, lane,
                          HX + (size_t)row * DM, md + 5120, a.in[18] + l * 1024);
            } else row_op<4>(xin, YB + (size_t)row * DM, md + 2048, a.in[14] + l * 1024, a.out + (size_t)row * DM, nullptr, nullptr, nullptr, nullptr, lane,
                             HX + (size_t)row * DM, md + 5120, a.in[18] + l * 1024);
        }
        if (!last) for (int row = ML + gw * 2; row < MT; row += NGW * 2) {
            const float* md = modl + (size_t)8 * 6144; const float* mdn = MOD + (size_t)(9 + 8) * 6144;
            row_op<2, 4>(X1C + (size_t)row * DM, (const bf16*)((const float*)(ws + WS_PART) + (size_t)(row - ML) * DM), md + 5120, a.in[18] + l * 1024, nullptr, HX + (size_t)row * DM, a.in[6] + 1024, mdn + 1024, mdn, lane);
        }
        if (!last) GSYNC();
    }
}

extern "C" void kernel_launch(void* const* d_in, const int* in_sizes, int n_in, void* d_out, int out_size, void* d_ws, size_t ws_size, hipStream_t stream) {
    static int grid = 0;
    if (grid == 0) {
        if (n_in != 19 || ws_size < WS_TOTAL) { fprintf(stderr, "kernel_launch: unexpected n_in %d / ws %zu\n", n_in, ws_size); grid = -1; return; }
        int dev = 0, cus = 0, per_cu = 0;
        hipGetDevice(&dev);
        hipDeviceGetAttribute(&cus, hipDeviceAttributeMultiprocessorCount, dev);
        hipFuncSetAttribute((const void*)fwd_megakernel, hipFuncAttributeMaxDynamicSharedMemorySize, LDS_BYTES);
        hipOccupancyMaxActiveBlocksPerMultiprocessor(&per_cu, (const void*)fwd_megakernel, 512, LDS_BYTES);
        if (per_cu < 1) per_cu = 1;
        grid = cus * per_cu;
        (void)hipGetLastError();
    }
    if (grid < 0) return;
    Args a{};
    for (int i = 0; i < 19; ++i) a.in[i] = (const float*)d_in[i];
    a.out = (float*)d_out; a.ws = (unsigned char*)d_ws;
    void* args[] = {&a};
    hipError_t e = hipLaunchCooperativeKernel((const void*)fwd_megakernel, dim3(grid), dim3(512), args, LDS_BYTES, stream);
    if (e != hipSuccess) fprintf(stderr, "cooperative launch failed: %s (grid %d)\n", hipGetErrorString(e), grid);
}
```

```cpp
#include <hip/hip_runtime.h>
#include <hip/hip_cooperative_groups.h>
#include <cstdio>
#include <cstdint>
namespace cg = cooperative_groups;
namespace pg8 {
#define PG8_LAS __attribute__((address_space(3)))
typedef unsigned short bf16_t;
typedef short bf16x8 __attribute__((ext_vector_type(8)));
typedef float f32x4 __attribute__((ext_vector_type(4)));
typedef unsigned u32x4 __attribute__((ext_vector_type(4)));
constexpr int BM = 256, BK = 64, HALF = 128, HTB = HALF * BK * 2  , STAGE_BYTES = 8 * HTB, NXCD = 8, WGM = 8;

__host__ __device__ __forceinline__ int lds_byte(int r, int c) { const int st = (r >> 4) * 2 + (c >> 5), rr = r & 15, cc = c & 31, ob = rr * 64 + cc * 2; return st * 1024 + (ob ^ (((ob >> 9) & 1) << 5)); }
__host__ __device__ __forceinline__ void stage_rc(int b, int& R, int& C) { const int st = b / 1024, sb = b % 1024, swz = sb ^ (((sb >> 9) & 1) << 5); R = (st >> 1) * 16 + swz / 64; C = (st & 1) * 32 + (swz % 64) / 2; }
__host__ __device__ __forceinline__ int perm32(int rho) { const int n = rho >> 4, i = rho & 15; return 8 * (i >> 2) + 4 * n + (i & 3); }

struct Unit { int pm, pn, ko; };
struct Gemm { const bf16_t* A; const bf16_t* Bt; int M, N, K, ld; };

struct StaticOrder {
    int nM, nN, nwg, G, c;
    __host__ __device__ void init(int M, int N, int G_, int c_) { nM = M / BM; nN = N / BM; nwg = nM * nN; G = G_; c = c_; }
    __host__ __device__ bool next(int i, Unit& u) const {
        const long L = (long)i * G + c; if (L >= nwg) return false;
        int wgid = (int)L; { const int q = nwg / NXCD, r = nwg % NXCD, xcd = wgid % NXCD, off = wgid / NXCD; wgid = (xcd < r ? xcd * (q + 1) : r * (q + 1) + (xcd - r) * q) + off; }
        const int nig = WGM * nN, gid = wgid / nig, fm = gid * WGM, gsz = (nM - fm) < WGM ? (nM - fm) : WGM;
        u.pm = fm + ((wgid % nig) % gsz); u.pn = (wgid % nig) / gsz; u.ko = 0; return true;
    }
    __device__ __forceinline__ void a_ready(const Unit&) const {}
    __device__ __forceinline__ void done(const Unit&) const {}
};

__device__ __forceinline__ unsigned cvt_pk_bf16(float lo, float hi) { unsigned r; asm volatile("v_cvt_pk_bf16_f32 %0, %1, %2" : "=v"(r) : "v"(lo), "v"(hi)); return r; }
typedef float f32x2 __attribute__((ext_vector_type(2)));
typedef unsigned u32x2 __attribute__((ext_vector_type(2)));
__device__ __forceinline__ unsigned short f2bf1(float f) { return (unsigned short)(cvt_pk_bf16(f, 0.f) & 0xffffu); }
__device__ __forceinline__ float gelu_tanh(float x) {
    const float u = 0.7978845608f * (x + 0.044715f * x * x * x);
    return x * __builtin_amdgcn_rcpf(1.0f + __builtin_amdgcn_exp2f(-2.885390082f * u));
}
template <int ACT, bool REMAP> struct EpiPlain {
    static constexpr bool PERM = true, AFTER_DRAIN = false;
    bf16_t* O; int ldc; float scale;
    __device__ __forceinline__ void operator()(const f32x4 (&acc)[2][2][4][2], const Unit& u, int wr, int wc, int fr, int fq) const {
        asm volatile("" : "+v"(fr), "+v"(fq));
        const int row0 = (REMAP ? u.pn * BM : u.pm * BM) + wr * 64 + fr; const int col0 = (REMAP ? 0 : u.pn * BM) + wc * 32 + 8 * fq;
#pragma unroll
        for (int ai = 0; ai < 2; ++ai)
#pragma unroll
            for (int m = 0; m < 4; ++m) { bf16_t* rowp = O + (size_t)(row0 + ai * HALF + m * 16) * ldc + col0;
#pragma unroll
                for (int bj = 0; bj < 2; ++bj) { f32x4 v0 = acc[ai][bj][m][0], v1 = acc[ai][bj][m][1];
                    if (ACT == 1) {
#pragma unroll
                        for (int j = 0; j < 4; ++j) { float a = fmaxf(v0[j], 0.f), b = fmaxf(v1[j], 0.f); v0[j] = a * a; v1[j] = b * b; } }
                    v0 = v0 * scale; v1 = v1 * scale;
                    u32x4 w; w.x = cvt_pk_bf16(v0[0], v0[1]); w.y = cvt_pk_bf16(v0[2], v0[3]); w.z = cvt_pk_bf16(v1[0], v1[1]); w.w = cvt_pk_bf16(v1[2], v1[3]);
                    *(u32x4*)(rowp + bj * HALF) = w; } }
    }
};

struct SplitKOrder {
    int G, c, pm0, npm, npn, nks, ksub_bytes;
    __device__ bool next(int i, Unit& u) const {
        const int L = i * G + c; if (L >= npm * npn * nks) return false;
        u.ko = (L % nks) * ksub_bytes; const int t = L / nks; u.pn = t % npn; u.pm = pm0 + t / npn; return true;
    }
    __device__ __forceinline__ void a_ready(const Unit&) const {}
    __device__ __forceinline__ void done(const Unit&) const {}
};
struct EpiPart {
    static constexpr bool PERM = true, AFTER_DRAIN = false;
    float* P; int ldc, ksub_bytes, pm0; size_t slice;
    __device__ __forceinline__ void operator()(const f32x4 (&acc)[2][2][4][2], const Unit& u, int wr, int wc, int fr, int fq) const {
        asm volatile("" : "+v"(fr), "+v"(fq));
        float* base = P + (size_t)(u.ko / ksub_bytes) * slice;
        const int row0 = (u.pm - pm0) * BM + wr * 64 + fr, col0 = u.pn * BM + wc * 32 + 8 * fq;
#pragma unroll
        for (int ai = 0; ai < 2; ++ai)
#pragma unroll
            for (int m = 0; m < 4; ++m) { float* rowp = base + (size_t)(row0 + ai * HALF + m * 16) * ldc + col0;
#pragma unroll
                for (int bj = 0; bj < 2; ++bj) { *(f32x4*)(rowp + bj * HALF) = acc[ai][bj][m][0]; *(f32x4*)(rowp + bj * HALF + 4) = acc[ai][bj][m][1]; } }
    }
};
template <class Epi, class Sched, bool ALIGN_EPI = false, bool SP2 = false>
__device__ __forceinline__ void gemm_phase(PG8_LAS unsigned char* lds, const Gemm g, const Sched& S, const Epi& E) {
    int tid_l = threadIdx.x; asm volatile("" : "+v"(tid_l));
    const int tid = tid_l, wid = __builtin_amdgcn_readfirstlane(tid >> 6), lane = tid & 63, wr = wid >> 2, wc = wid & 3, fr = lane & 15, fq = lane >> 4;
    const int K = g.K, LD = g.ld ? g.ld : g.K, nt = K / BK;
    unsigned voffA[2], voffB[2];
#pragma unroll
    for (int i = 0; i < 2; ++i) { int R, C; stage_rc(tid * 16 + i * 8192, R, C); const int Rb = Epi::PERM ? ((R & ~31) + perm32(R & 31)) : R;
        voffA[i] = (unsigned)(R * LD + C) * 2u; voffB[i] = (unsigned)(Rb * LD + C) * 2u; }
    const size_t kstep = (size_t)(BK * 2);
    const size_t hstep = (size_t)HALF * LD * 2;
    const size_t tstep = 2 * hstep;
    const unsigned ldsw = (unsigned)wid * 1024u;
    const int aoff = lds_byte(wr * 64 + fr, fq * 8), boff = lds_byte(wc * 32 + fr, fq * 8);
#define PG8_SA(b, h) (((b) * 2 + (h)) * HTB)
#define PG8_SB(b, h) ((4 + (b) * 2 + (h)) * HTB)
#define PG8_STAGE(bufoff, gbase, voff) do { _Pragma("unroll") for (int _i = 0; _i < 2; ++_i) \
        __builtin_amdgcn_global_load_lds((const unsigned*)((const char*)(gbase) + (voff)[_i]), (PG8_LAS unsigned*)(lds + (bufoff) + ldsw + _i * 8192), 16, 0, 0); } while (0)
#define PG8_LDA(dst, b, h) do { _Pragma("unroll") for (int m = 0; m < 4; ++m) _Pragma("unroll") for (int k = 0; k < 2; ++k) dst[m][k] = *(const PG8_LAS bf16x8*)(lds + PG8_SA(b, h) + aoff + m * 2048 + k * 1024); } while (0)
#define PG8_LDB(dst, b, h) do { _Pragma("unroll") for (int n = 0; n < 2; ++n) _Pragma("unroll") for (int k = 0; k < 2; ++k) dst[n][k] = *(const PG8_LAS bf16x8*)(lds + PG8_SB(b, h) + boff + n * 2048 + k * 1024); } while (0)
#define PG8_MMA(ai, bj, At, Bt) do { __builtin_amdgcn_s_setprio(1); _Pragma("unroll") for (int m = 0; m < 4; ++m) _Pragma("unroll") for (int n = 0; n < 2; ++n) _Pragma("unroll") for (int k = 0; k < 2; ++k) \
        acc[ai][bj][m][n] = __builtin_amdgcn_mfma_f32_16x16x32_bf16(Bt[n][k], At[m][k], acc[ai][bj][m][n], 0, 0, 0); __builtin_amdgcn_s_setprio(0); } while (0)
#define PG8_WAIT_V(n) asm volatile("s_waitcnt vmcnt(" #n ")" ::: "memory")
#define PG8_WAIT_L(n) asm volatile("s_waitcnt lgkmcnt(" #n ")" ::: "memory")
#define PG8_BAR __builtin_amdgcn_s_barrier()
#define PG8_SCHED __builtin_amdgcn_sched_barrier(0)
    Unit cur, nxt; int ui = 0;
    if (!S.next(0, cur)) return;
    f32x4 acc[2][2][4][2];
#pragma unroll
    for (int a = 0; a < 2; ++a)
#pragma unroll
        for (int b = 0; b < 2; ++b)
#pragma unroll
            for (int m = 0; m < 4; ++m)
#pragma unroll
                for (int n = 0; n < 2; ++n) acc[a][b][m][n] = (f32x4){0.f, 0.f, 0.f, 0.f};
    bf16x8 At[4][2], B0[2][2], B1[2][2];
    const char* cA = (const char*)g.A + (size_t)cur.pm * tstep + cur.ko; const char* cB = (const char*)g.Bt + (size_t)cur.pn * tstep + cur.ko;
    S.a_ready(cur);
    if constexpr (SP2) {
        PG8_STAGE(PG8_SB(0, 0), cB, voffB); PG8_STAGE(PG8_SB(0, 1), cB + hstep, voffB); PG8_STAGE(PG8_SA(0, 0), cA, voffA); PG8_STAGE(PG8_SA(0, 1), cA + hstep, voffA);
        if (wr == 1) PG8_BAR;
        PG8_WAIT_V(2); PG8_BAR;
        PG8_STAGE(PG8_SB(1, 0), cB + kstep, voffB); PG8_STAGE(PG8_SA(1, 0), cA + kstep, voffA); PG8_STAGE(PG8_SB(1, 1), cB + hstep + kstep, voffB);
        PG8_WAIT_V(6); PG8_BAR;
    } else {
        PG8_STAGE(PG8_SB(0, 0), cB, voffB); PG8_STAGE(PG8_SA(0, 0), cA, voffA); PG8_STAGE(PG8_SB(0, 1), cB + hstep, voffB); PG8_STAGE(PG8_SA(0, 1), cA + hstep, voffA);
        if (wr == 1) PG8_BAR;
        PG8_WAIT_V(4); PG8_BAR;
        PG8_STAGE(PG8_SB(1, 0), cB + kstep, voffB); PG8_STAGE(PG8_SA(1, 0), cA + kstep, voffA); PG8_STAGE(PG8_SB(1, 1), cB + hstep + kstep, voffB);
        PG8_WAIT_V(6); PG8_BAR;
    }
    for (;;) {
        const bool has_next = S.next(ui + 1, nxt);
        const char* nA = has_next ? (const char*)g.A + (size_t)nxt.pm * tstep + nxt.ko : cA; const char* nB = has_next ? (const char*)g.Bt + (size_t)nxt.pn * tstep + nxt.ko : cB;
        for (int t = 0; t < nt; t += 2) {
            const bool last = (t == nt - 2);
            const char* a1 = cA + (size_t)(t + 1) * kstep;
            const char* a2 = last ? nA : cA + (size_t)(t + 2) * kstep; const char* b2 = last ? nB : cB + (size_t)(t + 2) * kstep;
            const char* a3 = a2 + kstep; const char* b3 = b2 + kstep;
            if (last && has_next) S.a_ready(nxt);
            if constexpr (SP2) {
            PG8_LDB(B0, 0, 0); PG8_LDB(B1, 0, 1); PG8_SCHED; PG8_LDA(At, 0, 0); PG8_STAGE(PG8_SA(1, 1), a1 + hstep, voffA);
            PG8_WAIT_V(8); PG8_WAIT_L(0); PG8_BAR; PG8_MMA(0, 0, At, B0); PG8_MMA(0, 1, At, B1); PG8_BAR; PG8_SCHED;
            PG8_LDA(At, 0, 1); PG8_STAGE(PG8_SB(0, 0), b2, voffB); PG8_STAGE(PG8_SB(0, 1), b2 + hstep, voffB); PG8_STAGE(PG8_SA(0, 0), a2, voffA);
            PG8_WAIT_V(8); PG8_WAIT_L(0); PG8_BAR; PG8_MMA(1, 0, At, B0); PG8_MMA(1, 1, At, B1); PG8_BAR; PG8_SCHED;
            PG8_LDB(B0, 1, 0); PG8_LDB(B1, 1, 1); PG8_SCHED; PG8_LDA(At, 1, 0); PG8_STAGE(PG8_SA(0, 1), a2 + hstep, voffA);
            PG8_WAIT_V(8); PG8_WAIT_L(0); PG8_BAR; PG8_MMA(0, 0, At, B0); PG8_MMA(0, 1, At, B1); PG8_BAR; PG8_SCHED;
            PG8_LDA(At, 1, 1); PG8_STAGE(PG8_SB(1, 0), b3, voffB); PG8_STAGE(PG8_SB(1, 1), b3 + hstep, voffB); PG8_STAGE(PG8_SA(1, 0), a3, voffA);
            PG8_WAIT_V(8); PG8_WAIT_L(0); PG8_BAR; PG8_MMA(1, 0, At, B0); PG8_MMA(1, 1, At, B1); PG8_BAR; PG8_SCHED;
            } else {
            PG8_LDB(B0, 0, 0); PG8_SCHED; PG8_LDA(At, 0, 0); PG8_STAGE(PG8_SA(1, 1), a1 + hstep, voffA);
            PG8_WAIT_L(8); PG8_BAR; PG8_WAIT_L(0); PG8_MMA(0, 0, At, B0); PG8_BAR; PG8_SCHED;
            PG8_LDB(B1, 0, 1); PG8_STAGE(PG8_SB(0, 0), b2, voffB);
            PG8_BAR; PG8_WAIT_L(0); PG8_MMA(0, 1, At, B1); PG8_BAR;
            PG8_LDA(At, 0, 1); PG8_STAGE(PG8_SA(0, 0), a2, voffA);
            PG8_BAR; PG8_WAIT_L(0); PG8_MMA(1, 0, At, B0); PG8_BAR; PG8_SCHED;
            PG8_STAGE(PG8_SB(0, 1), b2 + hstep, voffB);
            PG8_WAIT_V(6); PG8_BAR; PG8_MMA(1, 1, At, B1); PG8_BAR;
            PG8_LDB(B0, 1, 0); PG8_SCHED; PG8_LDA(At, 1, 0); PG8_STAGE(PG8_SA(0, 1), a2 + hstep, voffA);
            PG8_WAIT_L(8); PG8_BAR; PG8_WAIT_L(0); PG8_MMA(0, 0, At, B0); PG8_BAR; PG8_SCHED;
            PG8_LDB(B1, 1, 1); PG8_STAGE(PG8_SB(1, 0), b3, voffB);
            PG8_BAR; PG8_WAIT_L(0); PG8_MMA(0, 1, At, B1); PG8_BAR;
            PG8_LDA(At, 1, 1); PG8_STAGE(PG8_SA(1, 0), a3, voffA);
            PG8_BAR; PG8_WAIT_L(0); PG8_MMA(1, 0, At, B0); PG8_BAR; PG8_SCHED;
            PG8_STAGE(PG8_SB(1, 1), b3 + hstep, voffB);
            PG8_WAIT_V(6); PG8_BAR; PG8_MMA(1, 1, At, B1); PG8_BAR;
            }
        }
        if constexpr (ALIGN_EPI) { if (wr == 0) PG8_BAR; }
        if constexpr (!Epi::AFTER_DRAIN) { E(acc, cur, wr, wc, fr, fq); S.done(cur); }
        if (!has_next) break;
#pragma unroll
        for (int a = 0; a < 2; ++a)
#pragma unroll
            for (int b = 0; b < 2; ++b)
#pragma unroll
                for (int m = 0; m < 4; ++m)
#pragma unroll
                    for (int n = 0; n < 2; ++n) acc[a][b][m][n] = (f32x4){0.f, 0.f, 0.f, 0.f};
        cur = nxt; cA = nA; cB = nB; ++ui;
        if constexpr (ALIGN_EPI) { if (wr == 1) PG8_BAR; }
    }
    PG8_WAIT_V(0);
    if constexpr (!ALIGN_EPI) { if (wr == 0) PG8_BAR; }
    PG8_BAR;
    if constexpr (Epi::AFTER_DRAIN) { E.fused(acc, cur, wr, wc, fr, fq, lds, wid, lane); S.done(cur); }
#undef PG8_SA
#undef PG8_SB
#undef PG8_STAGE
#undef PG8_LDA
#undef PG8_LDB
#undef PG8_MMA
#undef PG8_WAIT_V
#undef PG8_WAIT_L
#undef PG8_BAR
#undef PG8_SCHED
}
}

#define LAS __attribute__((address_space(3)))
typedef unsigned short bf16;
typedef short bf16x8 __attribute__((ext_vector_type(8)));
typedef float f32x4 __attribute__((ext_vector_type(4)));
typedef float f32x16 __attribute__((ext_vector_type(16)));
typedef unsigned v4u __attribute__((ext_vector_type(4)));
typedef unsigned v2u __attribute__((ext_vector_type(2)));
using pg8::cvt_pk_bf16;

constexpr int NB = 8, SEQ = 8192, DM = 1024, CTXL = 256, DFF = 4096, NIN = 1536;
constexpr int ML = NB * SEQ;
constexpr int MT = ML + NB * CTXL;
constexpr float EPSN = 1e-6f;
constexpr float LOG2E = 1.4426950408889634f;
constexpr float QSCALE = 0.125f * 1.4426950408889634f;
constexpr size_t MiB = 1u << 20;
constexpr size_t WS_WIN = 0;
constexpr size_t WS_WOUT = 7 * MiB;
constexpr size_t WS_WFF1 = 11 * MiB;
constexpr size_t WS_WFF2 = 27 * MiB;
constexpr size_t WS_DFT512 = 43 * MiB;
constexpr size_t WS_DFT256 = 45 * MiB;
constexpr size_t WS_TW = 45 * MiB + 256 * 1024;
constexpr size_t WS_ROPEC = WS_TW + 64 * 1024;
constexpr size_t WS_ROPES = WS_ROPEC + 8 * 1024;
constexpr size_t WS_MOD = 46 * MiB;
constexpr size_t WS_HX = 48 * MiB;
constexpr size_t WS_XR = WS_HX + 132 * MiB;
constexpr size_t WS_C = WS_XR + 264 * MiB;
constexpr size_t WS_H1 = WS_C;
constexpr size_t WS_QB = WS_C;
constexpr size_t WS_KB = WS_QB + 66 * MiB;
constexpr size_t WS_VT = WS_KB + 17 * MiB;
constexpr size_t WS_VTC = WS_VT + 16 * MiB;
constexpr size_t WS_UB = WS_VTC + 1 * MiB;
constexpr size_t WS_GVT = WS_UB + 33 * MiB;
constexpr size_t WS_GVTC = WS_GVT + 32 * MiB;
constexpr size_t WS_GT = WS_GVTC + 1 * MiB;
constexpr size_t WS_GTC = WS_GT + 64 * MiB;
constexpr size_t WS_TP = WS_GTC + 2 * MiB;
constexpr size_t WS_MIX = WS_TP + 64 * MiB;
constexpr size_t WS_END = WS_C + 528 * MiB;
static_assert(WS_MIX + 132 * MiB <= WS_END, "overlay region");
constexpr size_t WS_PART = WS_END;
constexpr size_t WS_TOTAL = WS_PART + 32 * MiB;
static_assert(WS_TOTAL <= 1024 * MiB, "workspace");
constexpr int LDS_BYTES = 147456;
constexpr size_t WS_BAR = 46 * MiB + 512 * 1024;
constexpr int LDS_BARST = LDS_BYTES - 64;

__device__ __forceinline__ float bf2f(unsigned short h) { return __builtin_bit_cast(float, (unsigned)h << 16); }
__device__ __forceinline__ float bflo(unsigned w) { return __builtin_bit_cast(float, w << 16); }
__device__ __forceinline__ float bfhi(unsigned w) { return __builtin_bit_cast(float, w & 0xffff0000u); }
__device__ __forceinline__ float wave_sum(float v) {
#pragma unroll
    for (int o = 1; o < 64; o <<= 1) v += __shfl_xor(v, o);
    return v;
}
#define LDS_WAIT() asm volatile("s_waitcnt lgkmcnt(0)" ::: "memory")
__host__ __device__ __forceinline__ int fsig(int p) { return (p & 1) ? ((p == 1) ? 32 : 64 - (p >> 1)) : (p >> 1); }

struct Args { const float* in[19]; float* out; unsigned char* ws; };

struct EpiIn {
    static constexpr bool PERM = true, AFTER_DRAIN = false;
    unsigned char* wsb; int last;
    __device__ __forceinline__ void operator()(const pg8::f32x4 (&acc)[2][2][4][2], const pg8::Unit& u, int wr, int wc, int fr, int fq) const {
        using namespace pg8;
        asm volatile("" : "+v"(fr), "+v"(fq));
        unsigned char* ws = wsb; asm volatile("" : "+s"(ws));
        bf16_t* const QB = (bf16_t*)(ws + WS_QB); bf16_t* const KB = (bf16_t*)(ws + WS_KB); bf16_t* const VT = (bf16_t*)(ws + WS_VT); bf16_t* const VTc = (bf16_t*)(ws + WS_VTC);
        bf16_t* const UB = (bf16_t*)(ws + WS_UB); bf16_t* const GVT = (bf16_t*)(ws + WS_GVT); bf16_t* const GVTc = (bf16_t*)(ws + WS_GVTC); bf16_t* const GT = (bf16_t*)(ws + WS_GT); bf16_t* const GTc = (bf16_t*)(ws + WS_GTC);
        const float* const ropeC = (const float*)(ws + WS_ROPEC); const float* const ropeS = (const float*)(ws + WS_ROPES);
        const int pm = u.pm, pn = u.pn; const bool isctx = pm >= 256;
        if (isctx && last && pn != 2) return;
        const int b = isctx ? pm - 256 : pm >> 5;
        const int sbase = (isctx ? 0 : (pm & 31) * 256) + wr * 64 + fr;
        const size_t grow0 = (size_t)pm * 256 + wr * 64 + fr;
        const int c8 = wc * 32 + 8 * fq;
        if (pn <= 2) {
#pragma unroll
            for (int bj = 0; bj < 2; ++bj) {
                if (pn == 2 && bj == 1) {
                    bf16_t* base = isctx ? VTc + (size_t)b * 128 * 256 : VT + (size_t)b * 128 * 8192; const int ld = isctx ? 256 : 8192;
#pragma unroll
                    for (int ai = 0; ai < 2; ++ai)
#pragma unroll
                        for (int m = 0; m < 4; ++m) { const int s = sbase + ai * HALF + m * 16;
#pragma unroll
                            for (int n = 0; n < 2; ++n)
#pragma unroll
                                for (int j = 0; j < 4; ++j) base[(size_t)(c8 + 4 * n + j) * ld + s] = f2bf1(acc[ai][1][m][n][j]); asm volatile("" ::: "memory"); }
                } else {
                    const int i0 = 8 * (fq & 1); const bool odd = (wc & 1) != 0; const float sgn = (fq < 2) ? -1.f : 1.f;
#pragma unroll
                    for (int ai = 0; ai < 2; ++ai)
#pragma unroll
                        for (int m = 0; m < 4; ++m) { const int s = sbase + ai * HALF + m * 16;
                            f32x4 v0 = acc[ai][bj][m][0], v1 = acc[ai][bj][m][1];
                            if (!isctx) {
                                const int pos = odd ? (s & 63) : (s >> 6);
                                const f32x4 c0 = *(const f32x4*)(ropeC + pos * 16 + i0), c1 = *(const f32x4*)(ropeC + pos * 16 + i0 + 4);
                                const f32x4 s0 = *(const f32x4*)(ropeS + pos * 16 + i0), s1 = *(const f32x4*)(ropeS + pos * 16 + i0 + 4);
#pragma unroll
                                for (int j = 0; j < 4; ++j) { const float p0 = __shfl_xor(v0[j], 32), p1 = __shfl_xor(v1[j], 32);
                                    v0[j] = v0[j] * c0[j] + sgn * p0 * s0[j]; v1[j] = v1[j] * c1[j] + sgn * p1 * s1[j]; }
                            }
                            if (pn < 2) { v0 = v0 * QSCALE; v1 = v1 * QSCALE; }
                            u32x4 w; w.x = cvt_pk_bf16(v0[0], v0[1]); w.y = cvt_pk_bf16(v0[2], v0[3]); w.z = cvt_pk_bf16(v1[0], v1[1]); w.w = cvt_pk_bf16(v1[2], v1[3]);
                            const size_t grow = grow0 + ai * HALF + m * 16;
                            if (pn < 2) *(u32x4*)(QB + grow * 512 + pn * 256 + bj * HALF + c8) = w; else *(u32x4*)(KB + grow * 128 + c8) = w; asm volatile("" ::: "memory"); }
                }
            }
        } else if (pn == 3) {
#pragma unroll
            for (int ai = 0; ai < 2; ++ai)
#pragma unroll
                for (int m = 0; m < 4; ++m) { const size_t grow = grow0 + ai * HALF + m * 16;
#pragma unroll
                    for (int bj = 0; bj < 2; ++bj) { f32x4 v0 = acc[ai][bj][m][0], v1 = acc[ai][bj][m][1];
#pragma unroll
                        for (int j = 0; j < 4; ++j) { v0[j] = gelu_tanh(v0[j]); v1[j] = gelu_tanh(v1[j]); }
                        u32x4 w; w.x = cvt_pk_bf16(v0[0], v0[1]); w.y = cvt_pk_bf16(v0[2], v0[3]); w.z = cvt_pk_bf16(v1[0], v1[1]); w.w = cvt_pk_bf16(v1[2], v1[3]);
                        *(u32x4*)(UB + grow * 256 + bj * HALF + c8) = w; } asm volatile("" ::: "memory"); }
        } else if (pn == 4) {
            bf16_t* base = isctx ? GVTc + (size_t)b * 256 * 256 : GVT + (size_t)b * 256 * 8192; const int ld = isctx ? 256 : 8192;
#pragma unroll
            for (int ai = 0; ai < 2; ++ai)
#pragma unroll
                for (int m = 0; m < 4; ++m) { const int s = sbase + ai * HALF + m * 16;
#pragma unroll
                    for (int bj = 0; bj < 2; ++bj)
#pragma unroll
                        for (int n = 0; n < 2; ++n)
#pragma unroll
                            for (int j = 0; j < 4; ++j) base[(size_t)(bj * HALF + c8 + 4 * n + j) * ld + s] = f2bf1(gelu_tanh(acc[ai][bj][m][n][j])); asm volatile("" ::: "memory"); }
        } else {
            if (!isctx) {
                bf16_t* base = GT + ((size_t)b * 256 * 16 + fr) * 512 + 16 * (pm & 31) + 4 * wr;
#pragma unroll
                for (int bj = 0; bj < 2; ++bj)
#pragma unroll
                    for (int n = 0; n < 2; ++n)
#pragma unroll
                        for (int j = 0; j < 4; ++j) { const int ch = bj * HALF + c8 + 4 * n + j;
#pragma unroll
                            for (int ai = 0; ai < 2; ++ai) { u32x2 w; w.x = cvt_pk_bf16(acc[ai][bj][0][n][j], acc[ai][bj][1][n][j]); w.y = cvt_pk_bf16(acc[ai][bj][2][n][j], acc[ai][bj][3][n][j]);
                                *(u32x2*)(base + (size_t)ch * 8192 + 8 * ai) = w; } asm volatile("" ::: "memory"); }
            } else {
                bf16_t* base = GTc + (size_t)b * 256 * 512;
#pragma unroll
                for (int ai = 0; ai < 2; ++ai)
#pragma unroll
                    for (int m = 0; m < 4; ++m) { const int s = sbase + ai * HALF + m * 16;
#pragma unroll
                        for (int bj = 0; bj < 2; ++bj)
#pragma unroll
                            for (int n = 0; n < 2; ++n)
#pragma unroll
                                for (int j = 0; j < 4; ++j) { const int ch = bj * HALF + c8 + 4 * n + j; const bool ity = (ch & 1) && ((ch & 63) != 1);
                                    base[(size_t)ch * 512 + (ity ? 256 : 0) + s] = f2bf1(acc[ai][bj][m][n][j]); base[(size_t)ch * 512 + (ity ? 0 : 256) + s] = 0; } asm volatile("" ::: "memory"); }
            }
        }
    }
};


template <bool PERMK = false>
__device__ __forceinline__ void p0_transpose_item(const float* W, int K, int N, bf16* WT, int nblk, LAS float* scr, int item, int lane) {
    const int kb = item / nblk, nb = item % nblk, k0 = 64 * kb, n0 = 32 * nb;
    float tv[32];
#pragma unroll
    for (int i = 0; i < 32; ++i) { int kr = k0 + 2 * i + (lane >> 5); if (PERMK && kr >= 768) kr = (kr & ~63) + fsig(kr & 63); tv[i] = W[(size_t)kr * N + n0 + (lane & 31)]; }
#pragma unroll
    for (int i = 0; i < 32; ++i) scr[(2 * i + (lane >> 5)) * 33 + (lane & 31)] = tv[i];
    LDS_WAIT();
    const int c = lane & 7;
#pragma unroll
    for (int j = 0; j < 4; ++j) { const int n = (lane >> 3) + 8 * j; const LAS float* s = scr + (8 * c) * 33 + n;
        v4u o; o.x = cvt_pk_bf16(s[0 * 33], s[1 * 33]); o.y = cvt_pk_bf16(s[2 * 33], s[3 * 33]); o.z = cvt_pk_bf16(s[4 * 33], s[5 * 33]); o.w = cvt_pk_bf16(s[6 * 33], s[7 * 33]);
        *(v4u*)(WT + (size_t)(n0 + n) * K + k0 + 8 * c) = o; }
    LDS_WAIT();
}
__device__ __forceinline__ void p0_fold_item(const float* Win  , bf16* WT  , LAS float* scr, int item, int lane) {
    const int g = item >> 6, k0 = ((item >> 2) & 15) * 64, q0 = (item & 3) * 16;
    LAS float* cs = scr + 64 * 65; LAS float* sn = cs + 64;
    cs[lane] = cospif((float)lane / 32.f); sn[lane] = -sinpif((float)lane / 32.f);
#pragma unroll 1
    for (int i0 = 0; i0 < 64; i0 += 32) { float tv[32];
#pragma unroll
        for (int i = 0; i < 32; ++i) tv[i] = Win[(size_t)(k0 + i0 + i) * 1536 + 1280 + g * 64 + lane];
#pragma unroll
        for (int i = 0; i < 32; ++i) scr[(i0 + i) * 65 + lane] = tv[i]; }
    LDS_WAIT();
    for (int q = q0; q < q0 + 16; ++q) {
        const bool rtype = !(q & 1) || q == 1; const int jm = q == 1 ? 32 : (q >> 1);
        const LAS float* tab = rtype ? cs : sn;
        float ar = 0.f;
#pragma unroll 8
        for (int c = 0; c < 64; ++c) ar += scr[lane * 65 + c] * tab[(jm * c) & 63];
        WT[(size_t)(1280 + g * 64 + q) * 1024 + k0 + lane] = pg8::f2bf1(ar);
    }
    LDS_WAIT();
}
__device__ __forceinline__ void p0_mod_item(LAS unsigned char* lds, int item, const float* w_ada, const float* b_ada, float* MOD, int tid) {
    LAS float* sl = (LAS float*)lds; LAS float* red = sl + 9 * 1024;
    const int wave = tid >> 6, lane = tid & 63;
    const int l = item / 96, n0 = (item % 96) * 64;
    f32x4 acc[9];
#pragma unroll
    for (int r = 0; r < 9; ++r) acc[r] = (f32x4){0.f, 0.f, 0.f, 0.f};
    const int kr = lane >> 4, c4 = lane & 15;
    const float* W = w_ada + (size_t)l * 1024 * 6144 + n0 + c4 * 4;
#pragma unroll 1
    for (int k0 = 0; k0 < 128; k0 += 32) {
        f32x4 wv[8];
#pragma unroll
        for (int i = 0; i < 8; ++i) wv[i] = *(const f32x4*)(W + (size_t)(wave * 128 + k0 + i * 4 + kr) * 6144);
#pragma unroll
        for (int i = 0; i < 8; ++i) { const int k = wave * 128 + k0 + i * 4 + kr;
#pragma unroll
            for (int r = 0; r < 9; ++r) acc[r] = acc[r] + wv[i] * sl[r * 1024 + k]; }
    }
#pragma unroll
    for (int r = 0; r < 9; ++r)
#pragma unroll
        for (int e = 0; e < 4; ++e) { float v = acc[r][e]; v += __shfl_xor(v, 16); v += __shfl_xor(v, 32); acc[r][e] = v; }
    if (kr == 0) {
#pragma unroll
        for (int r = 0; r < 9; ++r)
#pragma unroll
            for (int e = 0; e < 4; ++e) red[(wave * 9 + r) * 64 + c4 * 4 + e] = acc[r][e];
    }
    __syncthreads();
    for (int i = tid; i < 576; i += 512) { const int r = i >> 6, n = i & 63; float s = b_ada[l * 6144 + n0 + n];
#pragma unroll
        for (int w = 0; w < 8; ++w) s += red[(w * 9 + r) * 64 + n];
        MOD[(size_t)(l * 9 + r) * 6144 + n0 + n] = s; }
    __syncthreads();
}
__device__ __forceinline__ void p0_prologue(const Args& a, LAS unsigned char* lds, int bid, int G, int tid) {
    asm volatile("" : "+v"(tid));
    unsigned char* ws = a.ws;
    const int wave = tid >> 6, lane = tid & 63;
    if (bid < 192) {
        LAS float* sl = (LAS float*)lds;
        for (int i = tid; i < 9 * 1024; i += 512) { const int r = i >> 10, k = i & 1023; const float v = r < 8 ? a.in[1][r * 1024 + k] : a.in[3][k]; sl[i] = v / (1.f + __expf(-v)); }
        __syncthreads();
        for (int it = bid; it < 192; it += G) p0_mod_item(lds, it, a.in[4], a.in[5], (float*)(ws + WS_MOD), tid);
    }
    __syncthreads();
    {
        const int gt = bid * 512 + tid, NT = G * 512;
        float* rc = (float*)(ws + WS_ROPEC); float* rs = (float*)(ws + WS_ROPES);
        for (int i = gt; i < 2048; i += NT) { const int pos = i >> 4, f = i & 15; const float invf = exp2f(-(float)f * (13.287712379549449f / 16.f));
            const float ang = (float)pos * invf; float rev = ang * 0.15915494309189535f; rev -= floorf(rev); rc[i] = cospif(2.f * rev); rs[i] = sinpif(2.f * rev); }
        float* tw = (float*)(ws + WS_TW);
        for (int i = gt; i < 8192; i += NT) { tw[2 * i] = cospif((float)i / 4096.f); tw[2 * i + 1] = sinpif((float)i / 4096.f); }
        bf16* d5 = (bf16*)(ws + WS_DFT512);
        for (int i = gt; i < 512 * 512; i += NT) { const int R = i >> 9, s1 = i & 511;
            float v; if (R < 256) v = cospif((float)((R * s1) & 511) / 256.f); else if (R == 256) v = (s1 & 1) ? -1.f : 1.f; else v = -sinpif((float)(((R - 256) * s1) & 511) / 256.f);
            d5[i] = pg8::f2bf1(v); }
        bf16* d2 = (bf16*)(ws + WS_DFT256);
        for (int i = gt; i < 256 * 512; i += NT) { const int k = i >> 9, C = i & 511, pc = C >> 8, s = C & 255; const int m = (k * s) & 255;
            d2[i] = pg8::f2bf1(pc == 0 ? cospif((float)m / 128.f) : sinpif((float)m / 128.f)); }
    }
    LAS float* scr = (LAS float*)(lds + wave * 17408);
    const int gw = bid * 8 + wave, NGW = G * 8;
    constexpr int PER = 640 + 256 + 512 + 2048 + 2048;
    for (int it = gw; it < 2 * PER; it += NGW) {
        const int l = it / PER; int r = it % PER;
        const float* win = a.in[7] + (size_t)l * 1024 * 1536; bf16* wtin = (bf16*)(ws + WS_WIN) + (size_t)l * NIN * 1024;
        if (r < 640) { p0_transpose_item(win, 1024, 1536, wtin, 40, scr, r, lane); continue; } r -= 640;
        if (r < 256) { p0_fold_item(win, wtin, scr, r, lane); continue; } r -= 256;
        if (r < 512) { p0_transpose_item<true>(a.in[13] + (size_t)l * 1024 * 1024, 1024, 1024, (bf16*)(ws + WS_WOUT) + (size_t)l * 1024 * 1024, 32, scr, r, lane); continue; } r -= 512;
        if (r < 2048) { p0_transpose_item(a.in[16] + (size_t)l * 1024 * 4096, 1024, 4096, (bf16*)(ws + WS_WFF1) + (size_t)l * 4096 * 1024, 128, scr, r, lane); continue; } r -= 2048;
        p0_transpose_item(a.in[17] + (size_t)l * 4096 * 1024, 4096, 1024, (bf16*)(ws + WS_WFF2) + (size_t)l * 1024 * 4096, 32, scr, r, lane);
    }
}

template <int NR, int NP = 0>
__device__ __forceinline__ void row_op(const float* xin, const bf16* upd, const float* gate, const float* gupd, float* xout, bf16* hxout,
                                       const float* gn, const float* sc, const float* sh, int lane,
                                       const bf16* upd2 = nullptr, const float* gate2 = nullptr, const float* gupd2 = nullptr) {
    asm volatile("" : "+v"(lane));
    f32x4 x[NR][4];
#pragma unroll
    for (int r = 0; r < NR; ++r)
#pragma unroll
        for (int j = 0; j < 4; ++j) x[r][j] = *(const f32x4*)(xin + (size_t)r * DM + j * 256 + lane * 4);
    if (upd) {
        f32x4 y[NR][4];
#pragma unroll
        for (int r = 0; r < NR; ++r)
#pragma unroll
            for (int j = 0; j < 4; ++j) {
                if (NP == 0) { const v2u w = *(const v2u*)(upd + (size_t)r * DM + j * 256 + lane * 4); y[r][j][0] = bflo(w.x); y[r][j][1] = bfhi(w.x); y[r][j][2] = bflo(w.y); y[r][j][3] = bfhi(w.y); }
                else { const float* pp = (const float*)upd + (size_t)r * DM + j * 256 + lane * 4; f32x4 t = *(const f32x4*)pp;
#pragma unroll
                    for (int p = 1; p < NP; ++p) t = t + *(const f32x4*)(pp + (size_t)p * 2048 * 1024);
                    y[r][j] = t; } }
        float rr[NR];
#pragma unroll
        for (int r = 0; r < NR; ++r) { float ss = 0.f;
#pragma unroll
            for (int j = 0; j < 4; ++j) ss += (y[r][j][0] * y[r][j][0] + y[r][j][1] * y[r][j][1]) + (y[r][j][2] * y[r][j][2] + y[r][j][3] * y[r][j][3]);
            rr[r] = ss; }
#pragma unroll
        for (int r = 0; r < NR; ++r) rr[r] = rsqrtf(wave_sum(rr[r]) * (1.f / 1024.f) + EPSN);
#pragma unroll
        for (int j = 0; j < 4; ++j) { const f32x4 g = *(const f32x4*)(gate + j * 256 + lane * 4) * *(const f32x4*)(gupd + j * 256 + lane * 4);
#pragma unroll
            for (int r = 0; r < NR; ++r) x[r][j] = x[r][j] + g * (y[r][j] * rr[r]); }
    }
    if (upd2) {
        f32x4 y[NR][4];
#pragma unroll
        for (int r = 0; r < NR; ++r)
#pragma unroll
            for (int j = 0; j < 4; ++j) { const v2u w = *(const v2u*)(upd2 + (size_t)r * DM + j * 256 + lane * 4); y[r][j][0] = bflo(w.x); y[r][j][1] = bfhi(w.x); y[r][j][2] = bflo(w.y); y[r][j][3] = bfhi(w.y); }
        float rr[NR];
#pragma unroll
        for (int r = 0; r < NR; ++r) { float ss = 0.f;
#pragma unroll
            for (int j = 0; j < 4; ++j) ss += (y[r][j][0] * y[r][j][0] + y[r][j][1] * y[r][j][1]) + (y[r][j][2] * y[r][j][2] + y[r][j][3] * y[r][j][3]);
            rr[r] = ss; }
#pragma unroll
        for (int r = 0; r < NR; ++r) rr[r] = rsqrtf(wave_sum(rr[r]) * (1.f / 1024.f) + EPSN);
#pragma unroll
        for (int j = 0; j < 4; ++j) { const f32x4 g = *(const f32x4*)(gate2 + j * 256 + lane * 4) * *(const f32x4*)(gupd2 + j * 256 + lane * 4);
#pragma unroll
            for (int r = 0; r < NR; ++r) x[r][j] = x[r][j] + g * (y[r][j] * rr[r]); }
    }
    if (xout) {
#pragma unroll
        for (int r = 0; r < NR; ++r)
#pragma unroll
            for (int j = 0; j < 4; ++j) *(f32x4*)(xout + (size_t)r * DM + j * 256 + lane * 4) = x[r][j];
    }
    if (hxout) {
        float rr[NR];
#pragma unroll
        for (int r = 0; r < NR; ++r) { float ss = 0.f;
#pragma unroll
            for (int j = 0; j < 4; ++j) ss += (x[r][j][0] * x[r][j][0] + x[r][j][1] * x[r][j][1]) + (x[r][j][2] * x[r][j][2] + x[r][j][3] * x[r][j][3]);
            rr[r] = ss; }
#pragma unroll
        for (int r = 0; r < NR; ++r) rr[r] = rsqrtf(wave_sum(rr[r]) * (1.f / 1024.f) + EPSN);
#pragma unroll
        for (int j = 0; j < 4; ++j) { const f32x4 g = *(const f32x4*)(gn + j * 256 + lane * 4) * (*(const f32x4*)(sc + j * 256 + lane * 4) + 1.f), s0 = *(const f32x4*)(sh + j * 256 + lane * 4);
#pragma unroll
            for (int r = 0; r < NR; ++r) { const f32x4 h = (x[r][j] * rr[r]) * g + s0; v2u w; w.x = cvt_pk_bf16(h[0], h[1]); w.y = cvt_pk_bf16(h[2], h[3]); *(v2u*)(hxout + (size_t)r * DM + j * 256 + lane * 4) = w; } }
    }
}
template <int NR>
__device__ __forceinline__ void mixnorm_rows(bf16* mix, const float* gmix, int lane, bf16* outp) {
    asm volatile("" : "+v"(lane));
    v4u w[NR][2];
#pragma unroll
    for (int r = 0; r < NR; ++r) { w[r][0] = *(const v4u*)(mix + (size_t)r * 1024 + lane * 16); w[r][1] = *(const v4u*)(mix + (size_t)r * 1024 + lane * 16 + 8); }
    f32x4 g[4];
#pragma unroll
    for (int q = 0; q < 4; ++q) g[q] = *(const f32x4*)(gmix + lane * 16 + q * 4);
    float rr[NR];
#pragma unroll
    for (int r = 0; r < NR; ++r) { float ss = 0.f;
#pragma unroll
        for (int h = 0; h < 2; ++h)
#pragma unroll
            for (int e = 0; e < 4; ++e) { const float a = bflo(w[r][h][e]), b = bfhi(w[r][h][e]); ss += a * a + b * b; }
        rr[r] = ss; }
#pragma unroll
    for (int r = 0; r < NR; ++r) { float ss = rr[r]; ss += __shfl_xor(ss, 1); ss += __shfl_xor(ss, 2); ss += __shfl_xor(ss, 4); ss += __shfl_xor(ss, 8);
        const float s16 = __shfl_xor(ss, 16); const float tot = lane < 32 ? ss + s16 : ss; const float cnt = lane < 32 ? 512.f : 256.f;
        rr[r] = rsqrtf(tot / cnt + EPSN); }
#pragma unroll
    for (int r = 0; r < NR; ++r) {
#pragma unroll
        for (int h = 0; h < 2; ++h)
#pragma unroll
            for (int e = 0; e < 4; ++e) { const int q = h * 2 + (e >> 1); const float a = bflo(w[r][h][e]) * rr[r] * g[q][(e & 1) * 2], b = bfhi(w[r][h][e]) * rr[r] * g[q][(e & 1) * 2 + 1]; w[r][h][e] = cvt_pk_bf16(a, b); }
        *(v4u*)(outp + (size_t)r * 1024 + lane * 16) = w[r][0]; *(v4u*)(outp + (size_t)r * 1024 + lane * 16 + 8) = w[r][1]; }
}

#define MFMA32(a, b, c) __builtin_amdgcn_mfma_f32_32x32x16_bf16(a, b, c, 0, 0, 0)
constexpr int AT_ST = 136;
constexpr int AT_HALF = 128 * AT_ST * 2;
constexpr int AT_BUF = 2 * AT_HALF;
constexpr int AT_RED = 2 * AT_BUF;
__device__ __forceinline__ void attn_units(LAS unsigned char* lds, const bf16* QB, const bf16* KB, const bf16* VT, const bf16* VTc, bf16* MIX, const float* sink, const float* gmix,
                                           int nunits, int G, int vb, int tid) {
    asm volatile("" : "+v"(tid));
    const int wave = __builtin_amdgcn_readfirstlane(tid >> 6), lane = tid & 63, h = wave >> 2, c = lane & 31, hh = lane >> 5;
    LAS float* red = (LAS float*)(lds + AT_RED);
    for (int L = vb; L < nunits; L += G) {
        const int uidx = (L < 1024 && (G & 7) == 0) ? (L & 7) * 128 + (L >> 3) : L;
        const bool isctx = uidx >= 1024; int b, nb, q0;
        if (!isctx) { b = uidx >> 7; nb = (uidx >> 1) & 63; q0 = nb * 128 + (uidx & 1) * 64; } else { const int v = uidx - 1024; b = v >> 2; nb = 0; q0 = (v & 3) * 64; }
        const size_t qrow0 = (size_t)(isctx ? ML + b * CTXL : b * SEQ) + q0;
        bf16x8 qf[2][4];
#pragma unroll
        for (int qs = 0; qs < 2; ++qs)
#pragma unroll
            for (int ks = 0; ks < 4; ++ks) qf[qs][ks] = *(const bf16x8*)(QB + (qrow0 + qs * 32 + c) * 512 + wave * 64 + ks * 16 + hh * 8);
        float mrun[2], lrun[2]; f32x16 o[2][2];
        const float sk = sink[wave] * LOG2E;
#pragma unroll
        for (int qs = 0; qs < 2; ++qs) { mrun[qs] = sk; lrun[qs] = 1.f;
#pragma unroll
            for (int dt = 0; dt < 2; ++dt)
#pragma unroll
                for (int r = 0; r < 16; ++r) o[qs][dt][r] = 0.f; }
        int s = isctx ? 3 : (nb == 0 ? 1 : 0);
        v4u pk[4], pv[4];
#define AT_ISSUE(ss) do { const bf16* kg; const bf16* vg; int ldv; \
            if ((ss) < 3) { const int kb0 = (nb - 1 + (ss)) * 128; kg = KB + (size_t)(b * SEQ + kb0) * 128; vg = VT + (size_t)(b * 128) * SEQ + kb0; ldv = SEQ; } \
            else { const int kb0 = ((ss) - 3) * 128; kg = KB + (size_t)(ML + b * CTXL + kb0) * 128; vg = VTc + (size_t)(b * 128) * CTXL + kb0; ldv = CTXL; } \
            _Pragma("unroll") for (int e = 0; e < 4; ++e) { const int i = tid + 512 * e, r = i >> 4, ch = i & 15; pk[e] = *(const v4u*)(kg + (size_t)r * 128 + ch * 8); pv[e] = *(const v4u*)(vg + (size_t)r * ldv + ch * 8); } } while (0)
#define AT_WRITE(bufo) do { _Pragma("unroll") for (int e = 0; e < 4; ++e) { const int i = tid + 512 * e, r = i >> 4, ch = i & 15; \
            *(LAS v4u*)(lds + (bufo) + (r * AT_ST + ch * 8) * 2) = pk[e]; *(LAS v4u*)(lds + (bufo) + AT_HALF + (r * AT_ST + ch * 8) * 2) = pv[e]; } } while (0)
        AT_ISSUE(s);
        __syncthreads();
        AT_WRITE(0);
        __syncthreads();
        int cur = 0;
        for (;;) {
            int sn = s + 1; if (sn == 2 && !isctx && nb == 63) sn = 3;
            if (sn <= 4) AT_ISSUE(sn);
            const LAS bf16* Ks = (const LAS bf16*)(lds + cur * AT_BUF); const LAS bf16* Vs = (const LAS bf16*)(lds + cur * AT_BUF + AT_HALF);
            int t_lo = 0, t_hi = 3; const int kb0 = (nb - 1 + s) * 128;
            if (s < 3) { const int a0 = q0 - 128 - kb0, a1 = q0 + 191 - kb0; t_lo = a0 > 0 ? a0 >> 5 : 0; t_hi = (a1 >> 5) < 3 ? (a1 >> 5) : 3; }
#pragma unroll 2
            for (int kt = t_lo; kt <= t_hi; ++kt) {
                bf16x8 kf[4];
#pragma unroll
                for (int ks = 0; ks < 4; ++ks) kf[ks] = *(const LAS bf16x8*)(Ks + (kt * 32 + c) * AT_ST + h * 64 + ks * 16 + hh * 8);
                bf16x8 vf[2][2];
#pragma unroll
                for (int dt = 0; dt < 2; ++dt)
#pragma unroll
                    for (int s2 = 0; s2 < 2; ++s2) { const LAS bf16* p = Vs + (h * 64 + dt * 32 + c) * AT_ST + kt * 32 + s2 * 16 + hh * 4;
                        const v2u lo = *(const LAS v2u*)p, hi = *(const LAS v2u*)(p + 8); v4u t; t.x = lo.x; t.y = lo.y; t.z = hi.x; t.w = hi.y; vf[dt][s2] = __builtin_bit_cast(bf16x8, t); }
                f32x16 st[2];
#pragma unroll
                for (int qs = 0; qs < 2; ++qs) {
                    const float nm = -mrun[qs];
#pragma unroll
                    for (int r = 0; r < 16; ++r) st[qs][r] = nm;
#pragma unroll
                    for (int ks = 0; ks < 4; ++ks) st[qs] = MFMA32(kf[ks], qf[qs][ks], st[qs]);
                }
                bf16x8 pb[2][2];
#pragma unroll
                for (int qs = 0; qs < 2; ++qs) {
                    const int kmin = kb0 + kt * 32, qmin = q0 + qs * 32;
                    if (s < 3 && (kmin - (qmin + 31) > 128 || qmin - (kmin + 31) > 128)) continue;
                    float t[16];
#pragma unroll
                    for (int r = 0; r < 16; ++r) t[r] = st[qs][r];
                    if (s < 3 && (kmin - (qmin + 31) < -128 || kmin + 31 - qmin > 128)) {
                        const int base = kmin + 4 * hh - (qmin + c) + 128;
#pragma unroll
                        for (int r = 0; r < 16; ++r) { if ((unsigned)(base + (r & 3) + 8 * (r >> 2)) > 256u) t[r] = -1e30f; } }
                    float tmax = fmaxf(fmaxf(t[0], t[1]), t[2]);
#pragma unroll
                    for (int r = 3; r < 15; r += 2) tmax = fmaxf(fmaxf(tmax, t[r]), t[r + 1]);
                    tmax = fmaxf(tmax, t[15]);
                    { auto rr = __builtin_amdgcn_permlane32_swap(__float_as_uint(tmax), __float_as_uint(tmax), false, false); tmax = fmaxf(__uint_as_float(rr[0]), __uint_as_float(rr[1])); }
                    if (!__all(tmax <= 8.f)) {
                        const float delta = fmaxf(tmax, 0.f), alpha = __builtin_amdgcn_exp2f(-delta);
                        lrun[qs] *= alpha; mrun[qs] += delta;
#pragma unroll
                        for (int dt = 0; dt < 2; ++dt) o[qs][dt] = o[qs][dt] * alpha;
#pragma unroll
                        for (int r = 0; r < 16; ++r) t[r] -= delta;
                    }
                    float psum = 0.f;
#pragma unroll
                    for (int r = 0; r < 16; ++r) { t[r] = __builtin_amdgcn_exp2f(t[r]); psum += t[r]; }
                    { auto rr = __builtin_amdgcn_permlane32_swap(__float_as_uint(psum), __float_as_uint(psum), false, false); psum = __uint_as_float(rr[0]) + __uint_as_float(rr[1]); }
                    lrun[qs] += psum;
#pragma unroll
                    for (int s2 = 0; s2 < 2; ++s2) { v4u w; w.x = cvt_pk_bf16(t[8 * s2 + 0], t[8 * s2 + 1]); w.y = cvt_pk_bf16(t[8 * s2 + 2], t[8 * s2 + 3]); w.z = cvt_pk_bf16(t[8 * s2 + 4], t[8 * s2 + 5]); w.w = cvt_pk_bf16(t[8 * s2 + 6], t[8 * s2 + 7]);
                        pb[qs][s2] = __builtin_bit_cast(bf16x8, w); }
#pragma unroll
                    for (int s2 = 0; s2 < 2; ++s2)
#pragma unroll
                        for (int dt = 0; dt < 2; ++dt) o[qs][dt] = MFMA32(vf[dt][s2], pb[qs][s2], o[qs][dt]);
                    __builtin_amdgcn_sched_barrier(0);
                }
            }
            if (sn > 4) break;
            AT_WRITE((cur ^ 1) * AT_BUF);
            __syncthreads();
            cur ^= 1; s = sn;
        }
#undef AT_ISSUE
#undef AT_WRITE
        float ssq[2];
#pragma unroll
        for (int qs = 0; qs < 2; ++qs) { const float inv = 1.f / lrun[qs]; float ss = 0.f;
#pragma unroll
            for (int dt = 0; dt < 2; ++dt) { o[qs][dt] = o[qs][dt] * inv;
#pragma unroll
                for (int r = 0; r < 16; ++r) ss += o[qs][dt][r] * o[qs][dt][r]; }
            { auto rr = __builtin_amdgcn_permlane32_swap(__float_as_uint(ss), __float_as_uint(ss), false, false); ss = __uint_as_float(rr[0]) + __uint_as_float(rr[1]); }
            ssq[qs] = ss; if (hh == 0) red[wave * 64 + qs * 32 + c] = ss; }
        __syncthreads();
        LAS bf16* otile = (LAS bf16*)(lds + wave * 9216);
#pragma unroll
        for (int qs = 0; qs < 2; ++qs) { float tot = 0.f;
#pragma unroll
            for (int w = 0; w < 8; ++w) tot += red[w * 64 + qs * 32 + c];
            const float rn = rsqrtf(tot * (1.f / 512.f) + EPSN);
#pragma unroll
            for (int dt = 0; dt < 2; ++dt)
#pragma unroll
                for (int rg = 0; rg < 4; ++rg) { const f32x4 gm = *(const f32x4*)(gmix + wave * 64 + dt * 32 + rg * 8 + hh * 4);
                    v2u w; w.x = cvt_pk_bf16(o[qs][dt][4 * rg] * rn * gm[0], o[qs][dt][4 * rg + 1] * rn * gm[1]); w.y = cvt_pk_bf16(o[qs][dt][4 * rg + 2] * rn * gm[2], o[qs][dt][4 * rg + 3] * rn * gm[3]);
                    *(LAS v2u*)(otile + (qs * 32 + c) * 72 + dt * 32 + rg * 8 + hh * 4) = w; } }
        LDS_WAIT();
#pragma unroll
        for (int it = 0; it < 8; ++it) { const int r = it * 8 + (lane >> 3), ch = lane & 7; const v4u v = *(const LAS v4u*)(otile + r * 72 + ch * 8);
            *(v4u*)(MIX + (qrow0 + r) * 1024 + wave * 64 + ch * 8) = v; }
    }
    __syncthreads();
}

__device__ __forceinline__ void sgu_units(LAS unsigned char* lds, const bf16* UB, const bf16* GVT, const bf16* GVTc, bf16* MIX, const float* wsgu, const float* bsgu, const float* gsgu, const float* gmix,
                                          int nchunks, int G, int bid, int tid) {
    asm volatile("" : "+v"(tid));
    const int wave = __builtin_amdgcn_readfirstlane(tid >> 6), lane = tid & 63, hd = wave >> 1, ph = wave & 1, c = lane & 31, h2 = lane >> 5;
    LAS float* rq = (LAS float*)lds + wave * 128;
    bf16x8 bfr[2][8];
#pragma unroll
    for (int ps = 0; ps < 2; ++ps)
#pragma unroll
        for (int ks = 0; ks < 8; ++ks) { const float* wp = wsgu + ((size_t)(hd * 128 + ph * 64 + ps * 32 + c)) * 128 + ks * 16 + h2 * 8; const f32x4 w0 = *(const f32x4*)wp, w1 = *(const f32x4*)(wp + 4);
            v4u w; w.x = cvt_pk_bf16(w0[0], w0[1]); w.y = cvt_pk_bf16(w0[2], w0[3]); w.z = cvt_pk_bf16(w1[0], w1[1]); w.w = cvt_pk_bf16(w1[2], w1[3]); bfr[ps][ks] = __builtin_bit_cast(bf16x8, w); }
    for (int L = bid; L < nchunks; L += G) {
        const int chunk = (L < 512 && (G & 7) == 0) ? (L & 7) * 64 + (L >> 3) : L;
        const bool isctx = chunk >= 512; const int b = isctx ? (chunk - 512) >> 1 : chunk >> 6, s0 = isctx ? ((chunk - 512) & 1) * 128 : (chunk & 63) * 128;
        const int ld = isctx ? CTXL : SEQ;
        const bf16* Gt = (isctx ? GVTc + ((size_t)(b * 256 + hd * 64)) * CTXL : GVT + ((size_t)(b * 256 + hd * 64)) * SEQ) + s0;
        float sa = 0.f, sb = 0.f;
#pragma unroll 1
        for (int d0 = 0; d0 < 64; d0 += 32) { unsigned gv[32];
#pragma unroll
            for (int d = 0; d < 32; ++d) gv[d] = *(const unsigned*)(Gt + (size_t)(d0 + d) * ld + 2 * lane);
#pragma unroll
            for (int d = 0; d < 32; ++d) { const float x0 = bflo(gv[d]), x1 = bfhi(gv[d]); sa += x0 * x0; sb += x1 * x1; } }
        LDS_WAIT();
        rq[2 * lane] = rsqrtf(sa * (1.f / 64.f) + EPSN); rq[2 * lane + 1] = rsqrtf(sb * (1.f / 64.f) + EPSN);
        LDS_WAIT();
        f32x16 o[2][2];
#pragma unroll
        for (int dt = 0; dt < 2; ++dt)
#pragma unroll
            for (int ps = 0; ps < 2; ++ps)
#pragma unroll
                for (int r = 0; r < 16; ++r) o[dt][ps][r] = 0.f;
        v4u afr[2][8];
#pragma unroll
        for (int ks = 0; ks < 8; ++ks)
#pragma unroll
            for (int dt = 0; dt < 2; ++dt) afr[dt][ks] = *(const v4u*)(Gt + (size_t)(dt * 32 + c) * ld + ks * 16 + h2 * 8);
        LAS bf16* utile = (LAS bf16*)(lds + 8192 + wave * 9216);
        { v4u ut[8];
#pragma unroll
          for (int it = 0; it < 8; ++it) ut[it] = *(const v4u*)(UB + ((size_t)chunk * 128 + ph * 64 + it * 8 + (lane >> 3)) * 256 + hd * 64 + (lane & 7) * 8);
#pragma unroll
          for (int it = 0; it < 8; ++it) *(LAS v4u*)(utile + (it * 8 + (lane >> 3)) * 72 + (lane & 7) * 8) = ut[it]; }
#pragma unroll
        for (int ks = 0; ks < 8; ++ks) {
            const f32x4 r0 = *(const LAS f32x4*)(rq + ks * 16 + h2 * 8), r1 = *(const LAS f32x4*)(rq + ks * 16 + h2 * 8 + 4);
#pragma unroll
            for (int dt = 0; dt < 2; ++dt) { const v4u g = afr[dt][ks]; v4u w;
                w.x = cvt_pk_bf16(bflo(g.x) * r0[0], bfhi(g.x) * r0[1]); w.y = cvt_pk_bf16(bflo(g.y) * r0[2], bfhi(g.y) * r0[3]); w.z = cvt_pk_bf16(bflo(g.z) * r1[0], bfhi(g.z) * r1[1]); w.w = cvt_pk_bf16(bflo(g.w) * r1[2], bfhi(g.w) * r1[3]);
                const bf16x8 af = __builtin_bit_cast(bf16x8, w);
#pragma unroll
                for (int ps = 0; ps < 2; ++ps) o[dt][ps] = MFMA32(af, bfr[ps][ks], o[dt][ps]); }
        }
        LAS float* red2 = (LAS float*)(lds + 4096);
#pragma unroll
        for (int ps = 0; ps < 2; ++ps) { const int p = ph * 64 + ps * 32 + c; const size_t row = (size_t)chunk * 128 + p; const float bs = bsgu[hd * 128 + p]; float ss = 0.f;
#pragma unroll
            for (int dt = 0; dt < 2; ++dt)
#pragma unroll
                for (int rg = 0; rg < 4; ++rg) { const int d0 = dt * 32 + rg * 8 + h2 * 4; const f32x4 gs = *(const f32x4*)(gsgu + hd * 64 + d0);
                    const v2u uw = *(const LAS v2u*)(utile + (ps * 32 + c) * 72 + d0);
                    const float o0 = bflo(uw.x) * (gs[0] * o[dt][ps][4 * rg] + bs), o1 = bfhi(uw.x) * (gs[1] * o[dt][ps][4 * rg + 1] + bs), o2 = bflo(uw.y) * (gs[2] * o[dt][ps][4 * rg + 2] + bs), o3 = bfhi(uw.y) * (gs[3] * o[dt][ps][4 * rg + 3] + bs);
                    o[dt][ps][4 * rg] = o0; o[dt][ps][4 * rg + 1] = o1; o[dt][ps][4 * rg + 2] = o2; o[dt][ps][4 * rg + 3] = o3; ss += (o0 * o0 + o1 * o1) + (o2 * o2 + o3 * o3); }
            { auto rr = __builtin_amdgcn_permlane32_swap(__float_as_uint(ss), __float_as_uint(ss), false, false); ss = __uint_as_float(rr[0]) + __uint_as_float(rr[1]); }
            if (h2 == 0) red2[hd * 128 + p] = ss; }
        __syncthreads();
        LAS bf16* otile = (LAS bf16*)(lds + 8192 + wave * 9216);
#pragma unroll
        for (int ps = 0; ps < 2; ++ps) { const int p = ph * 64 + ps * 32 + c;
            const float rn = rsqrtf((red2[p] + red2[128 + p] + red2[256 + p] + red2[384 + p]) * (1.f / 256.f) + EPSN);
#pragma unroll
            for (int dt = 0; dt < 2; ++dt)
#pragma unroll
                for (int rg = 0; rg < 4; ++rg) { const int d0 = dt * 32 + rg * 8 + h2 * 4; const f32x4 gm = *(const f32x4*)(gmix + 512 + hd * 64 + d0);
                    v2u w; w.x = cvt_pk_bf16(o[dt][ps][4 * rg] * rn * gm[0], o[dt][ps][4 * rg + 1] * rn * gm[1]); w.y = cvt_pk_bf16(o[dt][ps][4 * rg + 2] * rn * gm[2], o[dt][ps][4 * rg + 3] * rn * gm[3]);
                    *(LAS v2u*)(otile + (ps * 32 + c) * 72 + d0) = w; } }
        LDS_WAIT();
#pragma unroll
        for (int it = 0; it < 8; ++it) { const int r = it * 8 + (lane >> 3), ch = lane & 7; const v4u v = *(const LAS v4u*)(otile + r * 72 + ch * 8);
            *(v4u*)(MIX + ((size_t)chunk * 128 + ph * 64 + r) * 1024 + 512 + hd * 64 + ch * 8) = v; }
        LDS_WAIT();
        __syncthreads();
    }
}

__device__ __forceinline__ void fourier_stage2(LAS unsigned char* lds, int wave, const bf16* Tp, bf16* MIX, const float* gmix, int gw, int NGW, int lane) {
    asm volatile("" : "+v"(lane));
    LAS bf16* slab = (LAS bf16*)(lds + wave * 8448);
    const int k2 = lane & 15, kq = lane >> 4, prt = kq >> 1, s2b = (kq & 1) * 8;
    constexpr float NRM = 0.0013810679320049757f;
    for (int item = gw; item < 4096; item += NGW) {
        const int k1 = item >> 3, b = item & 7, k = k1 + 512 * k2;
        const int k1p = k1 <= 256 ? k1 : 512 - k1;
        const float imf = (k1p == 0 || k1p == 256) ? 0.f : (k1 > 256 ? -1.f : 1.f);
        const int trow = prt == 0 ? k1p : ((k1p == 0 || k1p == 256) ? 0 : 256 + k1p);
        unsigned wr_[4], wi_[4];
#pragma unroll
        for (int jj = 0; jj < 4; ++jj) { float c[2], sn[2];
#pragma unroll
            for (int u = 0; u < 2; ++u) { const int n = (k * (s2b + 2 * jj + u)) & 8191; const float rev = (float)n * (1.f / 8192.f); c[u] = __builtin_amdgcn_cosf(rev); sn[u] = __builtin_amdgcn_sinf(rev); }
            wr_[jj] = prt == 0 ? cvt_pk_bf16(c[0], c[1]) : cvt_pk_bf16(imf * sn[0], imf * sn[1]);
            wi_[jj] = prt == 0 ? cvt_pk_bf16(sn[0], sn[1]) : cvt_pk_bf16(-imf * c[0], -imf * c[1]); }
        v4u t0; t0.x = wr_[0]; t0.y = wr_[1]; t0.z = wr_[2]; t0.w = wr_[3]; const bf16x8 bR = __builtin_bit_cast(bf16x8, t0);
        v4u t1; t1.x = wi_[0]; t1.y = wi_[1]; t1.z = wi_[2]; t1.w = wi_[3]; const bf16x8 bI = __builtin_bit_cast(bf16x8, t1);
        const bf16* ap = Tp + (size_t)trow * 32768 + ((size_t)(b * 256 + k2) * 16 + s2b);
        bf16x8 af[16];
#pragma unroll
        for (int t = 0; t < 16; ++t) af[t] = *(const bf16x8*)(ap + t * 256);
        f32x4 y[16]; float ss = 0.f;
#pragma unroll
        for (int t = 0; t < 16; ++t) {
            const f32x4 z4 = {0.f, 0.f, 0.f, 0.f};
            const f32x4 aR = __builtin_amdgcn_mfma_f32_16x16x32_bf16(af[t], bR, z4, 0, 0, 0), aI = __builtin_amdgcn_mfma_f32_16x16x32_bf16(af[t], bI, z4, 0, 0, 0);
            const bool special = ((t & 3) == 0) && kq == 0;
            const float p0 = aR[0] * NRM, p1 = (special ? aR[1] : aI[1]) * NRM, p2 = aR[2] * NRM, p3 = aI[3] * NRM;
            f32x4 o; o[0] = special ? p0 : p0 + p1; o[1] = special ? p1 : p0 - p1; o[2] = p2 + p3; o[3] = p2 - p3;
            y[t] = o; ss += (o[0] * o[0] + o[1] * o[1]) + (o[2] * o[2] + o[3] * o[3]); }
        ss += __shfl_xor(ss, 16); ss += __shfl_xor(ss, 32);
        const float rn = rsqrtf(ss * (1.f / 256.f) + EPSN);
#pragma unroll
        for (int t = 0; t < 16; ++t) { const float* gb = gmix + 768 + (t >> 2) * 64; const int p = 16 * (t & 3) + 4 * kq;
            v2u w; w.x = cvt_pk_bf16(y[t][0] * rn * gb[fsig(p)], y[t][1] * rn * gb[fsig(p + 1)]); w.y = cvt_pk_bf16(y[t][2] * rn * gb[fsig(p + 2)], y[t][3] * rn * gb[fsig(p + 3)]);
            *(LAS v2u*)(slab + k2 * 264 + 16 * t + 4 * kq) = w; }
        LDS_WAIT();
#pragma unroll
        for (int it = 0; it < 8; ++it) { const int r = it * 2 + (lane >> 5), ch = lane & 31; const v4u v = *(const LAS v4u*)(slab + r * 264 + ch * 8);
            *(v4u*)(MIX + ((size_t)b * SEQ + k1 + 512 * r) * 1024 + 768 + ch * 8) = v; }
        LDS_WAIT();
    }
}
__device__ __forceinline__ void ctx_fourier_norm(bf16* MIX, const float* gmix, int gw, int NGW, int lane) {
    asm volatile("" : "+v"(lane));
    const int pg = (lane * 4) & 63, grp = lane >> 4;
    for (int row = ML + gw; row < MT; row += NGW) { bf16* p = MIX + (size_t)row * 1024 + 768 + lane * 4;
        const v2u w = *(const v2u*)p; const float a0 = bflo(w.x), b0 = bfhi(w.x), a1 = bflo(w.y), b1 = bfhi(w.y);
        const bool pass = pg == 0;
        const float v0 = pass ? a0 : a0 + b0, v1 = pass ? b0 : a0 - b0, v2 = a1 + b1, v3 = a1 - b1;
        const float rn = rsqrtf(wave_sum((v0 * v0 + v1 * v1) + (v2 * v2 + v3 * v3)) * (1.f / 256.f) + EPSN);
        const float* gb = gmix + 768 + grp * 64;
        v2u o; o.x = cvt_pk_bf16(v0 * rn * gb[fsig(pg)], v1 * rn * gb[fsig(pg + 1)]); o.y = cvt_pk_bf16(v2 * rn * gb[fsig(pg + 2)], v3 * rn * gb[fsig(pg + 3)]); *(v2u*)p = o; }
}

#define XB_TMO      128
#define XB_XCNT(j)  (256  + 64 * (j))
#define XB_XSUB(j)  (1280 + 64 * (j))
#define XB_XGEN(j)  (2304 + 64 * (j))
#define XB_TOP      3328
#define XB_TOPGEN   3392
#define XCD_BAR_WORDS 3456
#define XB_SPIN_CAP (1u << 18)

__device__ __forceinline__ unsigned xb_ld(unsigned* p)              { return __hip_atomic_load(p, __ATOMIC_RELAXED, __HIP_MEMORY_SCOPE_AGENT); }
__device__ __forceinline__ unsigned xb_add(unsigned* p, unsigned v) { return __hip_atomic_fetch_add(p, v, __ATOMIC_RELAXED, __HIP_MEMORY_SCOPE_AGENT); }
__device__ __forceinline__ unsigned xb_xcc_id() { return (unsigned)__builtin_amdgcn_s_getreg((3 << 11) | 20) & 0xFu; }
#define XB_SPIN(cond, bar) do { unsigned _sp = 0; while (cond) { __builtin_amdgcn_s_sleep(1); \
    if ((++_sp & 255u) == 0u) { if (xb_ld(&(bar)[XB_TMO])) break; if (_sp > XB_SPIN_CAP) { atomicAdd(&(bar)[XB_TMO], 1u); break; } } } } while (0)

struct XcdBarrier {
    unsigned* bar; unsigned x;
    volatile LAS unsigned* st;
};

__device__ __forceinline__ XcdBarrier xcd_barrier_post(unsigned* bar, volatile LAS unsigned* st) {
    XcdBarrier b; b.bar = bar; b.x = xb_xcc_id(); b.st = st;
    if (threadIdx.x == 0) (void)xb_add(&bar[XB_XCNT(b.x)], 1u);
    return b;
}
__device__ __forceinline__ void xcd_barrier_complete(unsigned* bar, unsigned x, unsigned& nloc, unsigned& nx) {
    const unsigned G = gridDim.x * gridDim.y * gridDim.z;
    unsigned sum, cnt, mine, sp = 0u;
    for (;;) {
        sum = 0u; cnt = 0u; mine = 0u;
#pragma unroll
        for (unsigned j = 0; j < 16; ++j) { const unsigned c = xb_ld(&bar[XB_XCNT(j)]); sum += c; cnt += (c > 0u) ? 1u : 0u; mine = (j == x) ? c : mine; }
        if (sum == G) break;
        __builtin_amdgcn_s_sleep(1);
        if ((++sp & 255u) == 0u) { if (xb_ld(&bar[XB_TMO])) break; if (sp > XB_SPIN_CAP) { atomicAdd(&bar[XB_TMO], 1u); break; } }
    }
    nloc = mine > 0u ? mine : 1u; nx = cnt > 0u ? cnt : 1u;
}

__device__ __forceinline__ void xcd_barrier(const XcdBarrier& b) {
    asm volatile("s_waitcnt vmcnt(0)" ::: "memory");
    __syncthreads();
    if (threadIdx.x == 0) {
        unsigned* bar = b.bar;
        __builtin_amdgcn_s_waitcnt(0);
        unsigned nloc = b.st[0], nx = b.st[1];
        if (nloc == 0u) { xcd_barrier_complete(bar, b.x, nloc, nx); b.st[0] = nloc; b.st[1] = nx; }
        const unsigned old = xb_add(&bar[XB_XSUB(b.x)], 1u);
        const unsigned gen = old / nloc;
        if (old + 1u == (gen + 1u) * nloc) {
            __builtin_amdgcn_fence(__ATOMIC_RELEASE, "agent");
            asm volatile("s_waitcnt vmcnt(0)" ::: "memory");
            const unsigned og = xb_add(&bar[XB_TOP], 1u);
            const unsigned tg = og / nx;
            if (og + 1u == (tg + 1u) * nx) xb_add(&bar[XB_TOPGEN], 1u);
            else XB_SPIN(xb_ld(&bar[XB_TOPGEN]) == tg, bar);
            __builtin_amdgcn_fence(__ATOMIC_ACQUIRE, "agent");
            xb_add(&bar[XB_XGEN(b.x)], 1u);
            asm volatile("s_waitcnt vmcnt(0)" ::: "memory");
        } else {
            XB_SPIN(xb_ld(&bar[XB_XGEN(b.x)]) == gen, bar);
            __builtin_amdgcn_fence(__ATOMIC_ACQUIRE, "agent");
            asm volatile("s_waitcnt vmcnt(0)" ::: "memory");
        }
    }
    __syncthreads();
}

__global__ void __launch_bounds__(512, 2) fwd_megakernel(Args a) {
    extern __shared__ __attribute__((aligned(16))) unsigned char lds_raw[];
    LAS unsigned char* lds = (LAS unsigned char*)lds_raw;
    cg::grid_group grid = cg::this_grid();
#define GSYNC() do { XcdBarrier xb_; xb_.bar = (unsigned*)(ws + WS_BAR); xb_.x = xb_xcc_id(); xb_.st = (volatile LAS unsigned*)(lds + LDS_BARST); xcd_barrier(xb_); } while (0)
    const int tid = threadIdx.x, lane = tid & 63, wave = __builtin_amdgcn_readfirstlane(tid >> 6);
    const int bid = blockIdx.x, G = gridDim.x;
    const int gw = bid * 8 + wave, NGW = G * 8;
    unsigned char* ws = a.ws;
    const float* MOD = (const float*)(ws + WS_MOD);
    bf16* HX = (bf16*)(ws + WS_HX); bf16* YB = (bf16*)(ws + WS_XR);
    float* X1C = (float*)(ws + WS_XR + 132 * MiB) - (size_t)ML * DM;
    bf16* MIX = (bf16*)(ws + WS_MIX);
    if (bid == 0) { for (int i = tid; i < XCD_BAR_WORDS; i += 512) __hip_atomic_store((unsigned*)(ws + WS_BAR) + i, 0u, __ATOMIC_RELAXED, __HIP_MEMORY_SCOPE_AGENT); }

#ifndef SKIP_P0
    p0_prologue(a, lds, bid, G, tid);
#endif
    __syncthreads();
    if (tid < 2) ((volatile LAS unsigned*)(lds + LDS_BARST))[tid] = 0u;
    grid.sync();
    (void)xcd_barrier_post((unsigned*)(ws + WS_BAR), (volatile LAS unsigned*)(lds + LDS_BARST));
    __syncthreads();
    for (int row = gw * 4; row < ML; row += NGW * 4) {
        const float* md = MOD + (size_t)(row >> 13) * 6144;
        row_op<4>(a.in[0] + (size_t)row * DM, nullptr, nullptr, nullptr, nullptr, HX + (size_t)row * DM, a.in[6], md + 1024, md, lane);
    }
    for (int row = ML + gw; row < MT; row += NGW) {
        const float* md = MOD + (size_t)8 * 6144;
        row_op<1>(a.in[2] + (size_t)(row - ML) * DM, nullptr, nullptr, nullptr, nullptr, HX + (size_t)row * DM, a.in[6], md + 1024, md, lane);
    }
    GSYNC();
#pragma unroll 1
    for (int l = 0; l < 2; ++l) {
        const bool last = l == 1;
        const int MR = last ? ML : MT;
        const float* modl = MOD + (size_t)l * 9 * 6144;
#ifndef SKIP_G1
        {
            int fM = MT, fN = NIN, fK = DM; asm volatile("" : "+s"(fM), "+s"(fN), "+s"(fK));
            pg8::Gemm g{HX, (const bf16*)(ws + WS_WIN) + (size_t)l * NIN * 1024, fM, fN, fK}; pg8::StaticOrder S; S.init(fM, fN, G, bid);
            EpiIn E{ws, last ? 1 : 0};
            pg8::gemm_phase<EpiIn, pg8::StaticOrder, true, true>(lds, g, S, E);
        }
#endif
        GSYNC();
        const float* gmixl = a.in[12] + l * 1024;
        attn_units(lds, (const bf16*)(ws + WS_QB), (const bf16*)(ws + WS_KB), (const bf16*)(ws + WS_VT), (const bf16*)(ws + WS_VTC), MIX, a.in[8] + l * 8, gmixl, last ? 1024 : 1056, G, bid, tid);
        sgu_units(lds, (const bf16*)(ws + WS_UB), (const bf16*)(ws + WS_GVT), (const bf16*)(ws + WS_GVTC), MIX, a.in[9] + (size_t)l * 4 * 128 * 128, a.in[10] + l * 512, a.in[11] + l * 256, gmixl,
                  last ? 512 : 528, G, (bid + 224) % G, tid);
        __syncthreads();
#ifndef SKIP_F1
        {
            int fM = 512, fN = 32768, fK = 512; asm volatile("" : "+s"(fM), "+s"(fN), "+s"(fK));
            pg8::Gemm g{(const bf16*)(ws + WS_DFT512), (const bf16*)(ws + WS_GT), fM, fN, fK}; pg8::StaticOrder S; S.init(fM, fN, G, bid);
            pg8::EpiPlain<0, false> E{(bf16*)(ws + WS_TP), fN, 1.f};
            pg8::gemm_phase<pg8::EpiPlain<0, false>, pg8::StaticOrder, true, true>(lds, g, S, E);
        }
#endif
#ifndef SKIP_CF
        if (!last) {
            int fM = 256, fN = 2048, fK = 512, fL = 1024; asm volatile("" : "+s"(fM), "+s"(fN), "+s"(fK), "+s"(fL));
            pg8::Gemm g{(const bf16*)(ws + WS_DFT256), (const bf16*)(ws + WS_GTC), fM, fN, fK}; pg8::StaticOrder S; S.init(fM, fN, G, (bid + 208) % G);
            pg8::EpiPlain<0, true> E{MIX + (size_t)ML * 1024 + 768, fL, 0.0078125f};
            pg8::gemm_phase<pg8::EpiPlain<0, true>, pg8::StaticOrder, true, true>(lds, g, S, E);
        }
#endif
        GSYNC();
        fourier_stage2(lds, wave, (const bf16*)(ws + WS_TP), MIX, gmixl, gw, NGW, lane);
        if (!last) ctx_fourier_norm(MIX, gmixl, gw, NGW, lane);
        GSYNC();
#ifndef SKIP_G2
        {
            pg8::Gemm g{MIX, (const bf16*)(ws + WS_WOUT) + (size_t)l * 1024 * 1024, ML, DM, DM, 0}; pg8::StaticOrder S; S.init(ML, DM, G, bid);
            pg8::EpiPlain<0, false> E{YB, DM, 1.f};
            pg8::gemm_phase<pg8::EpiPlain<0, false>, pg8::StaticOrder, true, true>(lds, g, S, E);
        }
        if (!last) {
            int fK = 256, fL = DM; asm volatile("" : "+s"(fK), "+s"(fL));
            pg8::Gemm g{MIX, (const bf16*)(ws + WS_WOUT) + (size_t)l * 1024 * 1024, MT, DM, fK, fL}; pg8::SplitKOrder S{G, bid, 256, 8, 4, 4, fK * 2};
            pg8::EpiPart E{(float*)(ws + WS_PART), fL, fK * 2, 256, (size_t)2048 * 1024};
            pg8::gemm_phase<pg8::EpiPart, pg8::SplitKOrder, true, true>(lds, g, S, E);
        }
#endif
        GSYNC();
        for (int row = gw * 4; row < ML; row += NGW * 4) {
            const float* md = modl + (size_t)(row >> 13) * 6144;
            const float* xin = l == 0 ? a.in[0] + (size_t)row * DM : a.out + (size_t)row * DM;
            row_op<4>(xin, YB + (size_t)row * DM, md + 2048, a.in[14] + l * 1024, nullptr, HX + (size_t)row * DM, a.in[15] + l * 1024, md + 4096, md + 3072, lane);
        }
        if (!last) for (int row = ML + gw * 2; row < MT; row += NGW * 2) {
            const float* md = modl + (size_t)8 * 6144;
            row_op<2, 4>(a.in[2] + (size_t)(row - ML) * DM, (const bf16*)((const float*)(ws + WS_PART) + (size_t)(row - ML) * DM), md + 2048, a.in[14] + l * 1024, X1C + (size_t)row * DM, HX + (size_t)row * DM, a.in[15] + l * 1024, md + 4096, md + 3072, lane);
        }
        GSYNC();
#ifndef SKIP_G3
        {
            pg8::Gemm g{HX, (const bf16*)(ws + WS_WFF1) + (size_t)l * 4096 * 1024, MR, DFF, DM}; pg8::StaticOrder S; S.init(MR, DFF, G, bid);
            pg8::EpiPlain<1, false> E{(bf16*)(ws + WS_H1), DFF, 1.f};
            pg8::gemm_phase<pg8::EpiPlain<1, false>, pg8::StaticOrder, true, true>(lds, g, S, E);
        }
#endif
        GSYNC();
#ifndef SKIP_G4
        {
            pg8::Gemm g{(const bf16*)(ws + WS_H1), (const bf16*)(ws + WS_WFF2) + (size_t)l * 1024 * 4096, ML, DM, DFF, 0}; pg8::StaticOrder S; S.init(ML, DM, G, bid);
            pg8::EpiPlain<0, false> E{HX, DM, 1.f};
            pg8::gemm_phase<pg8::EpiPlain<0, false>, pg8::StaticOrder, true, true>(lds, g, S, E);
        }
        if (!last) {
            int fK = 1024, fL = DFF, fC = DM; asm volatile("" : "+s"(fK), "+s"(fL), "+s"(fC));
            pg8::Gemm g{(const bf16*)(ws + WS_H1), (const bf16*)(ws + WS_WFF2) + (size_t)l * 1024 * 4096, MT, DM, fK, fL}; pg8::SplitKOrder S{G, bid, 256, 8, 4, 4, fK * 2};
            pg8::EpiPart E{(float*)(ws + WS_PART), fC, fK * 2, 256, (size_t)2048 * 1024};
            pg8::gemm_phase<pg8::EpiPart, pg8::SplitKOrder, true, true>(lds, g, S, E);
        }
#endif
        GSYNC();
        for (int row = gw * 4; row < ML; row += NGW * 4) {
            const int mr = row >> 13; const float* md = modl + (size_t)mr * 6144;
            const float* xin = l == 0 ? a.in[0] + (size_t)row * DM : a.out + (size_t)row * DM;
            if (!last) { const float* mdn = MOD + (size_t)(9 + mr) * 6144;
                row_op<4>(xin, YB + (size_t)row * DM, md + 2048, a.in[14] + l * 1024, a.out + (size_t)row * DM, HX + (size_t)row * DM, a.in[6] + 1024, mdn + 1024, mdn, lane,
                          HX + (size_t)row * DM, md + 5120, a.in[18] + l * 1024);
            } else row_op<4>(xin, YB + (size_t)row * DM, md + 2048, a.in[14] + l * 1024, a.out + (size_t)row * DM, nullptr, nullptr, nullptr, nullptr, lane,
                             HX + (size_t)row * DM, md + 5120, a.in[18] + l * 1024);
        }
        if (!last) for (int row = ML + gw * 2; row < MT; row += NGW * 2) {
            const float* md = modl + (size_t)8 * 6144; const float* mdn = MOD + (size_t)(9 + 8) * 6144;
            row_op<2, 4>(X1C + (size_t)row * DM, (const bf16*)((const float*)(ws + WS_PART) + (size_t)(row - ML) * DM), md + 5120, a.in[18] + l * 1024, nullptr, HX + (size_t)row * DM, a.in[6] + 1024, mdn + 1024, mdn, lane);
        }
        if (!last) GSYNC();
    }
}

extern "C" void kernel_launch(void* const* d_in, const int* in_sizes, int n_in, void* d_out, int out_size, void* d_ws, size_t ws_size, hipStream_t stream) {
    static int grid = 0;
    if (grid == 0) {
        if (n_in != 19 || ws_size < WS_TOTAL) { fprintf(stderr, "kernel_launch: unexpected n_in %d / ws %zu\n", n_in, ws_size); grid = -1; return; }
        int dev = 0, cus = 0, per_cu = 0;
        hipGetDevice(&dev);
        hipDeviceGetAttribute(&cus, hipDeviceAttributeMultiprocessorCount, dev);
        hipFuncSetAttribute((const void*)fwd_megakernel, hipFuncAttributeMaxDynamicSharedMemorySize, LDS_BYTES);
        hipOccupancyMaxActiveBlocksPerMultiprocessor(&per_cu, (const void*)fwd_megakernel, 512, LDS_BYTES);
        if (per_cu < 1) per_cu = 1;
        grid = cus * per_cu;
        (void)hipGetLastError();
    }
    if (grid < 0) return;
    Args a{};
    for (int i = 0; i < 19; ++i) a.in[i] = (const float*)d_in[i];
    a.out = (float*)d_out; a.ws = (unsigned char*)d_ws;
    void* args[] = {&a};
    hipError_t e = hipLaunchCooperativeKernel((const void*)fwd_megakernel, dim3(grid), dim3(512), args, LDS_BYTES, stream);
    if (e != hipSuccess) fprintf(stderr, "cooperative launch failed: %s (grid %d)\n", hipGetErrorString(e), grid);
}
```

```cpp
#include <hip/hip_runtime.h>
#include <hip/hip_cooperative_groups.h>
#include <cstdio>
#include <cstdint>
namespace cg = cooperative_groups;
namespace pg8 {
#define PG8_LAS __attribute__((address_space(3)))
typedef unsigned short bf16_t;
typedef short bf16x8 __attribute__((ext_vector_type(8)));
typedef float f32x4 __attribute__((ext_vector_type(4)));
typedef unsigned u32x4 __attribute__((ext_vector_type(4)));
constexpr int BM = 256, BK = 64, HALF = 128, HTB = HALF * BK * 2  , STAGE_BYTES = 8 * HTB, NXCD = 8, WGM = 8;

__host__ __device__ __forceinline__ int lds_byte(int r, int c) { const int st = (r >> 4) * 2 + (c >> 5), rr = r & 15, cc = c & 31, ob = rr * 64 + cc * 2; return st * 1024 + (ob ^ (((ob >> 9) & 1) << 5)); }
__host__ __device__ __forceinline__ void stage_rc(int b, int& R, int& C) { const int st = b / 1024, sb = b % 1024, swz = sb ^ (((sb >> 9) & 1) << 5); R = (st >> 1) * 16 + swz / 64; C = (st & 1) * 32 + (swz % 64) / 2; }
__host__ __device__ __forceinline__ int perm32(int rho) { const int n = rho >> 4, i = rho & 15; return 8 * (i >> 2) + 4 * n + (i & 3); }

struct Unit { int pm, pn, ko; };
struct Gemm { const bf16_t* A; const bf16_t* Bt; int M, N, K, ld; };

struct StaticOrder {
    int nM, nN, nwg, G, c;
    __host__ __device__ void init(int M, int N, int G_, int c_) { nM = M / BM; nN = N / BM; nwg = nM * nN; G = G_; c = c_; }
    __host__ __device__ bool next(int i, Unit& u) const {
        const long L = (long)i * G + c; if (L >= nwg) return false;
        int wgid = (int)L; { const int q = nwg / NXCD, r = nwg % NXCD, xcd = wgid % NXCD, off = wgid / NXCD; wgid = (xcd < r ? xcd * (q + 1) : r * (q + 1) + (xcd - r) * q) + off; }
        const int nig = WGM * nN, gid = wgid / nig, fm = gid * WGM, gsz = (nM - fm) < WGM ? (nM - fm) : WGM;
        u.pm = fm + ((wgid % nig) % gsz); u.pn = (wgid % nig) / gsz; u.ko = 0; return true;
    }
    __device__ __forceinline__ void a_ready(const Unit&) const {}
    __device__ __forceinline__ void done(const Unit&) const {}
};

__device__ __forceinline__ unsigned cvt_pk_bf16(float lo, float hi) { unsigned r; asm volatile("v_cvt_pk_bf16_f32 %0, %1, %2" : "=v"(r) : "v"(lo), "v"(hi)); return r; }
typedef float f32x2 __attribute__((ext_vector_type(2)));
typedef unsigned u32x2 __attribute__((ext_vector_type(2)));
__device__ __forceinline__ unsigned short f2bf1(float f) { return (unsigned short)(cvt_pk_bf16(f, 0.f) & 0xffffu); }
__device__ __forceinline__ float gelu_tanh(float x) {
    const float u = 0.7978845608f * (x + 0.044715f * x * x * x);
    return x * __builtin_amdgcn_rcpf(1.0f + __builtin_amdgcn_exp2f(-2.885390082f * u));
}
template <int ACT, bool REMAP> struct EpiPlain {
    static constexpr bool PERM = true, AFTER_DRAIN = false;
    bf16_t* O; int ldc; float scale;
    __device__ __forceinline__ void operator()(const f32x4 (&acc)[2][2][4][2], const Unit& u, int wr, int wc, int fr, int fq) const {
        asm volatile("" : "+v"(fr), "+v"(fq));
        const int row0 = (REMAP ? u.pn * BM : u.pm * BM) + wr * 64 + fr; const int col0 = (REMAP ? 0 : u.pn * BM) + wc * 32 + 8 * fq;
#pragma unroll
        for (int ai = 0; ai < 2; ++ai)
#pragma unroll
            for (int m = 0; m < 4; ++m) { bf16_t* rowp = O + (size_t)(row0 + ai * HALF + m * 16) * ldc + col0;
#pragma unroll
                for (int bj = 0; bj < 2; ++bj) { f32x4 v0 = acc[ai][bj][m][0], v1 = acc[ai][bj][m][1];
                    if (ACT == 1) {
#pragma unroll
                        for (int j = 0; j < 4; ++j) { float a = fmaxf(v0[j], 0.f), b = fmaxf(v1[j], 0.f); v0[j] = a * a; v1[j] = b * b; } }
                    v0 = v0 * scale; v1 = v1 * scale;
                    u32x4 w; w.x = cvt_pk_bf16(v0[0], v0[1]); w.y = cvt_pk_bf16(v0[2], v0[3]); w.z = cvt_pk_bf16(v1[0], v1[1]); w.w = cvt_pk_bf16(v1[2], v1[3]);
                    *(u32x4*)(rowp + bj * HALF) = w; } }
    }
};

struct SplitKOrder {
    int G, c, pm0, npm, npn, nks, ksub_bytes;
    __device__ bool next(int i, Unit& u) const {
        const int L = i * G + c; if (L >= npm * npn * nks) return false;
        u.ko = (L % nks) * ksub_bytes; const int t = L / nks; u.pn = t % npn; u.pm = pm0 + t / npn; return true;
    }
    __device__ __forceinline__ void a_ready(const Unit&) const {}
    __device__ __forceinline__ void done(const Unit&) const {}
};
struct EpiPart {
    static constexpr bool PERM = true, AFTER_DRAIN = false;
    float* P; int ldc, ksub_bytes, pm0; size_t slice;
    __device__ __forceinline__ void operator()(const f32x4 (&acc)[2][2][4][2], const Unit& u, int wr, int wc, int fr, int fq) const {
        asm volatile("" : "+v"(fr), "+v"(fq));
        float* base = P + (size_t)(u.ko / ksub_bytes) * slice;
        const int row0 = (u.pm - pm0) * BM + wr * 64 + fr, col0 = u.pn * BM + wc * 32 + 8 * fq;
#pragma unroll
        for (int ai = 0; ai < 2; ++ai)
#pragma unroll
            for (int m = 0; m < 4; ++m) { float* rowp = base + (size_t)(row0 + ai * HALF + m * 16) * ldc + col0;
#pragma unroll
                for (int bj = 0; bj < 2; ++bj) { *(f32x4*)(rowp + bj * HALF) = acc[ai][bj][m][0]; *(f32x4*)(rowp + bj * HALF + 4) = acc[ai][bj][m][1]; } }
    }
};
template <class Epi, class Sched, bool ALIGN_EPI = false, bool SP2 = false>
__device__ __forceinline__ void gemm_phase(PG8_LAS unsigned char* lds, const Gemm g, const Sched& S, const Epi& E) {
    int tid_l = threadIdx.x; asm volatile("" : "+v"(tid_l));
    const int tid = tid_l, wid = __builtin_amdgcn_readfirstlane(tid >> 6), lane = tid & 63, wr = wid >> 2, wc = wid & 3, fr = lane & 15, fq = lane >> 4;
    const int K = g.K, LD = g.ld ? g.ld : g.K, nt = K / BK;
    unsigned voffA[2], voffB[2];
#pragma unroll
    for (int i = 0; i < 2; ++i) { int R, C; stage_rc(tid * 16 + i * 8192, R, C); const int Rb = Epi::PERM ? ((R & ~31) + perm32(R & 31)) : R;
        voffA[i] = (unsigned)(R * LD + C) * 2u; voffB[i] = (unsigned)(Rb * LD + C) * 2u; }
    const size_t kstep = (size_t)(BK * 2);
    const size_t hstep = (size_t)HALF * LD * 2;
    const size_t tstep = 2 * hstep;
    const unsigned ldsw = (unsigned)wid * 1024u;
    const int aoff = lds_byte(wr * 64 + fr, fq * 8), boff = lds_byte(wc * 32 + fr, fq * 8);
#define PG8_SA(b, h) (((b) * 2 + (h)) * HTB)
#define PG8_SB(b, h) ((4 + (b) * 2 + (h)) * HTB)
#define PG8_STAGE(bufoff, gbase, voff) do { _Pragma("unroll") for (int _i = 0; _i < 2; ++_i) \
        __builtin_amdgcn_global_load_lds((const unsigned*)((const char*)(gbase) + (voff)[_i]), (PG8_LAS unsigned*)(lds + (bufoff) + ldsw + _i * 8192), 16, 0, 0); } while (0)
#define PG8_LDA(dst, b, h) do { _Pragma("unroll") for (int m = 0; m < 4; ++m) _Pragma("unroll") for (int k = 0; k < 2; ++k) dst[m][k] = *(const PG8_LAS bf16x8*)(lds + PG8_SA(b, h) + aoff + m * 2048 + k * 1024); } while (0)
#define PG8_LDB(dst, b, h) do { _Pragma("unroll") for (int n = 0; n < 2; ++n) _Pragma("unroll") for (int k = 0; k < 2; ++k) dst[n][k] = *(const PG8_LAS bf16x8*)(lds + PG8_SB(b, h) + boff + n * 2048 + k * 1024); } while (0)
#define PG8_MMA(ai, bj, At, Bt) do { __builtin_amdgcn_s_setprio(1); _Pragma("unroll") for (int m = 0; m < 4; ++m) _Pragma("unroll") for (int n = 0; n < 2; ++n) _Pragma("unroll") for (int k = 0; k < 2; ++k) \
        acc[ai][bj][m][n] = __builtin_amdgcn_mfma_f32_16x16x32_bf16(Bt[n][k], At[m][k], acc[ai][bj][m][n], 0, 0, 0); __builtin_amdgcn_s_setprio(0); } while (0)
#define PG8_WAIT_V(n) asm volatile("s_waitcnt vmcnt(" #n ")" ::: "memory")
#define PG8_WAIT_L(n) asm volatile("s_waitcnt lgkmcnt(" #n ")" ::: "memory")
#define PG8_BAR __builtin_amdgcn_s_barrier()
#define PG8_SCHED __builtin_amdgcn_sched_barrier(0)
    Unit cur, nxt; int ui = 0;
    if (!S.next(0, cur)) return;
    f32x4 acc[2][2][4][2];
#pragma unroll
    for (int a = 0; a < 2; ++a)
#pragma unroll
        for (int b = 0; b < 2; ++b)
#pragma unroll
            for (int m = 0; m < 4; ++m)
#pragma unroll
                for (int n = 0; n < 2; ++n) acc[a][b][m][n] = (f32x4){0.f, 0.f, 0.f, 0.f};
    bf16x8 At[4][2], B0[2][2], B1[2][2];
    const char* cA = (const char*)g.A + (size_t)cur.pm * tstep + cur.ko; const char* cB = (const char*)g.Bt + (size_t)cur.pn * tstep + cur.ko;
    S.a_ready(cur);
    if constexpr (SP2) {
        PG8_STAGE(PG8_SB(0, 0), cB, voffB); PG8_STAGE(PG8_SB(0, 1), cB + hstep, voffB); PG8_STAGE(PG8_SA(0, 0), cA, voffA); PG8_STAGE(PG8_SA(0, 1), cA + hstep, voffA);
        if (wr == 1) PG8_BAR;
        PG8_WAIT_V(2); PG8_BAR;
        PG8_STAGE(PG8_SB(1, 0), cB + kstep, voffB); PG8_STAGE(PG8_SA(1, 0), cA + kstep, voffA); PG8_STAGE(PG8_SB(1, 1), cB + hstep + kstep, voffB);
        PG8_WAIT_V(6); PG8_BAR;
    } else {
        PG8_STAGE(PG8_SB(0, 0), cB, voffB); PG8_STAGE(PG8_SA(0, 0), cA, voffA); PG8_STAGE(PG8_SB(0, 1), cB + hstep, voffB); PG8_STAGE(PG8_SA(0, 1), cA + hstep, voffA);
        if (wr == 1) PG8_BAR;
        PG8_WAIT_V(4); PG8_BAR;
        PG8_STAGE(PG8_SB(1, 0), cB + kstep, voffB); PG8_STAGE(PG8_SA(1, 0), cA + kstep, voffA); PG8_STAGE(PG8_SB(1, 1), cB + hstep + kstep, voffB);
        PG8_WAIT_V(6); PG8_BAR;
    }
    for (;;) {
        const bool has_next = S.next(ui + 1, nxt);
        const char* nA = has_next ? (const char*)g.A + (size_t)nxt.pm * tstep + nxt.ko : cA; const char* nB = has_next ? (const char*)g.Bt + (size_t)nxt.pn * tstep + nxt.ko : cB;
        for (int t = 0; t < nt; t += 2) {
            const bool last = (t == nt - 2);
            const char* a1 = cA + (size_t)(t + 1) * kstep;
            const char* a2 = last ? nA : cA + (size_t)(t + 2) * kstep; const char* b2 = last ? nB : cB + (size_t)(t + 2) * kstep;
            const char* a3 = a2 + kstep; const char* b3 = b2 + kstep;
            if (last && has_next) S.a_ready(nxt);
            if constexpr (SP2) {
            PG8_LDB(B0, 0, 0); PG8_LDB(B1, 0, 1); PG8_SCHED; PG8_LDA(At, 0, 0); PG8_STAGE(PG8_SA(1, 1), a1 + hstep, voffA);
            PG8_WAIT_V(8); PG8_WAIT_L(0); PG8_BAR; PG8_MMA(0, 0, At, B0); PG8_MMA(0, 1, At, B1); PG8_BAR; PG8_SCHED;
            PG8_LDA(At, 0, 1); PG8_STAGE(PG8_SB(0, 0), b2, voffB); PG8_STAGE(PG8_SB(0, 1), b2 + hstep, voffB); PG8_STAGE(PG8_SA(0, 0), a2, voffA);
            PG8_WAIT_V(8); PG8_WAIT_L(0); PG8_BAR; PG8_MMA(1, 0, At, B0); PG8_MMA(1, 1, At, B1); PG8_BAR; PG8_SCHED;
            PG8_LDB(B0, 1, 0); PG8_LDB(B1, 1, 1); PG8_SCHED; PG8_LDA(At, 1, 0); PG8_STAGE(PG8_SA(0, 1), a2 + hstep, voffA);
            PG8_WAIT_V(8); PG8_WAIT_L(0); PG8_BAR; PG8_MMA(0, 0, At, B0); PG8_MMA(0, 1, At, B1); PG8_BAR; PG8_SCHED;
            PG8_LDA(At, 1, 1); PG8_STAGE(PG8_SB(1, 0), b3, voffB); PG8_STAGE(PG8_SB(1, 1), b3 + hstep, voffB); PG8_STAGE(PG8_SA(1, 0), a3, voffA);
            PG8_WAIT_V(8); PG8_WAIT_L(0); PG8_BAR; PG8_MMA(1, 0, At, B0); PG8_MMA(1, 1, At, B1); PG8_BAR; PG8_SCHED;
            } else {
            PG8_LDB(B0, 0, 0); PG8_SCHED; PG8_LDA(At, 0, 0); PG8_STAGE(PG8_SA(1, 1), a1 + hstep, voffA);
            PG8_WAIT_L(8); PG8_BAR; PG8_WAIT_L(0); PG8_MMA(0, 0, At, B0); PG8_BAR; PG8_SCHED;
            PG8_LDB(B1, 0, 1); PG8_STAGE(PG8_SB(0, 0), b2, voffB);
            PG8_BAR; PG8_WAIT_L(0); PG8_MMA(0, 1, At, B1); PG8_BAR;
            PG8_LDA(At, 0, 1); PG8_STAGE(PG8_SA(0, 0), a2, voffA);
            PG8_BAR; PG8_WAIT_L(0); PG8_MMA(1, 0, At, B0); PG8_BAR; PG8_SCHED;
            PG8_STAGE(PG8_SB(0, 1), b2 + hstep, voffB);
            PG8_WAIT_V(6); PG8_BAR; PG8_MMA(1, 1, At, B1); PG8_BAR;
            PG8_LDB(B0, 1, 0); PG8_SCHED; PG8_LDA(At, 1, 0); PG8_STAGE(PG8_SA(0, 1), a2 + hstep, voffA);
            PG8_WAIT_L(8); PG8_BAR; PG8_WAIT_L(0); PG8_MMA(0, 0, At, B0); PG8_BAR; PG8_SCHED;
            PG8_LDB(B1, 1, 1); PG8_STAGE(PG8_SB(1, 0), b3, voffB);
            PG8_BAR; PG8_WAIT_L(0); PG8_MMA(0, 1, At, B1); PG8_BAR;
            PG8_LDA(At, 1, 1); PG8_STAGE(PG8_SA(1, 0), a3, voffA);
            PG8_BAR; PG8_WAIT_L(0); PG8_MMA(1, 0, At, B0); PG8_BAR; PG8_SCHED;
            PG8_STAGE(PG8_SB(1, 1), b3 + hstep, voffB);
            PG8_WAIT_V(6); PG8_BAR; PG8_MMA(1, 1, At, B1); PG8_BAR;
            }
        }
        if constexpr (ALIGN_EPI) { if (wr == 0) PG8_BAR; }
        if constexpr (!Epi::AFTER_DRAIN) { E(acc, cur, wr, wc, fr, fq); S.done(cur); }
        if (!has_next) break;
#pragma unroll
        for (int a = 0; a < 2; ++a)
#pragma unroll
            for (int b = 0; b < 2; ++b)
#pragma unroll
                for (int m = 0; m < 4; ++m)
#pragma unroll
                    for (int n = 0; n < 2; ++n) acc[a][b][m][n] = (f32x4){0.f, 0.f, 0.f, 0.f};
        cur = nxt; cA = nA; cB = nB; ++ui;
        if constexpr (ALIGN_EPI) { if (wr == 1) PG8_BAR; }
    }
    PG8_WAIT_V(0);
    if constexpr (!ALIGN_EPI) { if (wr == 0) PG8_BAR; }
    PG8_BAR;
    if constexpr (Epi::AFTER_DRAIN) { E.fused(acc, cur, wr, wc, fr, fq, lds, wid, lane); S.done(cur); }
#undef PG8_SA
#undef PG8_SB
#undef PG8_STAGE
#undef PG8_LDA
#undef PG8_LDB
#undef PG8_MMA
#undef PG8_WAIT_V
#undef PG8_WAIT_L
#undef PG8_BAR
#undef PG8_SCHED
}
}

#define LAS __attribute__((address_space(3)))
typedef unsigned short bf16;
typedef short bf16x8 __attribute__((ext_vector_type(8)));
typedef float f32x4 __attribute__((ext_vector_type(4)));
typedef float f32x16 __attribute__((ext_vector_type(16)));
typedef unsigned v4u __attribute__((ext_vector_type(4)));
typedef unsigned v2u __attribute__((ext_vector_type(2)));
using pg8::cvt_pk_bf16;

constexpr int NB = 8, SEQ = 8192, DM = 1024, CTXL = 256, DFF = 4096, NIN = 1536;
constexpr int ML = NB * SEQ;
constexpr int MT = ML + NB * CTXL;
constexpr float EPSN = 1e-6f;
constexpr float LOG2E = 1.4426950408889634f;
constexpr float QSCALE = 0.125f * 1.4426950408889634f;
constexpr size_t MiB = 1u << 20;
constexpr size_t WS_WIN = 0;
constexpr size_t WS_WOUT = 7 * MiB;
constexpr size_t WS_WFF1 = 11 * MiB;
constexpr size_t WS_WFF2 = 27 * MiB;
constexpr size_t WS_DFT512 = 43 * MiB;
constexpr size_t WS_DFT256 = 45 * MiB;
constexpr size_t WS_TW = 45 * MiB + 256 * 1024;
constexpr size_t WS_ROPEC = WS_TW + 64 * 1024;
constexpr size_t WS_ROPES = WS_ROPEC + 8 * 1024;
constexpr size_t WS_MOD = 46 * MiB;
constexpr size_t WS_HX = 48 * MiB;
constexpr size_t WS_XR = WS_HX + 132 * MiB;
constexpr size_t WS_C = WS_XR + 264 * MiB;
constexpr size_t WS_H1 = WS_C;
constexpr size_t WS_QB = WS_C;
constexpr size_t WS_KB = WS_QB + 66 * MiB;
constexpr size_t WS_VT = WS_KB + 17 * MiB;
constexpr size_t WS_VTC = WS_VT + 16 * MiB;
constexpr size_t WS_UB = WS_VTC + 1 * MiB;
constexpr size_t WS_GVT = WS_UB + 33 * MiB;
constexpr size_t WS_GVTC = WS_GVT + 32 * MiB;
constexpr size_t WS_GT = WS_GVTC + 1 * MiB;
constexpr size_t WS_GTC = WS_GT + 64 * MiB;
constexpr size_t WS_TP = WS_GTC + 2 * MiB;
constexpr size_t WS_MIX = WS_TP + 64 * MiB;
constexpr size_t WS_END = WS_C + 528 * MiB;
static_assert(WS_MIX + 132 * MiB <= WS_END, "overlay region");
constexpr size_t WS_PART = WS_END;
constexpr size_t WS_TOTAL = WS_PART + 32 * MiB;
static_assert(WS_TOTAL <= 1024 * MiB, "workspace");
constexpr int LDS_BYTES = 147456;
constexpr size_t WS_BAR = 46 * MiB + 512 * 1024;
constexpr int LDS_BARST = LDS_BYTES - 64;

__device__ __forceinline__ float bf2f(unsigned short h) { return __builtin_bit_cast(float, (unsigned)h << 16); }
__device__ __forceinline__ float bflo(unsigned w) { return __builtin_bit_cast(float, w << 16); }
__device__ __forceinline__ float bfhi(unsigned w) { return __builtin_bit_cast(float, w & 0xffff0000u); }
__device__ __forceinline__ float wave_sum(float v) {
#pragma unroll
    for (int o = 1; o < 64; o <<= 1) v += __shfl_xor(v, o);
    return v;
}
#define LDS_WAIT() asm volatile("s_waitcnt lgkmcnt(0)" ::: "memory")
__host__ __device__ __forceinline__ int fsig(int p) { return (p & 1) ? ((p == 1) ? 32 : 64 - (p >> 1)) : (p >> 1); }

struct Args { const float* in[19]; float* out; unsigned char* ws; };

struct EpiIn {
    static constexpr bool PERM = true, AFTER_DRAIN = false;
    unsigned char* wsb; int last;
    __device__ __forceinline__ void operator()(const pg8::f32x4 (&acc)[2][2][4][2], const pg8::Unit& u, int wr, int wc, int fr, int fq) const {
        using namespace pg8;
        asm volatile("" : "+v"(fr), "+v"(fq));
        unsigned char* ws = wsb; asm volatile("" : "+s"(ws));
        bf16_t* const QB = (bf16_t*)(ws + WS_QB); bf16_t* const KB = (bf16_t*)(ws + WS_KB); bf16_t* const VT = (bf16_t*)(ws + WS_VT); bf16_t* const VTc = (bf16_t*)(ws + WS_VTC);
        bf16_t* const UB = (bf16_t*)(ws + WS_UB); bf16_t* const GVT = (bf16_t*)(ws + WS_GVT); bf16_t* const GVTc = (bf16_t*)(ws + WS_GVTC); bf16_t* const GT = (bf16_t*)(ws + WS_GT); bf16_t* const GTc = (bf16_t*)(ws + WS_GTC);
        const float* const ropeC = (const float*)(ws + WS_ROPEC); const float* const ropeS = (const float*)(ws + WS_ROPES);
        const int pm = u.pm, pn = u.pn; const bool isctx = pm >= 256;
        if (isctx && last && pn != 2) return;
        const int b = isctx ? pm - 256 : pm >> 5;
        const int sbase = (isctx ? 0 : (pm & 31) * 256) + wr * 64 + fr;
        const size_t grow0 = (size_t)pm * 256 + wr * 64 + fr;
        const int c8 = wc * 32 + 8 * fq;
        if (pn <= 2) {
#pragma unroll
            for (int bj = 0; bj < 2; ++bj) {
                if (pn == 2 && bj == 1) {
                    bf16_t* base = isctx ? VTc + (size_t)b * 128 * 256 : VT + (size_t)b * 128 * 8192; const int ld = isctx ? 256 : 8192;
#pragma unroll
                    for (int ai = 0; ai < 2; ++ai)
#pragma unroll
                        for (int m = 0; m < 4; ++m) { const int s = sbase + ai * HALF + m * 16;
#pragma unroll
                            for (int n = 0; n < 2; ++n)
#pragma unroll
                                for (int j = 0; j < 4; ++j) base[(size_t)(c8 + 4 * n + j) * ld + s] = f2bf1(acc[ai][1][m][n][j]); asm volatile("" ::: "memory"); }
                } else {
                    const int i0 = 8 * (fq & 1); const bool odd = (wc & 1) != 0; const float sgn = (fq < 2) ? -1.f : 1.f;
#pragma unroll
                    for (int ai = 0; ai < 2; ++ai)
#pragma unroll
                        for (int m = 0; m < 4; ++m) { const int s = sbase + ai * HALF + m * 16;
                            f32x4 v0 = acc[ai][bj][m][0], v1 = acc[ai][bj][m][1];
                            if (!isctx) {
                                const int pos = odd ? (s & 63) : (s >> 6);
                                const f32x4 c0 = *(const f32x4*)(ropeC + pos * 16 + i0), c1 = *(const f32x4*)(ropeC + pos * 16 + i0 + 4);
                                const f32x4 s0 = *(const f32x4*)(ropeS + pos * 16 + i0), s1 = *(const f32x4*)(ropeS + pos * 16 + i0 + 4);
#pragma unroll
                                for (int j = 0; j < 4; ++j) { const float p0 = __shfl_xor(v0[j], 32), p1 = __shfl_xor(v1[j], 32);
                                    v0[j] = v0[j] * c0[j] + sgn * p0 * s0[j]; v1[j] = v1[j] * c1[j] + sgn * p1 * s1[j]; }
                            }
                            if (pn < 2) { v0 = v0 * QSCALE; v1 = v1 * QSCALE; }
                            u32x4 w; w.x = cvt_pk_bf16(v0[0], v0[1]); w.y = cvt_pk_bf16(v0[2], v0[3]); w.z = cvt_pk_bf16(v1[0], v1[1]); w.w = cvt_pk_bf16(v1[2], v1[3]);
                            const size_t grow = grow0 + ai * HALF + m * 16;
                            if (pn < 2) *(u32x4*)(QB + grow * 512 + pn * 256 + bj * HALF + c8) = w; else *(u32x4*)(KB + grow * 128 + c8) = w; asm volatile("" ::: "memory"); }
                }
            }
        } else if (pn == 3) {
#pragma unroll
            for (int ai = 0; ai < 2; ++ai)
#pragma unroll
                for (int m = 0; m < 4; ++m) { const size_t grow = grow0 + ai * HALF + m * 16;
#pragma unroll
                    for (int bj = 0; bj < 2; ++bj) { f32x4 v0 = acc[ai][bj][m][0], v1 = acc[ai][bj][m][1];
#pragma unroll
                        for (int j = 0; j < 4; ++j) { v0[j] = gelu_tanh(v0[j]); v1[j] = gelu_tanh(v1[j]); }
                        u32x4 w; w.x = cvt_pk_bf16(v0[0], v0[1]); w.y = cvt_pk_bf16(v0[2], v0[3]); w.z = cvt_pk_bf16(v1[0], v1[1]); w.w = cvt_pk_bf16(v1[2], v1[3]);
                        *(u32x4*)(UB + grow * 256 + bj * HALF + c8) = w; } asm volatile("" ::: "memory"); }
        } else if (pn == 4) {
            bf16_t* base = isctx ? GVTc + (size_t)b * 256 * 256 : GVT + (size_t)b * 256 * 8192; const int ld = isctx ? 256 : 8192;
#pragma unroll
            for (int ai = 0; ai < 2; ++ai)
#pragma unroll
                for (int m = 0; m < 4; ++m) { const int s = sbase + ai * HALF + m * 16;
#pragma unroll
                    for (int bj = 0; bj < 2; ++bj)
#pragma unroll
                        for (int n = 0; n < 2; ++n)
#pragma unroll
                            for (int j = 0; j < 4; ++j) base[(size_t)(bj * HALF + c8 + 4 * n + j) * ld + s] = f2bf1(gelu_tanh(acc[ai][bj][m][n][j])); asm volatile("" ::: "memory"); }
        } else {
            if (!isctx) {
                bf16_t* base = GT + ((size_t)b * 256 * 16 + fr) * 512 + 16 * (pm & 31) + 4 * wr;
#pragma unroll
                for (int bj = 0; bj < 2; ++bj)
#pragma unroll
                    for (int n = 0; n < 2; ++n)
#pragma unroll
                        for (int j = 0; j < 4; ++j) { const int ch = bj * HALF + c8 + 4 * n + j;
#pragma unroll
                            for (int ai = 0; ai < 2; ++ai) { u32x2 w; w.x = cvt_pk_bf16(acc[ai][bj][0][n][j], acc[ai][bj][1][n][j]); w.y = cvt_pk_bf16(acc[ai][bj][2][n][j], acc[ai][bj][3][n][j]);
                                *(u32x2*)(base + (size_t)ch * 8192 + 8 * ai) = w; } asm volatile("" ::: "memory"); }
            } else {
                bf16_t* base = GTc + (size_t)b * 256 * 512;
#pragma unroll
                for (int ai = 0; ai < 2; ++ai)
#pragma unroll
                    for (int m = 0; m < 4; ++m) { const int s = sbase + ai * HALF + m * 16;
#pragma unroll
                        for (int bj = 0; bj < 2; ++bj)
#pragma unroll
                            for (int n = 0; n < 2; ++n)
#pragma unroll
                                for (int j = 0; j < 4; ++j) { const int ch = bj * HALF + c8 + 4 * n + j; const bool ity = (ch & 1) && ((ch & 63) != 1);
                                    base[(size_t)ch * 512 + (ity ? 256 : 0) + s] = f2bf1(acc[ai][bj][m][n][j]); base[(size_t)ch * 512 + (ity ? 0 : 256) + s] = 0; } asm volatile("" ::: "memory"); }
            }
        }
    }
};


template <bool PERMK = false>
__device__ __forceinline__ void p0_transpose_item(const float* W, int K, int N, bf16* WT, int nblk, LAS float* scr, int item, int lane) {
    const int kb = item / nblk, nb = item % nblk, k0 = 64 * kb, n0 = 32 * nb;
    float tv[32];
#pragma unroll
    for (int i = 0; i < 32; ++i) { int kr = k0 + 2 * i + (lane >> 5); if (PERMK && kr >= 768) kr = (kr & ~63) + fsig(kr & 63); tv[i] = W[(size_t)kr * N + n0 + (lane & 31)]; }
#pragma unroll
    for (int i = 0; i < 32; ++i) scr[(2 * i + (lane >> 5)) * 33 + (lane & 31)] = tv[i];
    LDS_WAIT();
    const int c = lane & 7;
#pragma unroll
    for (int j = 0; j < 4; ++j) { const int n = (lane >> 3) + 8 * j; const LAS float* s = scr + (8 * c) * 33 + n;
        v4u o; o.x = cvt_pk_bf16(s[0 * 33], s[1 * 33]); o.y = cvt_pk_bf16(s[2 * 33], s[3 * 33]); o.z = cvt_pk_bf16(s[4 * 33], s[5 * 33]); o.w = cvt_pk_bf16(s[6 * 33], s[7 * 33]);
        *(v4u*)(WT + (size_t)(n0 + n) * K + k0 + 8 * c) = o; }
    LDS_WAIT();
}
__device__ __forceinline__ void p0_fold_item(const float* Win  , bf16* WT  , LAS float* scr, int item, int lane) {
    const int g = item >> 6, k0 = ((item >> 2) & 15) * 64, q0 = (item & 3) * 16;
    LAS float* cs = scr + 64 * 65; LAS float* sn = cs + 64;
    cs[lane] = cospif((float)lane / 32.f); sn[lane] = -sinpif((float)lane / 32.f);
#pragma unroll 1
    for (int i0 = 0; i0 < 64; i0 += 32) { float tv[32];
#pragma unroll
        for (int i = 0; i < 32; ++i) tv[i] = Win[(size_t)(k0 + i0 + i) * 1536 + 1280 + g * 64 + lane];
#pragma unroll
        for (int i = 0; i < 32; ++i) scr[(i0 + i) * 65 + lane] = tv[i]; }
    LDS_WAIT();
    for (int q = q0; q < q0 + 16; ++q) {
        const bool rtype = !(q & 1) || q == 1; const int jm = q == 1 ? 32 : (q >> 1);
        const LAS float* tab = rtype ? cs : sn;
        float ar = 0.f;
#pragma unroll 8
        for (int c = 0; c < 64; ++c) ar += scr[lane * 65 + c] * tab[(jm * c) & 63];
        WT[(size_t)(1280 + g * 64 + q) * 1024 + k0 + lane] = pg8::f2bf1(ar);
    }
    LDS_WAIT();
}
__device__ __forceinline__ void p0_mod_item(LAS unsigned char* lds, int item, const float* w_ada, const float* b_ada, float* MOD, int tid) {
    LAS float* sl = (LAS float*)lds; LAS float* red = sl + 9 * 1024;
    const int wave = tid >> 6, lane = tid & 63;
    const int l = item / 96, n0 = (item % 96) * 64;
    f32x4 acc[9];
#pragma unroll
    for (int r = 0; r < 9; ++r) acc[r] = (f32x4){0.f, 0.f, 0.f, 0.f};
    const int kr = lane >> 4, c4 = lane & 15;
    const float* W = w_ada + (size_t)l * 1024 * 6144 + n0 + c4 * 4;
#pragma unroll 1
    for (int k0 = 0; k0 < 128; k0 += 32) {
        f32x4 wv[8];
#pragma unroll
        for (int i = 0; i < 8; ++i) wv[i] = *(const f32x4*)(W + (size_t)(wave * 128 + k0 + i * 4 + kr) * 6144);
#pragma unroll
        for (int i = 0; i < 8; ++i) { const int k = wave * 128 + k0 + i * 4 + kr;
#pragma unroll
            for (int r = 0; r < 9; ++r) acc[r] = acc[r] + wv[i] * sl[r * 1024 + k]; }
    }
#pragma unroll
    for (int r = 0; r < 9; ++r)
#pragma unroll
        for (int e = 0; e < 4; ++e) { float v = acc[r][e]; v += __shfl_xor(v, 16); v += __shfl_xor(v, 32); acc[r][e] = v; }
    if (kr == 0) {
#pragma unroll
        for (int r = 0; r < 9; ++r)
#pragma unroll
            for (int e = 0; e < 4; ++e) red[(wave * 9 + r) * 64 + c4 * 4 + e] = acc[r][e];
    }
    __syncthreads();
    for (int i = tid; i < 576; i += 512) { const int r = i >> 6, n = i & 63; float s = b_ada[l * 6144 + n0 + n];
#pragma unroll
        for (int w = 0; w < 8; ++w) s += red[(w * 9 + r) * 64 + n];
        MOD[(size_t)(l * 9 + r) * 6144 + n0 + n] = s; }
    __syncthreads();
}
__device__ __forceinline__ void p0_prologue(const Args& a, LAS unsigned char* lds, int bid, int G, int tid) {
    asm volatile("" : "+v"(tid));
    unsigned char* ws = a.ws;
    const int wave = tid >> 6, lane = tid & 63;
    if (bid < 192) {
        LAS float* sl = (LAS float*)lds;
        for (int i = tid; i < 9 * 1024; i += 512) { const int r = i >> 10, k = i & 1023; const float v = r < 8 ? a.in[1][r * 1024 + k] : a.in[3][k]; sl[i] = v / (1.f + __expf(-v)); }
        __syncthreads();
        for (int it = bid; it < 192; it += G) p0_mod_item(lds, it, a.in[4], a.in[5], (float*)(ws + WS_MOD), tid);
    }
    __syncthreads();
    {
        const int gt = bid * 512 + tid, NT = G * 512;
        float* rc = (float*)(ws + WS_ROPEC); float* rs = (float*)(ws + WS_ROPES);
        for (int i = gt; i < 2048; i += NT) { const int pos = i >> 4, f = i & 15; const float invf = exp2f(-(float)f * (13.287712379549449f / 16.f));
            const float ang = (float)pos * invf; float rev = ang * 0.15915494309189535f; rev -= floorf(rev); rc[i] = cospif(2.f * rev); rs[i] = sinpif(2.f * rev); }
        float* tw = (float*)(ws + WS_TW);
        for (int i = gt; i < 8192; i += NT) { tw[2 * i] = cospif((float)i / 4096.f); tw[2 * i + 1] = sinpif((float)i / 4096.f); }
        bf16* d5 = (bf16*)(ws + WS_DFT512);
        for (int i = gt; i < 512 * 512; i += NT) { const int R = i >> 9, s1 = i & 511;
            float v; if (R < 256) v = cospif((float)((R * s1) & 511) / 256.f); else if (R == 256) v = (s1 & 1) ? -1.f : 1.f; else v = -sinpif((float)(((R - 256) * s1) & 511) / 256.f);
            d5[i] = pg8::f2bf1(v); }
        bf16* d2 = (bf16*)(ws + WS_DFT256);
        for (int i = gt; i < 256 * 512; i += NT) { const int k = i >> 9, C = i & 511, pc = C >> 8, s = C & 255; const int m = (k * s) & 255;
            d2[i] = pg8::f2bf1(pc == 0 ? cospif((float)m / 128.f) : sinpif((float)m / 128.f)); }
    }
    LAS float* scr = (LAS float*)(lds + wave * 17408);
    const int gw = bid * 8 + wave, NGW = G * 8;
    constexpr int PER = 640 + 256 + 512 + 2048 + 2048;
    for (int it = gw; it < 2 * PER; it += NGW) {
        const int l = it / PER; int r = it % PER;
        const float* win = a.in[7] + (size_t)l * 1024 * 1536; bf16* wtin = (bf16*)(ws + WS_WIN) + (size_t)l * NIN * 1024;
        if (r < 640) { p0_transpose_item(win, 1024, 1536, wtin, 40, scr, r, lane); continue; } r -= 640;
        if (r < 256) { p0_fold_item(win, wtin, scr, r, lane); continue; } r -= 256;
        if (r < 512) { p0_transpose_item<true>(a.in[13] + (size_t)l * 1024 * 1024, 1024, 1024, (bf16*)(ws + WS_WOUT) + (size_t)l * 1024 * 1024, 32, scr, r, lane); continue; } r -= 512;
        if (r < 2048) { p0_transpose_item(a.in[16] + (size_t)l * 1024 * 4096, 1024, 4096, (bf16*)(ws + WS_WFF1) + (size_t)l * 4096 * 1024, 128, scr, r, lane); continue; } r -= 2048;
        p0_transpose_item(a.in[17] + (size_t)l * 4096 * 1024, 4096, 1024, (bf16*)(ws + WS_WFF2) + (size_t)l * 1024 * 4096, 32, scr, r, lane);
    }
}

template <int NR, int NP = 0>
__device__ __forceinline__ void row_op(const float* xin, const bf16* upd, const float* gate, const float* gupd, float* xout, bf16* hxout,
                                       const float* gn, const float* sc, const float* sh, int lane,
                                       const bf16* upd2 = nullptr, const float* gate2 = nullptr, const float* gupd2 = nullptr) {
    asm volatile("" : "+v"(lane));
    f32x4 x[NR][4];
#pragma unroll
    for (int r = 0; r < NR; ++r)
#pragma unroll
        for (int j = 0; j < 4; ++j) x[r][j] = *(const f32x4*)(xin + (size_t)r * DM + j * 256 + lane * 4);
    if (upd) {
        f32x4 y[NR][4];
#pragma unroll
        for (int r = 0; r < NR; ++r)
#pragma unroll
            for (int j = 0; j < 4; ++j) {
                if (NP == 0) { const v2u w = *(const v2u*)(upd + (size_t)r * DM + j * 256 + lane * 4); y[r][j][0] = bflo(w.x); y[r][j][1] = bfhi(w.x); y[r][j][2] = bflo(w.y); y[r][j][3] = bfhi(w.y); }
                else { const float* pp = (const float*)upd + (size_t)r * DM + j * 256 + lane * 4; f32x4 t = *(const f32x4*)pp;
#pragma unroll
                    for (int p = 1; p < NP; ++p) t = t + *(const f32x4*)(pp + (size_t)p * 2048 * 1024);
                    y[r][j] = t; } }
        float rr[NR];
#pragma unroll
        for (int r = 0; r < NR; ++r) { float ss = 0.f;
#pragma unroll
            for (int j = 0; j < 4; ++j) ss += (y[r][j][0] * y[r][j][0] + y[r][j][1] * y[r][j][1]) + (y[r][j][2] * y[r][j][2] + y[r][j][3] * y[r][j][3]);
            rr[r] = ss; }
#pragma unroll
        for (int r = 0; r < NR; ++r) rr[r] = rsqrtf(wave_sum(rr[r]) * (1.f / 1024.f) + EPSN);
#pragma unroll
        for (int j = 0; j < 4; ++j) { const f32x4 g = *(const f32x4*)(gate + j * 256 + lane * 4) * *(const f32x4*)(gupd + j * 256 + lane * 4);
#pragma unroll
            for (int r = 0; r < NR; ++r) x[r][j] = x[r][j] + g * (y[r][j] * rr[r]); }
    }
    if (upd2) {
        f32x4 y[NR][4];
#pragma unroll
        for (int r = 0; r < NR; ++r)
#pragma unroll
            for (int j = 0; j < 4; ++j) { const v2u w = *(const v2u*)(upd2 + (size_t)r * DM + j * 256 + lane * 4); y[r][j][0] = bflo(w.x); y[r][j][1] = bfhi(w.x); y[r][j][2] = bflo(w.y); y[r][j][3] = bfhi(w.y); }
        float rr[NR];
#pragma unroll
        for (int r = 0; r < NR; ++r) { float ss = 0.f;
#pragma unroll
            for (int j = 0; j < 4; ++j) ss += (y[r][j][0] * y[r][j][0] + y[r][j][1] * y[r][j][1]) + (y[r][j][2] * y[r][j][2] + y[r][j][3] * y[r][j][3]);
            rr[r] = ss; }
#pragma unroll
        for (int r = 0; r < NR; ++r) rr[r] = rsqrtf(wave_sum(rr[r]) * (1.f / 1024.f) + EPSN);
#pragma unroll
        for (int j = 0; j < 4; ++j) { const f32x4 g = *(const f32x4*)(gate2 + j * 256 + lane * 4) * *(const f32x4*)(gupd2 + j * 256 + lane * 4);
#pragma unroll
            for (int r = 0; r < NR; ++r) x[r][j] = x[r][j] + g * (y[r][j] * rr[r]); }
    }
    if (xout) {
#pragma unroll
        for (int r = 0; r < NR; ++r)
#pragma unroll
            for (int j = 0; j < 4; ++j) *(f32x4*)(xout + (size_t)r * DM + j * 256 + lane * 4) = x[r][j];
    }
    if (hxout) {
        float rr[NR];
#pragma unroll
        for (int r = 0; r < NR; ++r) { float ss = 0.f;
#pragma unroll
            for (int j = 0; j < 4; ++j) ss += (x[r][j][0] * x[r][j][0] + x[r][j][1] * x[r][j][1]) + (x[r][j][2] * x[r][j][2] + x[r][j][3] * x[r][j][3]);
            rr[r] = ss; }
#pragma unroll
        for (int r = 0; r < NR; ++r) rr[r] = rsqrtf(wave_sum(rr[r]) * (1.f / 1024.f) + EPSN);
#pragma unroll
        for (int j = 0; j < 4; ++j) { const f32x4 g = *(const f32x4*)(gn + j * 256 + lane * 4) * (*(const f32x4*)(sc + j * 256 + lane * 4) + 1.f), s0 = *(const f32x4*)(sh + j * 256 + lane * 4);
#pragma unroll
            for (int r = 0; r < NR; ++r) { const f32x4 h = (x[r][j] * rr[r]) * g + s0; v2u w; w.x = cvt_pk_bf16(h[0], h[1]); w.y = cvt_pk_bf16(h[2], h[3]); *(v2u*)(hxout + (size_t)r * DM + j * 256 + lane * 4) = w; } }
    }
}
template <int NR>
__device__ __forceinline__ void mixnorm_rows(bf16* mix, const float* gmix, int lane, bf16* outp) {
    asm volatile("" : "+v"(lane));
    v4u w[NR][2];
#pragma unroll
    for (int r = 0; r < NR; ++r) { w[r][0] = *(const v4u*)(mix + (size_t)r * 1024 + lane * 16); w[r][1] = *(const v4u*)(mix + (size_t)r * 1024 + lane * 16 + 8); }
    f32x4 g[4];
#pragma unroll
    for (int q = 0; q < 4; ++q) g[q] = *(const f32x4*)(gmix + lane * 16 + q * 4);
    float rr[NR];
#pragma unroll
    for (int r = 0; r < NR; ++r) { float ss = 0.f;
#pragma unroll
        for (int h = 0; h < 2; ++h)
#pragma unroll
            for (int e = 0; e < 4; ++e) { const float a = bflo(w[r][h][e]), b = bfhi(w[r][h][e]); ss += a * a + b * b; }
        rr[r] = ss; }
#pragma unroll
    for (int r = 0; r < NR; ++r) { float ss = rr[r]; ss += __shfl_xor(ss, 1); ss += __shfl_xor(ss, 2); ss += __shfl_xor(ss, 4); ss += __shfl_xor(ss, 8);
        const float s16 = __shfl_xor(ss, 16); const float tot = lane < 32 ? ss + s16 : ss; const float cnt = lane < 32 ? 512.f : 256.f;
        rr[r] = rsqrtf(tot / cnt + EPSN); }
#pragma unroll
    for (int r = 0; r < NR; ++r) {
#pragma unroll
        for (int h = 0; h < 2; ++h)
#pragma unroll
            for (int e = 0; e < 4; ++e) { const int q = h * 2 + (e >> 1); const float a = bflo(w[r][h][e]) * rr[r] * g[q][(e & 1) * 2], b = bfhi(w[r][h][e]) * rr[r] * g[q][(e & 1) * 2 + 1]; w[r][h][e] = cvt_pk_bf16(a, b); }
        *(v4u*)(outp + (size_t)r * 1024 + lane * 16) = w[r][0]; *(v4u*)(outp + (size_t)r * 1024 + lane * 16 + 8) = w[r][1]; }
}

#define MFMA32(a, b, c) __builtin_amdgcn_mfma_f32_32x32x16_bf16(a, b, c, 0, 0, 0)
constexpr int AT_ST = 136;
constexpr int AT_HALF = 128 * AT_ST * 2;
constexpr int AT_BUF = 2 * AT_HALF;
constexpr int AT_RED = 2 * AT_BUF;
__device__ __forceinline__ void attn_units(LAS unsigned char* lds, const bf16* QB, const bf16* KB, const bf16* VT, const bf16* VTc, bf16* MIX, const float* sink, const float* gmix,
                                           int nunits, int G, int vb, int tid) {
    asm volatile("" : "+v"(tid));
    const int wave = __builtin_amdgcn_readfirstlane(tid >> 6), lane = tid & 63, h = wave >> 2, c = lane & 31, hh = lane >> 5;
    LAS float* red = (LAS float*)(lds + AT_RED);
    for (int L = vb; L < nunits; L += G) {
        const int uidx = (L < 1024 && (G & 7) == 0) ? (L & 7) * 128 + (L >> 3) : L;
        const bool isctx = uidx >= 1024; int b, nb, q0;
        if (!isctx) { b = uidx >> 7; nb = (uidx >> 1) & 63; q0 = nb * 128 + (uidx & 1) * 64; } else { const int v = uidx - 1024; b = v >> 2; nb = 0; q0 = (v & 3) * 64; }
        const size_t qrow0 = (size_t)(isctx ? ML + b * CTXL : b * SEQ) + q0;
        bf16x8 qf[2][4];
#pragma unroll
        for (int qs = 0; qs < 2; ++qs)
#pragma unroll
            for (int ks = 0; ks < 4; ++ks) qf[qs][ks] = *(const bf16x8*)(QB + (qrow0 + qs * 32 + c) * 512 + wave * 64 + ks * 16 + hh * 8);
        float mrun[2], lrun[2]; f32x16 o[2][2];
        const float sk = sink[wave] * LOG2E;
#pragma unroll
        for (int qs = 0; qs < 2; ++qs) { mrun[qs] = sk; lrun[qs] = 1.f;
#pragma unroll
            for (int dt = 0; dt < 2; ++dt)
#pragma unroll
                for (int r = 0; r < 16; ++r) o[qs][dt][r] = 0.f; }
        int s = isctx ? 3 : (nb == 0 ? 1 : 0);
        v4u pk[4], pv[4];
#define AT_ISSUE(ss) do { const bf16* kg; const bf16* vg; int ldv; \
            if ((ss) < 3) { const int kb0 = (nb - 1 + (ss)) * 128; kg = KB + (size_t)(b * SEQ + kb0) * 128; vg = VT + (size_t)(b * 128) * SEQ + kb0; ldv = SEQ; } \
            else { const int kb0 = ((ss) - 3) * 128; kg = KB + (size_t)(ML + b * CTXL + kb0) * 128; vg = VTc + (size_t)(b * 128) * CTXL + kb0; ldv = CTXL; } \
            _Pragma("unroll") for (int e = 0; e < 4; ++e) { const int i = tid + 512 * e, r = i >> 4, ch = i & 15; pk[e] = *(const v4u*)(kg + (size_t)r * 128 + ch * 8); pv[e] = *(const v4u*)(vg + (size_t)r * ldv + ch * 8); } } while (0)
#define AT_WRITE(bufo) do { _Pragma("unroll") for (int e = 0; e < 4; ++e) { const int i = tid + 512 * e, r = i >> 4, ch = i & 15; \
            *(LAS v4u*)(lds + (bufo) + (r * AT_ST + ch * 8) * 2) = pk[e]; *(LAS v4u*)(lds + (bufo) + AT_HALF + (r * AT_ST + ch * 8) * 2) = pv[e]; } } while (0)
        AT_ISSUE(s);
        __syncthreads();
        AT_WRITE(0);
        __syncthreads();
        int cur = 0;
        for (;;) {
            int sn = s + 1; if (sn == 2 && !isctx && nb == 63) sn = 3;
            if (sn <= 4) AT_ISSUE(sn);
            const LAS bf16* Ks = (const LAS bf16*)(lds + cur * AT_BUF); const LAS bf16* Vs = (const LAS bf16*)(lds + cur * AT_BUF + AT_HALF);
            int t_lo = 0, t_hi = 3; const int kb0 = (nb - 1 + s) * 128;
            if (s < 3) { const int a0 = q0 - 128 - kb0, a1 = q0 + 191 - kb0; t_lo = a0 > 0 ? a0 >> 5 : 0; t_hi = (a1 >> 5) < 3 ? (a1 >> 5) : 3; }
#pragma unroll 2
            for (int kt = t_lo; kt <= t_hi; ++kt) {
                bf16x8 kf[4];
#pragma unroll
                for (int ks = 0; ks < 4; ++ks) kf[ks] = *(const LAS bf16x8*)(Ks + (kt * 32 + c) * AT_ST + h * 64 + ks * 16 + hh * 8);
                bf16x8 vf[2][2];
#pragma unroll
                for (int dt = 0; dt < 2; ++dt)
#pragma unroll
                    for (int s2 = 0; s2 < 2; ++s2) { const LAS bf16* p = Vs + (h * 64 + dt * 32 + c) * AT_ST + kt * 32 + s2 * 16 + hh * 4;
                        const v2u lo = *(const LAS v2u*)p, hi = *(const LAS v2u*)(p + 8); v4u t; t.x = lo.x; t.y = lo.y; t.z = hi.x; t.w = hi.y; vf[dt][s2] = __builtin_bit_cast(bf16x8, t); }
                f32x16 st[2];
#pragma unroll
                for (int qs = 0; qs < 2; ++qs) {
                    const float nm = -mrun[qs];
#pragma unroll
                    for (int r = 0; r < 16; ++r) st[qs][r] = nm;
#pragma unroll
                    for (int ks = 0; ks < 4; ++ks) st[qs] = MFMA32(kf[ks], qf[qs][ks], st[qs]);
                }
                bf16x8 pb[2][2];
#pragma unroll
                for (int qs = 0; qs < 2; ++qs) {
                    const int kmin = kb0 + kt * 32, qmin = q0 + qs * 32;
                    if (s < 3 && (kmin - (qmin + 31) > 128 || qmin - (kmin + 31) > 128)) continue;
                    float t[16];
#pragma unroll
                    for (int r = 0; r < 16; ++r) t[r] = st[qs][r];
                    if (s < 3 && (kmin - (qmin + 31) < -128 || kmin + 31 - qmin > 128)) {
                        const int base = kmin + 4 * hh - (qmin + c) + 128;
#pragma unroll
                        for (int r = 0; r < 16; ++r) { if ((unsigned)(base + (r & 3) + 8 * (r >> 2)) > 256u) t[r] = -1e30f; } }
                    float tmax = fmaxf(fmaxf(t[0], t[1]), t[2]);
#pragma unroll
                    for (int r = 3; r < 15; r += 2) tmax = fmaxf(fmaxf(tmax, t[r]), t[r + 1]);
                    tmax = fmaxf(tmax, t[15]);
                    { auto rr = __builtin_amdgcn_permlane32_swap(__float_as_uint(tmax), __float_as_uint(tmax), false, false); tmax = fmaxf(__uint_as_float(rr[0]), __uint_as_float(rr[1])); }
                    if (!__all(tmax <= 8.f)) {
                        const float delta = fmaxf(tmax, 0.f), alpha = __builtin_amdgcn_exp2f(-delta);
                        lrun[qs] *= alpha; mrun[qs] += delta;
#pragma unroll
                        for (int dt = 0; dt < 2; ++dt) o[qs][dt] = o[qs][dt] * alpha;
#pragma unroll
                        for (int r = 0; r < 16; ++r) t[r] -= delta;
                    }
                    float psum = 0.f;
#pragma unroll
                    for (int r = 0; r < 16; ++r) { t[r] = __builtin_amdgcn_exp2f(t[r]); psum += t[r]; }
                    { auto rr = __builtin_amdgcn_permlane32_swap(__float_as_uint(psum), __float_as_uint(psum), false, false); psum = __uint_as_float(rr[0]) + __uint_as_float(rr[1]); }
                    lrun[qs] += psum;
#pragma unroll
                    for (int s2 = 0; s2 < 2; ++s2) { v4u w; w.x = cvt_pk_bf16(t[8 * s2 + 0], t[8 * s2 + 1]); w.y = cvt_pk_bf16(t[8 * s2 + 2], t[8 * s2 + 3]); w.z = cvt_pk_bf16(t[8 * s2 + 4], t[8 * s2 + 5]); w.w = cvt_pk_bf16(t[8 * s2 + 6], t[8 * s2 + 7]);
                        pb[qs][s2] = __builtin_bit_cast(bf16x8, w); }
#pragma unroll
                    for (int s2 = 0; s2 < 2; ++s2)
#pragma unroll
                        for (int dt = 0; dt < 2; ++dt) o[qs][dt] = MFMA32(vf[dt][s2], pb[qs][s2], o[qs][dt]);
                    __builtin_amdgcn_sched_barrier(0);
                }
            }
            if (sn > 4) break;
            AT_WRITE((cur ^ 1) * AT_BUF);
            __syncthreads();
            cur ^= 1; s = sn;
        }
#undef AT_ISSUE
#undef AT_WRITE
        float ssq[2];
#pragma unroll
        for (int qs = 0; qs < 2; ++qs) { const float inv = 1.f / lrun[qs]; float ss = 0.f;
#pragma unroll
            for (int dt = 0; dt < 2; ++dt) { o[qs][dt] = o[qs][dt] * inv;
#pragma unroll
                for (int r = 0; r < 16; ++r) ss += o[qs][dt][r] * o[qs][dt][r]; }
            { auto rr = __builtin_amdgcn_permlane32_swap(__float_as_uint(ss), __float_as_uint(ss), false, false); ss = __uint_as_float(rr[0]) + __uint_as_float(rr[1]); }
            ssq[qs] = ss; if (hh == 0) red[wave * 64 + qs * 32 + c] = ss; }
        __syncthreads();
        LAS bf16* otile = (LAS bf16*)(lds + wave * 9216);
#pragma unroll
        for (int qs = 0; qs < 2; ++qs) { float tot = 0.f;
#pragma unroll
            for (int w = 0; w < 8; ++w) tot += red[w * 64 + qs * 32 + c];
            const float rn = rsqrtf(tot * (1.f / 512.f) + EPSN);
#pragma unroll
            for (int dt = 0; dt < 2; ++dt)
#pragma unroll
                for (int rg = 0; rg < 4; ++rg) { const f32x4 gm = *(const f32x4*)(gmix + wave * 64 + dt * 32 + rg * 8 + hh * 4);
                    v2u w; w.x = cvt_pk_bf16(o[qs][dt][4 * rg] * rn * gm[0], o[qs][dt][4 * rg + 1] * rn * gm[1]); w.y = cvt_pk_bf16(o[qs][dt][4 * rg + 2] * rn * gm[2], o[qs][dt][4 * rg + 3] * rn * gm[3]);
                    *(LAS v2u*)(otile + (qs * 32 + c) * 72 + dt * 32 + rg * 8 + hh * 4) = w; } }
        LDS_WAIT();
#pragma unroll
        for (int it = 0; it < 8; ++it) { const int r = it * 8 + (lane >> 3), ch = lane & 7; const v4u v = *(const LAS v4u*)(otile + r * 72 + ch * 8);
            *(v4u*)(MIX + (qrow0 + r) * 1024 + wave * 64 + ch * 8) = v; }
    }
    __syncthreads();
}

__device__ __forceinline__ void sgu_units(LAS unsigned char* lds, const bf16* UB, const bf16* GVT, const bf16* GVTc, bf16* MIX, const float* wsgu, const float* bsgu, const float* gsgu, const float* gmix,
                                          int nchunks, int G, int bid, int tid) {
    asm volatile("" : "+v"(tid));
    const int wave = __builtin_amdgcn_readfirstlane(tid >> 6), lane = tid & 63, hd = wave >> 1, ph = wave & 1, c = lane & 31, h2 = lane >> 5;
    LAS float* rq = (LAS float*)lds + wave * 128;
    bf16x8 bfr[2][8];
#pragma unroll
    for (int ps = 0; ps < 2; ++ps)
#pragma unroll
        for (int ks = 0; ks < 8; ++ks) { const float* wp = wsgu + ((size_t)(hd * 128 + ph * 64 + ps * 32 + c)) * 128 + ks * 16 + h2 * 8; const f32x4 w0 = *(const f32x4*)wp, w1 = *(const f32x4*)(wp + 4);
            v4u w; w.x = cvt_pk_bf16(w0[0], w0[1]); w.y = cvt_pk_bf16(w0[2], w0[3]); w.z = cvt_pk_bf16(w1[0], w1[1]); w.w = cvt_pk_bf16(w1[2], w1[3]); bfr[ps][ks] = __builtin_bit_cast(bf16x8, w); }
    for (int L = bid; L < nchunks; L += G) {
        const int chunk = (L < 512 && (G & 7) == 0) ? (L & 7) * 64 + (L >> 3) : L;
        const bool isctx = chunk >= 512; const int b = isctx ? (chunk - 512) >> 1 : chunk >> 6, s0 = isctx ? ((chunk - 512) & 1) * 128 : (chunk & 63) * 128;
        const int ld = isctx ? CTXL : SEQ;
        const bf16* Gt = (isctx ? GVTc + ((size_t)(b * 256 + hd * 64)) * CTXL : GVT + ((size_t)(b * 256 + hd * 64)) * SEQ) + s0;
        float sa = 0.f, sb = 0.f;
#pragma unroll 1
        for (int d0 = 0; d0 < 64; d0 += 32) { unsigned gv[32];
#pragma unroll
            for (int d = 0; d < 32; ++d) gv[d] = *(const unsigned*)(Gt + (size_t)(d0 + d) * ld + 2 * lane);
#pragma unroll
            for (int d = 0; d < 32; ++d) { const float x0 = bflo(gv[d]), x1 = bfhi(gv[d]); sa += x0 * x0; sb += x1 * x1; } }
        LDS_WAIT();
        rq[2 * lane] = rsqrtf(sa * (1.f / 64.f) + EPSN); rq[2 * lane + 1] = rsqrtf(sb * (1.f / 64.f) + EPSN);
        LDS_WAIT();
        f32x16 o[2][2];
#pragma unroll
        for (int dt = 0; dt < 2; ++dt)
#pragma unroll
            for (int ps = 0; ps < 2; ++ps)
#pragma unroll
                for (int r = 0; r < 16; ++r) o[dt][ps][r] = 0.f;
        v4u afr[2][8];
#pragma unroll
        for (int ks = 0; ks < 8; ++ks)
#pragma unroll
            for (int dt = 0; dt < 2; ++dt) afr[dt][ks] = *(const v4u*)(Gt + (size_t)(dt * 32 + c) * ld + ks * 16 + h2 * 8);
        LAS bf16* utile = (LAS bf16*)(lds + 8192 + wave * 9216);
        { v4u ut[8];
#pragma unroll
          for (int it = 0; it < 8; ++it) ut[it] = *(const v4u*)(UB + ((size_t)chunk * 128 + ph * 64 + it * 8 + (lane >> 3)) * 256 + hd * 64 + (lane & 7) * 8);
#pragma unroll
          for (int it = 0; it < 8; ++it) *(LAS v4u*)(utile + (it * 8 + (lane >> 3)) * 72 + (lane & 7) * 8) = ut[it]; }
#pragma unroll
        for (int ks = 0; ks < 8; ++ks) {
            const f32x4 r0 = *(const LAS f32x4*)(rq + ks * 16 + h2 * 8), r1 = *(const LAS f32x4*)(rq + ks * 16 + h2 * 8 + 4);
#pragma unroll
            for (int dt = 0; dt < 2; ++dt) { const v4u g = afr[dt][ks]; v4u w;
                w.x = cvt_pk_bf16(bflo(g.x) * r0[0], bfhi(g.x) * r0[1]); w.y = cvt_pk_bf16(bflo(g.y) * r0[2], bfhi(g.y) * r0[3]); w.z = cvt_pk_bf16(bflo(g.z) * r1[0], bfhi(g.z) * r1[1]); w.w = cvt_pk_bf16(bflo(g.w) * r1[2], bfhi(g.w) * r1[3]);
                const bf16x8 af = __builtin_bit_cast(bf16x8, w);
#pragma unroll
                for (int ps = 0; ps < 2; ++ps) o[dt][ps] = MFMA32(af, bfr[ps][ks], o[dt][ps]); }
        }
        LAS float* red2 = (LAS float*)(lds + 4096);
#pragma unroll
        for (int ps = 0; ps < 2; ++ps) { const int p = ph * 64 + ps * 32 + c; const size_t row = (size_t)chunk * 128 + p; const float bs = bsgu[hd * 128 + p]; float ss = 0.f;
#pragma unroll
            for (int dt = 0; dt < 2; ++dt)
#pragma unroll
                for (int rg = 0; rg < 4; ++rg) { const int d0 = dt * 32 + rg * 8 + h2 * 4; const f32x4 gs = *(const f32x4*)(gsgu + hd * 64 + d0);
                    const v2u uw = *(const LAS v2u*)(utile + (ps * 32 + c) * 72 + d0);
                    const float o0 = bflo(uw.x) * (gs[0] * o[dt][ps][4 * rg] + bs), o1 = bfhi(uw.x) * (gs[1] * o[dt][ps][4 * rg + 1] + bs), o2 = bflo(uw.y) * (gs[2] * o[dt][ps][4 * rg + 2] + bs), o3 = bfhi(uw.y) * (gs[3] * o[dt][ps][4 * rg + 3] + bs);
                    o[dt][ps][4 * rg] = o0; o[dt][ps][4 * rg + 1] = o1; o[dt][ps][4 * rg + 2] = o2; o[dt][ps][4 * rg + 3] = o3; ss += (o0 * o0 + o1 * o1) + (o2 * o2 + o3 * o3); }
            { auto rr = __builtin_amdgcn_permlane32_swap(__float_as_uint(ss), __float_as_uint(ss), false, false); ss = __uint_as_float(rr[0]) + __uint_as_float(rr[1]); }
            if (h2 == 0) red2[hd * 128 + p] = ss; }
        __syncthreads();
        LAS bf16* otile = (LAS bf16*)(lds + 8192 + wave * 9216);
#pragma unroll
        for (int ps = 0; ps < 2; ++ps) { const int p = ph * 64 + ps * 32 + c;
            const float rn = rsqrtf((red2[p] + red2[128 + p] + red2[256 + p] + red2[384 + p]) * (1.f / 256.f) + EPSN);
#pragma unroll
            for (int dt = 0; dt < 2; ++dt)
#pragma unroll
                for (int rg = 0; rg < 4; ++rg) { const int d0 = dt * 32 + rg * 8 + h2 * 4; const f32x4 gm = *(const f32x4*)(gmix + 512 + hd * 64 + d0);
                    v2u w; w.x = cvt_pk_bf16(o[dt][ps][4 * rg] * rn * gm[0], o[dt][ps][4 * rg + 1] * rn * gm[1]); w.y = cvt_pk_bf16(o[dt][ps][4 * rg + 2] * rn * gm[2], o[dt][ps][4 * rg + 3] * rn * gm[3]);
                    *(LAS v2u*)(otile + (ps * 32 + c) * 72 + d0) = w; } }
        LDS_WAIT();
#pragma unroll
        for (int it = 0; it < 8; ++it) { const int r = it * 8 + (lane >> 3), ch = lane & 7; const v4u v = *(const LAS v4u*)(otile + r * 72 + ch * 8);
            *(v4u*)(MIX + ((size_t)chunk * 128 + ph * 64 + r) * 1024 + 512 + hd * 64 + ch * 8) = v; }
        LDS_WAIT();
        __syncthreads();
    }
}

__device__ __forceinline__ void fourier_stage2(LAS unsigned char* lds, int wave, const bf16* Tp, bf16* MIX, const float* gmix, int gw, int NGW, int lane) {
    asm volatile("" : "+v"(lane));
    LAS bf16* slab = (LAS bf16*)(lds + wave * 8448);
    const int k2 = lane & 15, kq = lane >> 4, prt = kq >> 1, s2b = (kq & 1) * 8;
    constexpr float NRM = 0.0013810679320049757f;
    for (int item = gw; item < 4096; item += NGW) {
        const int k1 = item >> 3, b = item & 7, k = k1 + 512 * k2;
        const int k1p = k1 <= 256 ? k1 : 512 - k1;
        const float imf = (k1p == 0 || k1p == 256) ? 0.f : (k1 > 256 ? -1.f : 1.f);
        const int trow = prt == 0 ? k1p : ((k1p == 0 || k1p == 256) ? 0 : 256 + k1p);
        unsigned wr_[4], wi_[4];
#pragma unroll
        for (int jj = 0; jj < 4; ++jj) { float c[2], sn[2];
#pragma unroll
            for (int u = 0; u < 2; ++u) { const int n = (k * (s2b + 2 * jj + u)) & 8191; const float rev = (float)n * (1.f / 8192.f); c[u] = __builtin_amdgcn_cosf(rev); sn[u] = __builtin_amdgcn_sinf(rev); }
            wr_[jj] = prt == 0 ? cvt_pk_bf16(c[0], c[1]) : cvt_pk_bf16(imf * sn[0], imf * sn[1]);
            wi_[jj] = prt == 0 ? cvt_pk_bf16(sn[0], sn[1]) : cvt_pk_bf16(-imf * c[0], -imf * c[1]); }
        v4u t0; t0.x = wr_[0]; t0.y = wr_[1]; t0.z = wr_[2]; t0.w = wr_[3]; const bf16x8 bR = __builtin_bit_cast(bf16x8, t0);
        v4u t1; t1.x = wi_[0]; t1.y = wi_[1]; t1.z = wi_[2]; t1.w = wi_[3]; const bf16x8 bI = __builtin_bit_cast(bf16x8, t1);
        const bf16* ap = Tp + (size_t)trow * 32768 + ((size_t)(b * 256 + k2) * 16 + s2b);
        bf16x8 af[16];
#pragma unroll
        for (int t = 0; t < 16; ++t) af[t] = *(const bf16x8*)(ap + t * 256);
        f32x4 y[16]; float ss = 0.f;
#pragma unroll
        for (int t = 0; t < 16; ++t) {
            const f32x4 z4 = {0.f, 0.f, 0.f, 0.f};
            const f32x4 aR = __builtin_amdgcn_mfma_f32_16x16x32_bf16(af[t], bR, z4, 0, 0, 0), aI = __builtin_amdgcn_mfma_f32_16x16x32_bf16(af[t], bI, z4, 0, 0, 0);
            const bool special = ((t & 3) == 0) && kq == 0;
            const float p0 = aR[0] * NRM, p1 = (special ? aR[1] : aI[1]) * NRM, p2 = aR[2] * NRM, p3 = aI[3] * NRM;
            f32x4 o; o[0] = special ? p0 : p0 + p1; o[1] = special ? p1 : p0 - p1; o[2] = p2 + p3; o[3] = p2 - p3;
            y[t] = o; ss += (o[0] * o[0] + o[1] * o[1]) + (o[2] * o[2] + o[3] * o[3]); }
        ss += __shfl_xor(ss, 16); ss += __shfl_xor(ss, 32);
        const float rn = rsqrtf(ss * (1.f / 256.f) + EPSN);
#pragma unroll
        for (int t = 0; t < 16; ++t) { const float* gb = gmix + 768 + (t >> 2) * 64; const int p = 16 * (t & 3) + 4 * kq;
            v2u w; w.x = cvt_pk_bf16(y[t][0] * rn * gb[fsig(p)], y[t][1] * rn * gb[fsig(p + 1)]); w.y = cvt_pk_bf16(y[t][2] * rn * gb[fsig(p + 2)], y[t][3] * rn * gb[fsig(p + 3)]);
            *(LAS v2u*)(slab + k2 * 264 + 16 * t + 4 * kq) = w; }
        LDS_WAIT();
#pragma unroll
        for (int it = 0; it < 8; ++it) { const int r = it * 2 + (lane >> 5), ch = lane & 31; const v4u v = *(const LAS v4u*)(slab + r * 264 + ch * 8);
            *(v4u*)(MIX + ((size_t)b * SEQ + k1 + 512 * r) * 1024 + 768 + ch * 8) = v; }
        LDS_WAIT();
    }
}
__device__ __forceinline__ void ctx_fourier_norm(bf16* MIX, const float* gmix, int gw, int NGW, int lane) {
    asm volatile("" : "+v"(lane));
    const int pg = (lane * 4) & 63, grp = lane >> 4;
    for (int row = ML + gw; row < MT; row += NGW) { bf16* p = MIX + (size_t)row * 1024 + 768 + lane * 4;
        const v2u w = *(const v2u*)p; const float a0 = bflo(w.x), b0 = bfhi(w.x), a1 = bflo(w.y), b1 = bfhi(w.y);
        const bool pass = pg == 0;
        const float v0 = pass ? a0 : a0 + b0, v1 = pass ? b0 : a0 - b0, v2 = a1 + b1, v3 = a1 - b1;
        const float rn = rsqrtf(wave_sum((v0 * v0 + v1 * v1) + (v2 * v2 + v3 * v3)) * (1.f / 256.f) + EPSN);
        const float* gb = gmix + 768 + grp * 64;
        v2u o; o.x = cvt_pk_bf16(v0 * rn * gb[fsig(pg)], v1 * rn * gb[fsig(pg + 1)]); o.y = cvt_pk_bf16(v2 * rn * gb[fsig(pg + 2)], v3 * rn * gb[fsig(pg + 3)]); *(v2u*)p = o; }
}

#define XB_TMO      128
#define XB_XCNT(j)  (256  + 64 * (j))
#define XB_XSUB(j)  (1280 + 64 * (j))
#define XB_XGEN(j)  (2304 + 64 * (j))
#define XB_TOP      3328
#define XB_TOPGEN   3392
#define XCD_BAR_WORDS 3456
#define XB_SPIN_CAP (1u << 18)

__device__ __forceinline__ unsigned xb_ld(unsigned* p)              { return __hip_atomic_load(p, __ATOMIC_RELAXED, __HIP_MEMORY_SCOPE_AGENT); }
__device__ __forceinline__ unsigned xb_add(unsigned* p, unsigned v) { return __hip_atomic_fetch_add(p, v, __ATOMIC_RELAXED, __HIP_MEMORY_SCOPE_AGENT); }
__device__ __forceinline__ unsigned xb_xcc_id() { return (unsigned)__builtin_amdgcn_s_getreg((3 << 11) | 20) & 0xFu; }
#define XB_SPIN(cond, bar) do { unsigned _sp = 0; while (cond) { __builtin_amdgcn_s_sleep(1); \
    if ((++_sp & 255u) == 0u) { if (xb_ld(&(bar)[XB_TMO])) break; if (_sp > XB_SPIN_CAP) { atomicAdd(&(bar)[XB_TMO], 1u); break; } } } } while (0)

struct XcdBarrier {
    unsigned* bar; unsigned x;
    volatile LAS unsigned* st;
};

__device__ __forceinline__ XcdBarrier xcd_barrier_post(unsigned* bar, volatile LAS unsigned* st) {
    XcdBarrier b; b.bar = bar; b.x = xb_xcc_id(); b.st = st;
    if (threadIdx.x == 0) (void)xb_add(&bar[XB_XCNT(b.x)], 1u);
    return b;
}
__device__ __forceinline__ void xcd_barrier_complete(unsigned* bar, unsigned x, unsigned& nloc, unsigned& nx) {
    const unsigned G = gridDim.x * gridDim.y * gridDim.z;
    unsigned sum, cnt, mine, sp = 0u;
    for (;;) {
        sum = 0u; cnt = 0u; mine = 0u;
#pragma unroll
        for (unsigned j = 0; j < 16; ++j) { const unsigned c = xb_ld(&bar[XB_XCNT(j)]); sum += c; cnt += (c > 0u) ? 1u : 0u; mine = (j == x) ? c : mine; }
        if (sum == G) break;
        __builtin_amdgcn_s_sleep(1);
        if ((++sp & 255u) == 0u) { if (xb_ld(&bar[XB_TMO])) break; if (sp > XB_SPIN_CAP) { atomicAdd(&bar[XB_TMO], 1u); break; } }
    }
    nloc = mine > 0u ? mine : 1u; nx = cnt > 0u ? cnt : 1u;
}

__device__ __forceinline__ void xcd_barrier(const XcdBarrier& b) {
    asm volatile("s_waitcnt vmcnt(0)" ::: "memory");
    __syncthreads();
    if (threadIdx.x == 0) {
        unsigned* bar = b.bar;
        __builtin_amdgcn_s_waitcnt(0);
        unsigned nloc = b.st[0], nx = b.st[1];
        if (nloc == 0u) { xcd_barrier_complete(bar, b.x, nloc, nx); b.st[0] = nloc; b.st[1] = nx; }
        const unsigned old = xb_add(&bar[XB_XSUB(b.x)], 1u);
        const unsigned gen = old / nloc;
        if (old + 1u == (gen + 1u) * nloc) {
            __builtin_amdgcn_fence(__ATOMIC_RELEASE, "agent");
            asm volatile("s_waitcnt vmcnt(0)" ::: "memory");
            const unsigned og = xb_add(&bar[XB_TOP], 1u);
            const unsigned tg = og / nx;
            if (og + 1u == (tg + 1u) * nx) xb_add(&bar[XB_TOPGEN], 1u);
            else XB_SPIN(xb_ld(&bar[XB_TOPGEN]) == tg, bar);
            __builtin_amdgcn_fence(__ATOMIC_ACQUIRE, "agent");
            xb_add(&bar[XB_XGEN(b.x)], 1u);
            asm volatile("s_waitcnt vmcnt(0)" ::: "memory");
        } else {
            XB_SPIN(xb_ld(&bar[XB_XGEN(b.x)]) == gen, bar);
            __builtin_amdgcn_fence(__ATOMIC_ACQUIRE, "agent");
            asm volatile("s_waitcnt vmcnt(0)" ::: "memory");
        }
    }
    __syncthreads();
}

__global__ void __launch_bounds__(512, 2) fwd_megakernel(Args a) {
    extern __shared__ __attribute__((aligned(16))) unsigned char lds_raw[];
    LAS unsigned char* lds = (LAS unsigned char*)lds_raw;
    cg::grid_group grid = cg::this_grid();
#define GSYNC() do { XcdBarrier xb_; xb_.bar = (unsigned*)(ws + WS_BAR); xb_.x = xb_xcc_id(); xb_.st = (volatile LAS unsigned*)(lds + LDS_BARST); xcd_barrier(xb_); } while (0)
    const int tid = threadIdx.x, lane = tid & 63, wave = __builtin_amdgcn_readfirstlane(tid >> 6);
    const int bid = blockIdx.x, G = gridDim.x;
    const int gw = bid * 8 + wave, NGW = G * 8;
    unsigned char* ws = a.ws;
    const float* MOD = (const float*)(ws + WS_MOD);
    bf16* HX = (bf16*)(ws + WS_HX); bf16* YB = (bf16*)(ws + WS_XR);
    float* X1C = (float*)(ws + WS_XR + 132 * MiB) - (size_t)ML * DM;
    bf16* MIX = (bf16*)(ws + WS_MIX);
    if (bid == 0) { for (int i = tid; i < XCD_BAR_WORDS; i += 512) __hip_atomic_store((unsigned*)(ws + WS_BAR) + i, 0u, __ATOMIC_RELAXED, __HIP_MEMORY_SCOPE_AGENT); }

#ifndef SKIP_P0
    p0_prologue(a, lds, bid, G, tid);
#endif
    __syncthreads();
    if (tid < 2) ((volatile LAS unsigned*)(lds + LDS_BARST))[tid] = 0u;
    grid.sync();
    (void)xcd_barrier_post((unsigned*)(ws + WS_BAR), (volatile LAS unsigned*)(lds + LDS_BARST));
    __syncthreads();
    for (int row = gw * 4; row < ML; row += NGW * 4) {
        const float* md = MOD + (size_t)(row >> 13) * 6144;
        row_op<4>(a.in[0] + (size_t)row * DM, nullptr, nullptr, nullptr, nullptr, HX + (size_t)row * DM, a.in[6], md + 1024, md, lane);
    }
    for (int row = ML + gw; row < MT; row += NGW) {
        const float* md = MOD + (size_t)8 * 6144;
        row_op<1>(a.in[2] + (size_t)(row - ML) * DM, nullptr, nullptr, nullptr, nullptr, HX + (size_t)row * DM, a.in[6], md + 1024, md, lane);
    }
    GSYNC();
#pragma unroll 1
    for (int l = 0; l < 2; ++l) {
        const bool last = l == 1;
        const int MR = last ? ML : MT;
        const float* modl = MOD + (size_t)l * 9 * 6144;
#ifndef SKIP_G1
        {
            int fM = MT, fN = NIN, fK = DM; asm volatile("" : "+s"(fM), "+s"(fN), "+s"(fK));
            pg8::Gemm g{HX, (const bf16*)(ws + WS_WIN) + (size_t)l * NIN * 1024, fM, fN, fK}; pg8::StaticOrder S; S.init(fM, fN, G, bid);
            EpiIn E{ws, last ? 1 : 0};
            pg8::gemm_phase<EpiIn, pg8::StaticOrder, true, true>(lds, g, S, E);
        }
#endif
        GSYNC();
        const float* gmixl = a.in[12] + l * 1024;
        attn_units(lds, (const bf16*)(ws + WS_QB), (const bf16*)(ws + WS_KB), (const bf16*)(ws + WS_VT), (const bf16*)(ws + WS_VTC), MIX, a.in[8] + l * 8, gmixl, last ? 1024 : 1056, G, bid, tid);
        sgu_units(lds, (const bf16*)(ws + WS_UB), (const bf16*)(ws + WS_GVT), (const bf16*)(ws + WS_GVTC), MIX, a.in[9] + (size_t)l * 4 * 128 * 128, a.in[10] + l * 512, a.in[11] + l * 256, gmixl,
                  last ? 512 : 528, G, (bid + 224) % G, tid);
        __syncthreads();
#ifndef SKIP_F1
        {
            int fM = 512, fN = 32768, fK = 512; asm volatile("" : "+s"(fM), "+s"(fN), "+s"(fK));
            pg8::Gemm g{(const bf16*)(ws + WS_DFT512), (const bf16*)(ws + WS_GT), fM, fN, fK}; pg8::StaticOrder S; S.init(fM, fN, G, bid);
            pg8::EpiPlain<0, false> E{(bf16*)(ws + WS_TP), fN, 1.f};
            pg8::gemm_phase<pg8::EpiPlain<0, false>, pg8::StaticOrder, true, true>(lds, g, S, E);
        }
#endif
#ifndef SKIP_CF
        if (!last) {
            int fM = 256, fN = 2048, fK = 512, fL = 1024; asm volatile("" : "+s"(fM), "+s"(fN), "+s"(fK), "+s"(fL));
            pg8::Gemm g{(const bf16*)(ws + WS_DFT256), (const bf16*)(ws + WS_GTC), fM, fN, fK}; pg8::StaticOrder S; S.init(fM, fN, G, (bid + 208) % G);
            pg8::EpiPlain<0, true> E{MIX + (size_t)ML * 1024 + 768, fL, 0.0078125f};
            pg8::gemm_phase<pg8::EpiPlain<0, true>, pg8::StaticOrder, true, true>(lds, g, S, E);
        }
#endif
        GSYNC();
        fourier_stage2(lds, wave, (const bf16*)(ws + WS_TP), MIX, gmixl, gw, NGW, lane);
        if (!last) ctx_fourier_norm(MIX, gmixl, gw, NGW, lane);
        GSYNC();
#ifndef SKIP_G2
        {
            pg8::Gemm g{MIX, (const bf16*)(ws + WS_WOUT) + (size_t)l * 1024 * 1024, ML, DM, DM, 0}; pg8::StaticOrder S; S.init(ML, DM, G, bid);
            pg8::EpiPlain<0, false> E{YB, DM, 1.f};
            pg8::gemm_phase<pg8::EpiPlain<0, false>, pg8::StaticOrder, true, true>(lds, g, S, E);
        }
        if (!last) {
            int fK = 256, fL = DM; asm volatile("" : "+s"(fK), "+s"(fL));
            pg8::Gemm g{MIX, (const bf16*)(ws + WS_WOUT) + (size_t)l * 1024 * 1024, MT, DM, fK, fL}; pg8::SplitKOrder S{G, bid, 256, 8, 4, 4, fK * 2};
            pg8::EpiPart E{(float*)(ws + WS_PART), fL, fK * 2, 256, (size_t)2048 * 1024};
            pg8::gemm_phase<pg8::EpiPart, pg8::SplitKOrder, true, true>(lds, g, S, E);
        }
#endif
        GSYNC();
        for (int row = gw * 4; row < ML; row += NGW * 4) {
            const float* md = modl + (size_t)(row >> 13) * 6144;
            const float* xin = l == 0 ? a.in[0] + (size_t)row * DM : a.out + (size_t)row * DM;
            row_op<4>(xin, YB + (size_t)row * DM, md + 2048, a.in[14] + l * 1024, nullptr, HX + (size_t)row * DM, a.in[15] + l * 1024, md + 4096, md + 3072, lane);
        }
        if (!last) for (int row = ML + gw; row < MT; row += NGW) {
            const float* md = modl + (size_t)8 * 6144;
            row_op<1, 4>(a.in[2] + (size_t)(row - ML) * DM, (const bf16*)((const float*)(ws + WS_PART) + (size_t)(row - ML) * DM), md + 2048, a.in[14] + l * 1024, X1C + (size_t)row * DM, HX + (size_t)row * DM, a.in[15] + l * 1024, md + 4096, md + 3072, lane);
        }
        GSYNC();
#ifndef SKIP_G3
        {
            pg8::Gemm g{HX, (const bf16*)(ws + WS_WFF1) + (size_t)l * 4096 * 1024, MR, DFF, DM}; pg8::StaticOrder S; S.init(MR, DFF, G, bid);
            pg8::EpiPlain<1, false> E{(bf16*)(ws + WS_H1), DFF, 1.f};
            pg8::gemm_phase<pg8::EpiPlain<1, false>, pg8::StaticOrder, true, true>(lds, g, S, E);
        }
#endif
        GSYNC();
#ifndef SKIP_G4
        {
            pg8::Gemm g{(const bf16*)(ws + WS_H1), (const bf16*)(ws + WS_WFF2) + (size_t)l * 1024 * 4096, ML, DM, DFF, 0}; pg8::StaticOrder S; S.init(ML, DM, G, bid);
            pg8::EpiPlain<0, false> E{HX, DM, 1.f};
            pg8::gemm_phase<pg8::EpiPlain<0, false>, pg8::StaticOrder, true, true>(lds, g, S, E);
        }
        if (!last) {
            int fK = 1024, fL = DFF, fC = DM; asm volatile("" : "+s"(fK), "+s"(fL), "+s"(fC));
            pg8::Gemm g{(const bf16*)(ws + WS_H1), (const bf16*)(ws + WS_WFF2) + (size_t)l * 1024 * 4096, MT, DM, fK, fL}; pg8::SplitKOrder S{G, bid, 256, 8, 4, 4, fK * 2};
            pg8::EpiPart E{(float*)(ws + WS_PART), fC, fK * 2, 256, (size_t)2048 * 1024};
            pg8::gemm_phase<pg8::EpiPart, pg8::SplitKOrder, true, true>(lds, g, S, E);
        }
#endif
        GSYNC();
        for (int row = gw * 4; row < ML; row += NGW * 4) {
            const int mr = row >> 13; const float* md = modl + (size_t)mr * 6144;
            const float* xin = l == 0 ? a.in[0] + (size_t)row * DM : a.out + (size_t)row * DM;
            if (!last) { const float* mdn = MOD + (size_t)(9 + mr) * 6144;
                row_op<4>(xin, YB + (size_t)row * DM, md + 2048, a.in[14] + l * 1024, a.out + (size_t)row * DM, HX + (size_t)row * DM, a.in[6] + 1024, mdn + 1024, mdn, lane,
                          HX + (size_t)row * DM, md + 5120, a.in[18] + l * 1024);
            } else row_op<4>(xin, YB + (size_t)row * DM, md + 2048, a.in[14] + l * 1024, a.out + (size_t)row * DM, nullptr, nullptr, nullptr, nullptr, lane,
                             HX + (size_t)row * DM, md + 5120, a.in[18] + l * 1024);
        }
        if (!last) for (int row = ML + gw; row < MT; row += NGW) {
            const float* md = modl + (size_t)8 * 6144; const float* mdn = MOD + (size_t)(9 + 8) * 6144;
            row_op<1, 4>(X1C + (size_t)row * DM, (const bf16*)((const float*)(ws + WS_PART) + (size_t)(row - ML) * DM), md + 5120, a.in[18] + l * 1024, nullptr, HX + (size_t)row * DM, a.in[6] + 1024, mdn + 1024, mdn, lane);
        }
        if (!last) GSYNC();
    }
}

extern "C" void kernel_launch(void* const* d_in, const int* in_sizes, int n_in, void* d_out, int out_size, void* d_ws, size_t ws_size, hipStream_t stream) {
    static int grid = 0;
    if (grid == 0) {
        if (n_in != 19 || ws_size < WS_TOTAL) { fprintf(stderr, "kernel_launch: unexpected n_in %d / ws %zu\n", n_in, ws_size); grid = -1; return; }
        int dev = 0, cus = 0, per_cu = 0;
        hipGetDevice(&dev);
        hipDeviceGetAttribute(&cus, hipDeviceAttributeMultiprocessorCount, dev);
        hipFuncSetAttribute((const void*)fwd_megakernel, hipFuncAttributeMaxDynamicSharedMemorySize, LDS_BYTES);
        hipOccupancyMaxActiveBlocksPerMultiprocessor(&per_cu, (const void*)fwd_megakernel, 512, LDS_BYTES);
        if (per_cu < 1) per_cu = 1;
        grid = cus * per_cu;
        (void)hipGetLastError();
    }
    if (grid < 0) return;
    Args a{};
    for (int i = 0; i < 19; ++i) a.in[i] = (const float*)d_in[i];
    a.out = (float*)d_out; a.ws = (unsigned char*)d_ws;
    void* args[] = {&a};
    hipError_t e = hipLaunchCooperativeKernel((const void*)fwd_megakernel, dim3(grid), dim3(512), args, LDS_BYTES, stream);
    if (e != hipSuccess) fprintf(stderr, "cooperative launch failed: %s (grid %d)\n", hipGetErrorString(e), grid);
}
```
